# Optimizing an MI355X kernel written in HIP

```python
import jax, jax.numpy as jnp
from jax import lax
import numpy as np

D_MODEL = 2048
BATCH = 8
SEQ = 2048
DEPTH = 1

GRID_W = 64
CTX_LEN = 256
D_MIX = D_MODEL
D_CONV = D_MIX // 2
CONV_GROUPS = 8
CONV_GROUP_DIM = D_CONV // CONV_GROUPS
CONV_WIDTH = 3
D_ATTN = D_MIX - D_CONV
N_HEADS = 8
HEAD_DIM = D_ATTN // N_HEADS
NA_ROWS = 8
NA_COLS = 16
ROPE_THETA = 10000.0
N_EXPERTS = 64
TOP_K = 8
N_EXPERT_GROUPS = 8
TOPK_GROUPS = 4
D_EXPERT = 512
D_SHARED = 512
ROUTED_SCALE = 2.5
EXPERT_CHUNK = 8
EPS = 1e-6
D_IN_PROJ = 3 * D_CONV + 3 * D_ATTN
IN_SPLITS = (D_CONV, 2 * D_CONV, 3 * D_CONV, 3 * D_CONV + D_ATTN, 3 * D_CONV + 2 * D_ATTN)
KV_OFFSET = 3 * D_CONV + D_ATTN

kernel_name = "hybrid_conv_natten_moe_dit_layer"


def _normalize(x):
    xf = x.astype(jnp.float32)
    return xf * lax.rsqrt(jnp.mean(xf * xf, axis=-1, keepdims=True) + EPS)


def rmsnorm(x, g):
    return (_normalize(x) * g.astype(jnp.float32)).astype(x.dtype)


def modulate(h, shift, scale):
    return h * (1 + scale) + shift


def axial_rope_tables(n_tokens):
    t = jnp.arange(n_tokens, dtype=jnp.int32)
    pos = jnp.stack([t // GRID_W, t % GRID_W], axis=-1).astype(jnp.float32)
    n_freq = HEAD_DIM // 4
    inv_freq = ROPE_THETA ** (-jnp.arange(n_freq, dtype=jnp.float32) / n_freq)
    ang = pos[:, :, None] * inv_freq
    return jnp.cos(ang), jnp.sin(ang)


def apply_rope(x, cos, sin):
    b, s, h, d = x.shape
    xr = x.reshape(b, s, h, 2, 2, d // 4)
    x1, x2 = xr[..., 0, :], xr[..., 1, :]
    c = cos[None, :, None].astype(x.dtype)
    sn = sin[None, :, None].astype(x.dtype)
    out = jnp.stack([x1 * c - x2 * sn, x2 * c + x1 * sn], axis=-2)
    return out.reshape(b, s, h, d)


def heads(t):
    b, l, _ = t.shape
    return t.reshape(b, l, N_HEADS, HEAD_DIM)


def short_conv(u, w, bias):
    up = jnp.pad(u, ((0, 0), (1, 1), (0, 0)))
    return up[:, :-2] * w[0] + up[:, 1:-1] * w[1] + up[:, 2:] * w[2] + bias


def gated_conv_mixer(bg, cg, u, w, bias):
    return bg * short_conv(cg * u, w, bias)


def neighbourhood_attention(q, k, v, kc, vc, rpb):
    b, s, h, d = q.shape
    rows = s // GRID_W
    kh = min(NA_ROWS, rows)
    kw = NA_COLS
    scale = HEAD_DIM ** -0.5
    qg = q.reshape(b, rows, GRID_W, h, d)
    kg = k.reshape(b, rows, GRID_W, h, d)
    vg = v.reshape(b, rows, GRID_W, h, d)
    row_start = jnp.clip(jnp.arange(rows) - kh // 2, 0, rows - kh)
    qcol = jnp.arange(GRID_W)
    col_idx = jnp.clip(qcol - kw // 2, 0, GRID_W - kw)[:, None] + jnp.arange(kw)
    col_off = col_idx - qcol[:, None] + (NA_COLS - 1)
    n_loc = kh * kw

    def one_row(r):
        r0 = row_start[r]
        kr = lax.dynamic_slice_in_dim(kg, r0, kh, axis=1)
        vr = lax.dynamic_slice_in_dim(vg, r0, kh, axis=1)
        k_sel = jnp.take(kr, col_idx, axis=2)
        v_sel = jnp.take(vr, col_idx, axis=2)
        qr = lax.dynamic_index_in_dim(qg, r, axis=1, keepdims=False)
        s_loc = jnp.einsum('bqhd,biqjhd->bhqij', qr, k_sel).astype(jnp.float32) * scale
        row_off = r0 + jnp.arange(kh) - r + (NA_ROWS - 1)
        bias = rpb[:, row_off[None, :, None], col_off[:, None, :]]
        s_loc = s_loc + bias[None].astype(jnp.float32)
        s_ctx = jnp.einsum('bqhd,bchd->bhqc', qr, kc).astype(jnp.float32) * scale
        logits = jnp.concatenate([s_loc.reshape(b, h, GRID_W, n_loc), s_ctx], axis=-1)
        p = jax.nn.softmax(logits, axis=-1).astype(v.dtype)
        p_loc = p[..., :n_loc].reshape(b, h, GRID_W, kh, kw)
        p_ctx = p[..., n_loc:]
        return (jnp.einsum('bhqij,biqjhd->bqhd', p_loc, v_sel)
                + jnp.einsum('bhqc,bchd->bqhd', p_ctx, vc))

    out = lax.map(one_row, jnp.arange(rows))
    return jnp.transpose(out, (1, 0, 2, 3, 4)).reshape(b, s, h, d)


def context_attention(q, k, v):
    scale = HEAD_DIM ** -0.5
    logits = jnp.einsum('bqhd,bkhd->bhqk', q, k).astype(jnp.float32) * scale
    p = jax.nn.softmax(logits, axis=-1).astype(v.dtype)
    return jnp.einsum('bhqk,bkhd->bqhd', p, v)


def merge_head_groups(conv_out, attn_out, g_conv, g_attn, w_out):
    b, l, _ = conv_out.shape
    yc = _normalize(conv_out.reshape(b, l, CONV_GROUPS, CONV_GROUP_DIM)).reshape(b, l, D_CONV)
    ya = _normalize(attn_out).reshape(b, l, D_ATTN)
    y = jnp.concatenate([yc * g_conv.astype(jnp.float32), ya * g_attn.astype(jnp.float32)], axis=-1)
    return y.astype(conv_out.dtype) @ w_out


def moe_ffn(h, w_router, router_bias, w_gate, w_up, w_down, ws_gate, ws_up, ws_down):
    b, s, d = h.shape
    t = h.reshape(b * s, d)
    n_tok = t.shape[0]
    scores = jax.nn.sigmoid((t @ w_router).astype(jnp.float32))
    sel = scores + router_bias.astype(jnp.float32)
    grp_scores = lax.top_k(sel.reshape(n_tok, N_EXPERT_GROUPS, N_EXPERTS // N_EXPERT_GROUPS), 2)[0].sum(-1)
    _, top_g = lax.top_k(grp_scores, TOPK_GROUPS)
    gmask = jnp.any(top_g[:, :, None] == jnp.arange(N_EXPERT_GROUPS), axis=1)
    emask = jnp.repeat(gmask, N_EXPERTS // N_EXPERT_GROUPS, axis=-1)
    _, idx = lax.top_k(jnp.where(emask, sel, -jnp.inf), TOP_K)
    wsel = jnp.take_along_axis(scores, idx, axis=-1)
    wsel = wsel / jnp.sum(wsel, axis=-1, keepdims=True) * ROUTED_SCALE
    gates = jnp.zeros((n_tok, N_EXPERTS), jnp.float32).at[jnp.arange(n_tok)[:, None], idx].set(wsel)
    gates = gates.astype(t.dtype)
    out = (jax.nn.silu(t @ ws_gate) * (t @ ws_up)) @ ws_down
    for e0 in range(0, N_EXPERTS, EXPERT_CHUNK):
        sl = slice(e0, e0 + EXPERT_CHUNK)
        hid = jax.nn.silu(jnp.einsum('td,edf->tef', t, w_gate[sl])) * jnp.einsum('td,edf->tef', t, w_up[sl])
        out = out + jnp.einsum('tef,efd->td', hid * gates[:, sl, None], w_down[sl])
    return out.reshape(b, s, d)


def setup_inputs(seed: int = 0) -> dict:
    key = jax.random.key(seed)
    ks = jax.random.split(key, 25)
    f32 = jnp.float32
    L = DEPTH

    def nrm(k, shape, scale):
        return jax.random.normal(k, shape, f32) * scale

    def gain(k, shape):
        return 1.0 + 0.01 * jax.random.normal(k, shape, f32)

    return {
        "x": nrm(ks[0], (BATCH, SEQ, D_MODEL), 1.0),
        "c": nrm(ks[1], (BATCH, D_MODEL), 1.0),
        "ctx": nrm(ks[2], (BATCH, CTX_LEN, D_MODEL), 1.0),
        "c_ctx": nrm(ks[3], (D_MODEL,), 1.0),
        "w_mod": nrm(ks[4], (L, D_MODEL, 6 * D_MODEL), 0.5 * D_MODEL ** -0.5),
        "b_mod": nrm(ks[5], (L, 6 * D_MODEL), 0.02),
        "g_pre_mix": gain(ks[6], (L, D_MODEL)),
        "g_post_mix": gain(ks[7], (L, D_MODEL)),
        "g_pre_ffn": gain(ks[8], (L, D_MODEL)),
        "g_post_ffn": gain(ks[9], (L, D_MODEL)),
        "w_in": nrm(ks[10], (L, D_MODEL, D_IN_PROJ), D_MODEL ** -0.5),
        "conv_w": nrm(ks[11], (L, CONV_WIDTH, D_CONV), CONV_WIDTH ** -0.5),
        "conv_b": nrm(ks[12], (L, D_CONV), 0.02),
        "rpb": nrm(ks[13], (L, N_HEADS, 2 * NA_ROWS - 1, 2 * NA_COLS - 1), 0.1),
        "g_conv_out": gain(ks[14], (L, D_CONV)),
        "g_attn_out": gain(ks[15], (L, D_ATTN)),
        "w_out": nrm(ks[16], (L, D_MIX, D_MODEL), D_MIX ** -0.5),
        "w_router": nrm(ks[17], (L, D_MODEL, N_EXPERTS), D_MODEL ** -0.5),
        "router_bias": nrm(ks[18], (L, N_EXPERTS), 0.01),
        "w_exp_gate": nrm(ks[19], (L, N_EXPERTS, D_MODEL, D_EXPERT), D_MODEL ** -0.5),
        "w_exp_up": nrm(ks[20], (L, N_EXPERTS, D_MODEL, D_EXPERT), D_MODEL ** -0.5),
        "w_exp_down": nrm(ks[21], (L, N_EXPERTS, D_EXPERT, D_MODEL), D_EXPERT ** -0.5),
        "w_sh_gate": nrm(ks[22], (L, D_MODEL, D_SHARED), D_MODEL ** -0.5),
        "w_sh_up": nrm(ks[23], (L, D_MODEL, D_SHARED), D_MODEL ** -0.5),
        "w_sh_down": nrm(ks[24], (L, D_SHARED, D_MODEL), D_SHARED ** -0.5),
    }


def reference(x, c, ctx, c_ctx, w_mod, b_mod, g_pre_mix, g_post_mix, g_pre_ffn, g_post_ffn,
              w_in, conv_w, conv_b, rpb, g_conv_out, g_attn_out, w_out, w_router, router_bias,
              w_exp_gate, w_exp_up, w_exp_down, w_sh_gate, w_sh_up, w_sh_down):
    seq = x.shape[1]
    cos, sin = axial_rope_tables(seq)
    xc = ctx
    for l in range(DEPTH):
        last = l == DEPTH - 1
        mod = jax.nn.silu(c) @ w_mod[l] + b_mod[l]
        mod_c = jax.nn.silu(c_ctx) @ w_mod[l] + b_mod[l]
        sh_a, sc_a, gt_a, sh_f, sc_f, gt_f = jnp.split(mod[:, None, :], 6, axis=-1)
        shc_a, scc_a, gtc_a, shc_f, scc_f, gtc_f = jnp.split(mod_c[None, None, :], 6, axis=-1)

        hl = modulate(rmsnorm(x, g_pre_mix[l]), sh_a, sc_a)
        hc = modulate(rmsnorm(xc, g_pre_mix[l]), shc_a, scc_a)
        ub, uc, ux, q, k, v = jnp.split(hl @ w_in[l], IN_SPLITS, axis=-1)
        if last:
            kc_, vc_ = jnp.split(hc @ w_in[l][:, KV_OFFSET:], 2, axis=-1)
        else:
            cb, cc, cx, qc_, kc_, vc_ = jnp.split(hc @ w_in[l], IN_SPLITS, axis=-1)
        kc, vc = heads(kc_), heads(vc_)
        attn_l = neighbourhood_attention(apply_rope(heads(q), cos, sin), apply_rope(heads(k), cos, sin),
                                         heads(v), kc, vc, rpb[l])
        conv_l = gated_conv_mixer(ub, uc, ux, conv_w[l], conv_b[l])
        y_l = merge_head_groups(conv_l, attn_l, g_conv_out[l], g_attn_out[l], w_out[l])
        x = x + gt_a * rmsnorm(y_l, g_post_mix[l])
        if not last:
            attn_c = context_attention(heads(qc_), kc, vc)
            conv_c = gated_conv_mixer(cb, cc, cx, conv_w[l], conv_b[l])
            y_c = merge_head_groups(conv_c, attn_c, g_conv_out[l], g_attn_out[l], w_out[l])
            xc = xc + gtc_a * rmsnorm(y_c, g_post_mix[l])

        ffn_args = (w_router[l], router_bias[l], w_exp_gate[l], w_exp_up[l], w_exp_down[l],
                    w_sh_gate[l], w_sh_up[l], w_sh_down[l])
        f_l = moe_ffn(modulate(rmsnorm(x, g_pre_ffn[l]), sh_f, sc_f), *ffn_args)
        x = x + gt_f * rmsnorm(f_l, g_post_ffn[l])
        if not last:
            f_c = moe_ffn(modulate(rmsnorm(xc, g_pre_ffn[l]), shc_f, scc_f), *ffn_args)
            xc = xc + gtc_f * rmsnorm(f_c, g_post_ffn[l])
    return x
```

```cpp
#include <hip/hip_runtime.h>
#include <cstdio>
#include <cstdint>


#ifndef MK_N_LAUNCHES
#define MK_N_LAUNCHES 9
#endif

#define GAS __attribute__((address_space(1)))
#define LAS __attribute__((address_space(3)))
typedef unsigned short bf16;
typedef unsigned v4u __attribute__((ext_vector_type(4)));
typedef unsigned v2u __attribute__((ext_vector_type(2)));
typedef float f32x4 __attribute__((ext_vector_type(4)));
typedef float f32x2 __attribute__((ext_vector_type(2)));
typedef short bf16x8 __attribute__((ext_vector_type(8)));
typedef __bf16 v2bf __attribute__((ext_vector_type(2)));

constexpr int NB = 8, SEQ = 2048, DM = 2048, T = NB * SEQ, LC = 256, TC = NB * LC;
constexpr int GW = 64, DC = 1024, NH = 8, HD = 128;
constexpr int NPROJ = 6144, QOFF = 3072, KOFF = 4096, VOFF = 5120;
constexpr int NE = 64, FE = 512, NSLOT = 9;
constexpr float EPS = 1e-6f;
constexpr int NWAVES = 8, NTHR = 512;
constexpr int LIST_CAP = 16384;
constexpr int MAX_TILES = 640;

constexpr size_t MiB = 1u << 20;
constexpr size_t WS_CTL = 0, CTL_ZERO_BYTES = 1 * MiB;
constexpr size_t WS_MOD = 1 * MiB;
constexpr size_t WS_ROPE = 1 * MiB + 512 * 1024;
constexpr size_t WS_SSQ = 2 * MiB;
constexpr size_t WS_LIST = 4 * MiB;
constexpr size_t WS_WRH = 13 * MiB, WS_WRL = 13 * MiB + 256 * 1024;
constexpr size_t WS_WDN = 14 * MiB;
constexpr size_t WS_YL = 144 * MiB;
constexpr size_t WS_HID = 208 * MiB;
constexpr size_t WS_WGU = 368 * MiB;
constexpr size_t WS_WIN = 628 * MiB;
constexpr size_t WS_WOUT = 652 * MiB;
constexpr size_t WS_HL = 660 * MiB;
constexpr size_t WS_HC = 724 * MiB;
constexpr size_t WS_KVC = 732 * MiB;
constexpr size_t WS_PROJ = 740 * MiB;
constexpr size_t WS_H2LO = 740 * MiB;
constexpr size_t WS_Y = 932 * MiB;
constexpr size_t WS_SLOT = 368 * MiB;
constexpr size_t WS_END = 996 * MiB;
static_assert(WS_SLOT + (size_t)T * NSLOT * DM * 2 <= WS_END, "slot buffer");
constexpr int CW_BAR = 4096;
constexpr int CW_CNT = 16384;

constexpr int RING_BYTES = 131072;
constexpr int MISC_OFF = RING_BYTES;
constexpr int BARW_OFF = 163840 - 64;
constexpr int LDS_BYTES = 163840;

#define RLX_AGENT __ATOMIC_RELAXED, __HIP_MEMORY_SCOPE_AGENT
#define LDS_WAIT() asm volatile("s_waitcnt lgkmcnt(0)" ::: "memory")
#define VM_WAIT() asm volatile("s_waitcnt vmcnt(0)" ::: "memory")
__device__ __forceinline__ unsigned cvt_pk_bf16(float lo, float hi) { unsigned r; asm volatile("v_cvt_pk_bf16_f32 %0, %1, %2" : "=v"(r) : "v"(lo), "v"(hi)); return r; }
__device__ __forceinline__ float u2f(unsigned u) { return __builtin_bit_cast(float, u); }
__device__ __forceinline__ float bf_lo(unsigned u) { return __builtin_bit_cast(float, u << 16); }
__device__ __forceinline__ float bf_hi(unsigned u) { return __builtin_bit_cast(float, u & 0xffff0000u); }
__device__ __forceinline__ float wave_sum(float v) {
#pragma unroll
    for (int o = 1; o < 64; o <<= 1) v += __shfl_xor(v, o);
    return v;
}
__device__ __forceinline__ float wave_max(float v) {
#pragma unroll
    for (int o = 1; o < 64; o <<= 1) v = fmaxf(v, __shfl_xor(v, o));
    return v;
}
__device__ __forceinline__ float silu_f(float v) { return v / (1.0f + expf(-v)); }

#define XB_TMO      128
#define XB_XCNT(j)  (256  + 64 * (j))
#define XB_XSUB(j)  (1280 + 64 * (j))
#define XB_XGEN(j)  (2304 + 64 * (j))
#define XB_TOP      3328
#define XB_TOPGEN   3392
#define XCD_BAR_WORDS 3456
#define XB_SPIN_CAP (1u << 18)
__device__ __forceinline__ unsigned xb_ld(unsigned* p)              { return __hip_atomic_load(p, __ATOMIC_RELAXED, __HIP_MEMORY_SCOPE_AGENT); }
__device__ __forceinline__ unsigned xb_add(unsigned* p, unsigned v) { return __hip_atomic_fetch_add(p, v, __ATOMIC_RELAXED, __HIP_MEMORY_SCOPE_AGENT); }
__device__ __forceinline__ unsigned xb_xcc_id() { return (unsigned)__builtin_amdgcn_s_getreg((3 << 11) | 20) & 0xFu; }
#define XB_SPIN(cond, bar) do { unsigned _sp = 0; while (cond) { __builtin_amdgcn_s_sleep(1); \
    if ((++_sp & 255u) == 0u) { if (xb_ld(&(bar)[XB_TMO])) break; if (_sp > XB_SPIN_CAP) { atomicAdd(&(bar)[XB_TMO], 1u); break; } } } } while (0)
struct XcdBarrier { unsigned* bar; unsigned x; volatile LAS unsigned* st; };
__device__ __forceinline__ XcdBarrier xcd_barrier_post(unsigned* bar, volatile LAS unsigned* st) {
    XcdBarrier b; b.bar = bar; b.x = xb_xcc_id(); b.st = st;
    if (threadIdx.x == 0) (void)xb_add(&bar[XB_XCNT(b.x)], 1u);
    return b;
}
__device__ __forceinline__ void xcd_barrier_complete(unsigned* bar, unsigned x, unsigned& nloc, unsigned& nx) {
    const unsigned G = gridDim.x * gridDim.y * gridDim.z;
    unsigned sum, cnt, mine, sp = 0u;
    for (;;) {
        sum = 0u; cnt = 0u; mine = 0u;
#pragma unroll
        for (unsigned j = 0; j < 16; ++j) { const unsigned c = xb_ld(&bar[XB_XCNT(j)]); sum += c; cnt += (c > 0u) ? 1u : 0u; mine = (j == x) ? c : mine; }
        if (sum == G) break;
        __builtin_amdgcn_s_sleep(1);
        if ((++sp & 255u) == 0u) { if (xb_ld(&bar[XB_TMO])) break; if (sp > XB_SPIN_CAP) { atomicAdd(&bar[XB_TMO], 1u); break; } }
    }
    nloc = mine > 0u ? mine : 1u; nx = cnt > 0u ? cnt : 1u;
}
__device__ __forceinline__ void xcd_barrier(const XcdBarrier& b) {
    asm volatile("s_waitcnt vmcnt(0)" ::: "memory");
    __syncthreads();
    if (threadIdx.x == 0) {
        unsigned* bar = b.bar;
        __builtin_amdgcn_s_waitcnt(0);
        unsigned nloc = b.st[0], nx = b.st[1];
        if (nloc == 0u) { xcd_barrier_complete(bar, b.x, nloc, nx); b.st[0] = nloc; b.st[1] = nx; }
        const unsigned old = xb_add(&bar[XB_XSUB(b.x)], 1u);
        const unsigned gen = old / nloc;
        if (old + 1u == (gen + 1u) * nloc) {
            __builtin_amdgcn_fence(__ATOMIC_RELEASE, "agent");
            asm volatile("s_waitcnt vmcnt(0)" ::: "memory");
            const unsigned og = xb_add(&bar[XB_TOP], 1u);
            const unsigned tg = og / nx;
            if (og + 1u == (tg + 1u) * nx) xb_add(&bar[XB_TOPGEN], 1u);
            else XB_SPIN(xb_ld(&bar[XB_TOPGEN]) == tg, bar);
            __builtin_amdgcn_fence(__ATOMIC_ACQUIRE, "agent");
            xb_add(&bar[XB_XGEN(b.x)], 1u);
            asm volatile("s_waitcnt vmcnt(0)" ::: "memory");
        } else {
            XB_SPIN(xb_ld(&bar[XB_XGEN(b.x)]) == gen, bar);
            __builtin_amdgcn_fence(__ATOMIC_ACQUIRE, "agent");
            asm volatile("s_waitcnt vmcnt(0)" ::: "memory");
        }
    }
    __syncthreads();
}

namespace pg8 {
constexpr int BM = 256, BK = 64, HALF = 128, HTB = HALF * BK * 2, STAGE_BYTES = 8 * HTB;
__host__ __device__ __forceinline__ int lds_byte(int r, int c) { const int st = (r >> 4) * 2 + (c >> 5), rr = r & 15, cc = c & 31, ob = rr * 64 + cc * 2; return st * 1024 + (ob ^ (((ob >> 9) & 1) << 5)); }
__host__ __device__ __forceinline__ void stage_rc(int b, int& R, int& C) { const int st = b / 1024, sb = b % 1024, swz = sb ^ (((sb >> 9) & 1) << 5); R = (st >> 1) * 16 + swz / 64; C = (st & 1) * 32 + (swz % 64) / 2; }
__host__ __device__ __forceinline__ int perm32(int rho) { const int n = rho >> 4, i = rho & 15; return 8 * (i >> 2) + 4 * n + (i & 3); }
struct Unit { int pm, pn, g; };

__device__ __forceinline__ int round_unit(int i, int G, int c, int total) {
    const int base = i * G; if (base + c >= total && (total - base) >= G) return -1;
    const int R = (total - base) < G ? (total - base) : G;
    if (R <= 0) return -1;
    if (R == G && (G & 7) == 0) return base + (c & 7) * (G >> 3) + (c >> 3);
    return c < R ? base + c : -1;
}

template <class P>
__device__ __forceinline__ void gemm_phase(LAS unsigned char* lds, const P& p) {
    constexpr int K = P::K, nt = K / BK;
    const int tid = threadIdx.x, wid = __builtin_amdgcn_readfirstlane(tid >> 6), lane = tid & 63, wr = wid >> 2, wc = wid & 3, fr = lane & 15, fq = lane >> 4;
    unsigned voffB[2], voffA[2];
#pragma unroll
    for (int i = 0; i < 2; ++i) { int R, C; stage_rc(tid * 16 + i * 8192, R, C); const int Rb = P::PERM ? ((R & ~31) + perm32(R & 31)) : R;
        voffA[i] = (unsigned)(R * K + C) * 2u; voffB[i] = (unsigned)(Rb * K + C) * 2u; }
    LAS unsigned* goffs = (LAS unsigned*)(lds + STAGE_BYTES + 1024);
    constexpr size_t kstep = (size_t)(BK * 2);
    constexpr size_t hstep = (size_t)HALF * K * 2;
    const unsigned ldsw = (unsigned)wid * 1024u;
    const int aoff = lds_byte(wr * 64 + fr, fq * 8), boff = lds_byte(wc * 32 + fr, fq * 8);
#define PG8_SA(b, h) (((b) * 2 + (h)) * HTB)
#define PG8_SB(b, h) ((4 + (b) * 2 + (h)) * HTB)
#define PG8_STAGE(bufoff, gbase, voff) do { _Pragma("unroll") for (int _i = 0; _i < 2; ++_i) \
        __builtin_amdgcn_global_load_lds((const unsigned*)((const char*)(gbase) + (voff)[_i]), (LAS unsigned*)(lds + (bufoff) + ldsw + _i * 8192), 16, 0, 0); } while (0)
#define PG8_STAGE_A(bufoff, h, nextu, kb) do { if constexpr (P::GATHER) { \
            _Pragma("unroll") for (int _i = 0; _i < 2; ++_i) { const unsigned _o = goffs[((((nextu) ? ui + 1 : ui) & 1) * 4 + (h) * 2 + _i) * 512 + tid]; \
                __builtin_amdgcn_global_load_lds((const unsigned*)(gA + (kb) + _o), (LAS unsigned*)(lds + (bufoff) + ldsw + _i * 8192), 16, 0, 0); } } \
        else { const char* _b = ((nextu) ? nA : cA) + (h) * hstep + (kb); PG8_STAGE(bufoff, _b, voffA); } } while (0)
#define PG8_LDA(dst, b, h) do { _Pragma("unroll") for (int m = 0; m < 4; ++m) _Pragma("unroll") for (int k = 0; k < 2; ++k) dst[m][k] = *(const LAS bf16x8*)(lds + PG8_SA(b, h) + aoff + m * 2048 + k * 1024); } while (0)
#define PG8_LDB(dst, b, h) do { _Pragma("unroll") for (int n = 0; n < 2; ++n) _Pragma("unroll") for (int k = 0; k < 2; ++k) dst[n][k] = *(const LAS bf16x8*)(lds + PG8_SB(b, h) + boff + n * 2048 + k * 1024); } while (0)
#define PG8_MMA(ai, bj, At, Bt) do { __builtin_amdgcn_s_setprio(1); _Pragma("unroll") for (int m = 0; m < 4; ++m) _Pragma("unroll") for (int n = 0; n < 2; ++n) _Pragma("unroll") for (int k = 0; k < 2; ++k) \
        acc[ai][bj][m][n] = __builtin_amdgcn_mfma_f32_16x16x32_bf16(Bt[n][k], At[m][k], acc[ai][bj][m][n], 0, 0, 0); __builtin_amdgcn_s_setprio(0); } while (0)
#define PG8_WAIT_V(n) asm volatile("s_waitcnt vmcnt(" #n ")" ::: "memory")
#define PG8_WAIT_L(n) asm volatile("s_waitcnt lgkmcnt(" #n ")" ::: "memory")
#define PG8_BAR __builtin_amdgcn_s_barrier()
#define PG8_SCHED __builtin_amdgcn_sched_barrier(0)
    Unit cur, nxt; int ui = 0;
    if (!p.next(0, cur)) return;
    f32x4 acc[2][2][4][2];
#pragma unroll
    for (int a = 0; a < 2; ++a)
#pragma unroll
        for (int b = 0; b < 2; ++b)
#pragma unroll
            for (int m = 0; m < 4; ++m)
#pragma unroll
                for (int n = 0; n < 2; ++n) acc[a][b][m][n] = (f32x4){0.f, 0.f, 0.f, 0.f};
    bf16x8 At[4][2], B0[2][2], B1[2][2];
    const char* cA = p.a_base(cur); const char* cB = p.b_base(cur);
    const char* nA = cA; const char* gA = cA;
    if constexpr (P::GATHER) { p.rows(cur, tid, goffs); p.rows(cur, tid, goffs + 4 * 512); }
    PG8_STAGE(PG8_SB(0, 0), cB, voffB); PG8_STAGE(PG8_SB(0, 1), cB + hstep, voffB); PG8_STAGE_A(PG8_SA(0, 0), 0, false, 0); PG8_STAGE_A(PG8_SA(0, 1), 1, false, 0);
    if (wr == 1) PG8_BAR;
    PG8_WAIT_V(2); PG8_BAR;
    PG8_STAGE(PG8_SB(1, 0), cB + kstep, voffB); PG8_STAGE_A(PG8_SA(1, 0), 0, false, kstep); PG8_STAGE(PG8_SB(1, 1), cB + hstep + kstep, voffB);
    PG8_WAIT_V(6); PG8_BAR;
    for (;;) {
        const bool has_next = p.next(ui + 1, nxt);
        nA = has_next ? p.a_base(nxt) : cA; const char* nB = has_next ? p.b_base(nxt) : cB;
        if constexpr (P::GATHER) { p.rows(has_next ? nxt : cur, tid, goffs + ((ui + 1) & 1) * 4 * 512); }
        for (int t = 0; t < nt; t += 2) {
            const bool last = (t == nt - 2);
            const size_t k1 = (size_t)(t + 1) * kstep;
            const size_t k2 = last ? 0 : (size_t)(t + 2) * kstep;
            const char* b2 = last ? nB : cB + (size_t)(t + 2) * kstep;
            const size_t k3 = k2 + kstep; const char* b3 = b2 + kstep;
            PG8_LDB(B0, 0, 0); PG8_LDB(B1, 0, 1); PG8_SCHED; PG8_LDA(At, 0, 0); PG8_STAGE_A(PG8_SA(1, 1), 1, false, k1);
            PG8_WAIT_V(8); PG8_WAIT_L(0); PG8_BAR; PG8_MMA(0, 0, At, B0); PG8_MMA(0, 1, At, B1); PG8_BAR; PG8_SCHED;
            PG8_LDA(At, 0, 1); PG8_STAGE(PG8_SB(0, 0), b2, voffB); PG8_STAGE(PG8_SB(0, 1), b2 + hstep, voffB); PG8_STAGE_A(PG8_SA(0, 0), 0, last, k2);
            PG8_WAIT_V(8); PG8_WAIT_L(0); PG8_BAR; PG8_MMA(1, 0, At, B0); PG8_MMA(1, 1, At, B1); PG8_BAR; PG8_SCHED;
            PG8_LDB(B0, 1, 0); PG8_LDB(B1, 1, 1); PG8_SCHED; PG8_LDA(At, 1, 0); PG8_STAGE_A(PG8_SA(0, 1), 1, last, k2);
            PG8_WAIT_V(8); PG8_WAIT_L(0); PG8_BAR; PG8_MMA(0, 0, At, B0); PG8_MMA(0, 1, At, B1); PG8_BAR; PG8_SCHED;
            PG8_LDA(At, 1, 1); PG8_STAGE(PG8_SB(1, 0), b3, voffB); PG8_STAGE(PG8_SB(1, 1), b3 + hstep, voffB); PG8_STAGE_A(PG8_SA(1, 0), 0, last, k3);
            PG8_WAIT_V(8); PG8_WAIT_L(0); PG8_BAR; PG8_MMA(1, 0, At, B0); PG8_MMA(1, 1, At, B1); PG8_BAR; PG8_SCHED;
        }
        if (wr == 0) PG8_BAR;
        p.epi(acc, cur, wr, wc, fr, fq);
        if (!has_next) break;
#pragma unroll
        for (int a = 0; a < 2; ++a)
#pragma unroll
            for (int b = 0; b < 2; ++b)
#pragma unroll
                for (int m = 0; m < 4; ++m)
#pragma unroll
                    for (int n = 0; n < 2; ++n) acc[a][b][m][n] = (f32x4){0.f, 0.f, 0.f, 0.f};
        cur = nxt; cA = nA; cB = nB; ++ui;
        if (wr == 1) PG8_BAR;
    }
    PG8_WAIT_V(0);
    PG8_BAR;
#undef PG8_SA
#undef PG8_SB
#undef PG8_STAGE
#undef PG8_STAGE_A
#undef PG8_LDA
#undef PG8_LDB
#undef PG8_MMA
#undef PG8_WAIT_V
#undef PG8_WAIT_L
#undef PG8_BAR
#undef PG8_SCHED
}
}

struct KArgs { const float* in[25]; float* out; unsigned char* ws; int ph_lo, ph_hi, li, pad; };
typedef const KArgs __attribute__((address_space(4))) CKArgs;
struct Frame {
    LAS unsigned char* lds;
    int tid, lane, wave, G, bid;
    CKArgs* ka;
    unsigned char* ws;
};
#define FIN(i) (F.ka->in[i])
#define FOUT (F.ka->out)
enum { I_X = 0, I_C, I_CTX, I_CCTX, I_WMOD, I_BMOD, I_GPREMIX, I_GPOSTMIX, I_GPREFFN, I_GPOSTFFN, I_WIN, I_CONVW, I_CONVB, I_RPB, I_GCONV, I_GATTN, I_WOUT, I_WROUTER, I_RBIAS,
       I_WEG, I_WEU, I_WED, I_WSG, I_WSU, I_WSD };

template <class RowMap>
__device__ __forceinline__ void transpose_item(const float* W, int ldn, int K, bf16* WT, LAS float* scr, int kb, int nb, int lane, const RowMap& rm) {
    const int k0 = 64 * kb, n0 = 32 * nb;
#pragma unroll 8
    for (int i = 0; i < 32; ++i) { const int kk = 2 * i + (lane >> 5); scr[kk * 33 + (lane & 31)] = W[(size_t)(k0 + kk) * ldn + n0 + (lane & 31)]; }
    LDS_WAIT(); asm volatile("" ::: "memory");
    const int c = lane & 7;
#pragma unroll
    for (int j = 0; j < 4; ++j) { const int n = (lane >> 3) + 8 * j; const LAS float* s = scr + (8 * c) * 33 + n;
        v4u o; o.x = cvt_pk_bf16(s[0 * 33], s[1 * 33]); o.y = cvt_pk_bf16(s[2 * 33], s[3 * 33]); o.z = cvt_pk_bf16(s[4 * 33], s[5 * 33]); o.w = cvt_pk_bf16(s[6 * 33], s[7 * 33]);
        *(GAS v4u*)(WT + (size_t)rm(n0 + n) * K + k0 + 8 * c) = o; }
    LDS_WAIT(); asm volatile("" ::: "memory");
}
struct RmIdent { int off; __device__ __forceinline__ int operator()(int n) const { return off + n; } };
struct RmWin {
    __device__ __forceinline__ int operator()(int n) const {
        if (n < QOFF || n >= VOFF) return n;
        const int nn = n & 127, axis = nn >> 6, half = (nn >> 5) & 1, f = nn & 31;
        return (n - nn) + 2 * (axis * 32 + f) + half; }
};
struct RmGU { int base; int up; __device__ __forceinline__ int operator()(int f) const { return base + 32 * (f >> 4) + 16 * up + (f & 15); } };

__device__ __forceinline__ void p0_prologue(Frame& F) {
    const int gw = F.bid * NWAVES + F.wave, NGW = F.G * NWAVES;
    if (F.bid == 0) {
        GAS f32x2* rope = (GAS f32x2*)(F.ws + WS_ROPE);
        for (int i = F.tid; i < 64 * 32; i += NTHR) { const int pos = i >> 5, f = i & 31;
            const float inv = powf(10000.0f, -(float)f / 32.0f); const float ang = (float)pos * inv;
            rope[i] = (f32x2){(float)cos((double)ang), (float)sin((double)ang)}; }
    }
    {
        LAS float* act = (LAS float*)F.lds;
        LAS float* red = (LAS float*)(F.lds + 9 * 2048 * 4);
        for (int i = F.tid; i < 9 * 2048; i += NTHR) { const int r = i >> 11, k = i & 2047; const float v = r < 8 ? FIN(I_C)[r * 2048 + k] : FIN(I_CCTX)[k]; act[i] = silu_f(v); }
        __syncthreads();
        const float* wm = FIN(I_WMOD);
        for (int cb = F.bid; cb < 256; cb += F.G) {
            const int kq = F.wave * 5 + F.lane / 12, cq = F.lane % 12; const bool on = F.lane < 60;
            f32x4 a[9];
#pragma unroll
            for (int r = 0; r < 9; ++r) a[r] = (f32x4){0.f, 0.f, 0.f, 0.f};
            if (on) for (int k = kq; k < 2048; k += 40) { const f32x4 w = *(const GAS f32x4*)(wm + (size_t)k * 12288 + cb * 48 + cq * 4);
#pragma unroll
                for (int r = 0; r < 9; ++r) a[r] += w * act[r * 2048 + k]; }
#pragma unroll
            for (int r = 0; r < 9; ++r) {
                f32x4 s = a[r];
#pragma unroll
                for (int j = 1; j < 5; ++j) { const int src = (F.lane % 12) + 12 * j; f32x4 o; o.x = __shfl(a[r].x, src); o.y = __shfl(a[r].y, src); o.z = __shfl(a[r].z, src); o.w = __shfl(a[r].w, src); s += o; }
                if (F.lane < 12) *(LAS f32x4*)(red + (F.wave * 9 + r) * 48 + F.lane * 4) = s;
            }
            __syncthreads();
            if (F.tid < 9 * 48) { const int r = F.tid / 48, cc = F.tid % 48; float s = 0.f;
#pragma unroll
                for (int w = 0; w < 8; ++w) s += red[(w * 9 + r) * 48 + cc];
                ((GAS float*)(F.ws + WS_MOD))[r * 12288 + cb * 48 + cc] = s + FIN(I_BMOD)[cb * 48 + cc]; }
            __syncthreads();
        }
    }
    {
        LAS float* scr = (LAS float*)(F.lds + F.wave * 16384);
        bf16* Win = (bf16*)(F.ws + WS_WIN); bf16* Wout = (bf16*)(F.ws + WS_WOUT); bf16* Wgu = (bf16*)(F.ws + WS_WGU); bf16* Wdn = (bf16*)(F.ws + WS_WDN);
        constexpr int IT_IN = 32 * 192, IT_OUT = 32 * 64, IT_G = 64 * 32 * 16, IT_D = 64 * 8 * 64, IT_SG = 32 * 16, IT_SD = 8 * 64, IT_R = 32 * 2;
        constexpr int NIT = IT_IN + IT_OUT + 2 * IT_G + IT_D + 2 * IT_SG + IT_SD + IT_R;
        for (int it = gw; it < NIT; it += NGW) {
            int r = it;
            if (r < IT_IN) { transpose_item(FIN(I_WIN), NPROJ, DM, Win, scr, r / 192, r % 192, F.lane, RmWin{}); continue; } r -= IT_IN;
            if (r < IT_OUT) { transpose_item(FIN(I_WOUT), DM, DM, Wout, scr, r / 64, r % 64, F.lane, RmIdent{0}); continue; } r -= IT_OUT;
            if (r < IT_G) { const int e = r / 512, q = r % 512; transpose_item(FIN(I_WEG) + (size_t)e * DM * FE, FE, DM, Wgu, scr, q / 16, q % 16, F.lane, RmGU{e * 1024, 0}); continue; } r -= IT_G;
            if (r < IT_G) { const int e = r / 512, q = r % 512; transpose_item(FIN(I_WEU) + (size_t)e * DM * FE, FE, DM, Wgu, scr, q / 16, q % 16, F.lane, RmGU{e * 1024, 1}); continue; } r -= IT_G;
            if (r < IT_D) { const int e = r / 512, q = r % 512; transpose_item(FIN(I_WED) + (size_t)e * FE * DM, DM, FE, Wdn, scr, q / 64, q % 64, F.lane, RmIdent{e * 2048}); continue; } r -= IT_D;
            if (r < IT_SG) { transpose_item(FIN(I_WSG), FE, DM, Wgu, scr, r / 16, r % 16, F.lane, RmGU{64 * 1024, 0}); continue; } r -= IT_SG;
            if (r < IT_SG) { transpose_item(FIN(I_WSU), FE, DM, Wgu, scr, r / 16, r % 16, F.lane, RmGU{64 * 1024, 1}); continue; } r -= IT_SG;
            if (r < IT_SD) { transpose_item(FIN(I_WSD), DM, FE, Wdn, scr, r / 64, r % 64, F.lane, RmIdent{64 * 2048}); continue; } r -= IT_SD;
            {
                const int kb = r / 2, nb = r % 2; const float* W = FIN(I_WROUTER);
                bf16* WH = (bf16*)(F.ws + WS_WRH); bf16* WL = (bf16*)(F.ws + WS_WRL);
                for (int i = 0; i < 32; ++i) { const int kk = 2 * i + (F.lane >> 5), n = nb * 32 + (F.lane & 31), k = kb * 64 + kk;
                    const float v = W[(size_t)k * NE + n]; const unsigned hi = cvt_pk_bf16(v, 0.f) & 0xffffu; const float rem = v - bf_lo(hi);
                    WH[(size_t)n * DM + k] = (bf16)hi; WL[(size_t)n * DM + k] = (bf16)(cvt_pk_bf16(rem, 0.f) & 0xffffu); }
            }
        }
    }
}

__device__ __forceinline__ void p1_norm(Frame& F) {
    const int gw = F.bid * NWAVES + F.wave, NGW = F.G * NWAVES;
    const float* MOD = (const float*)(F.ws + WS_MOD); const float* g = FIN(I_GPREMIX);
    for (int row = gw; row < T + TC; row += NGW) {
        const bool lat = row < T; const int rr = lat ? row : row - T;
        const float* xr = (lat ? FIN(I_X) : FIN(I_CTX)) + (size_t)rr * DM;
        const float* md = MOD + (size_t)(lat ? (rr >> 11) : 8) * 12288;
        bf16* orow = (bf16*)(F.ws + (lat ? WS_HL : WS_HC)) + (size_t)rr * DM;
        f32x4 v[8]; float ss = 0.f;
#pragma unroll
        for (int j = 0; j < 8; ++j) { v[j] = *(const GAS f32x4*)(xr + 4 * F.lane + 256 * j); ss += (v[j].x * v[j].x + v[j].y * v[j].y) + (v[j].z * v[j].z + v[j].w * v[j].w); }
        const float rstd = 1.0f / sqrtf(wave_sum(ss) * (1.0f / DM) + EPS);
#pragma unroll
        for (int j = 0; j < 8; ++j) { const int c = 4 * F.lane + 256 * j;
            const f32x4 gg = *(const GAS f32x4*)(g + c), sh = *(const GAS f32x4*)(md + c), sc = *(const GAS f32x4*)(md + 2048 + c);
            const f32x4 o = (v[j] * rstd) * gg * (sc + 1.0f) + sh;
            *(GAS v2u*)(orow + c) = (v2u){cvt_pk_bf16(o.x, o.y), cvt_pk_bf16(o.z, o.w)}; }
    }
}

struct ProbProj {
    static constexpr int K = DM; static constexpr bool GATHER = false, PERM = true;
    const bf16 *HL, *HC, *Win; bf16 *PROJ, *KVC; const f32x2* rope; int G, c;
    static constexpr int NMAIN = 64 * 24, NTOT = NMAIN + 64;
    __device__ __forceinline__ bool next(int i, pg8::Unit& u) const {
        const int w = pg8::round_unit(i, G, c, NTOT); if (w < 0) return false;
        if (w < NMAIN) { const int gid = w / 192, r = w % 192; u.pm = gid * 8 + (r & 7); u.pn = r >> 3; u.g = 0; }
        else { const int j = w - NMAIN; u.pm = j & 7; u.pn = 16 + (j >> 3); u.g = 1; }
        return true; }
    __device__ __forceinline__ const char* a_base(const pg8::Unit& u) const { return (const char*)HL + (size_t)u.g * (size_t)(WS_HC - WS_HL) + (size_t)u.pm * 256 * K * 2; }
    __device__ __forceinline__ const char* b_base(const pg8::Unit& u) const { return (const char*)Win + (size_t)u.pn * 256 * K * 2; }
    __device__ __forceinline__ void rows(const pg8::Unit&, int, LAS unsigned*) const {}
    __device__ __forceinline__ void epi(const f32x4 (&acc)[2][2][4][2], const pg8::Unit& u, int wr, int wc, int fr, int fq) const {
        const int row0 = u.pm * 256 + wr * 64 + fr;
        const bool rot = (u.g == 0) && (u.pn >= 12) && (u.pn < 20);
        bf16* base = (bf16*)((char*)PROJ + (long)u.g * ((long)WS_KVC - (long)WS_PROJ));
        const int ldc = NPROJ - u.g * (NPROJ - DM), col0 = (u.pn - 16 * u.g) * 256 + wc * 32 + 8 * fq;
        const int p0 = (wc * 32 + 8 * fq) >> 1, axis = p0 >> 5, f0 = p0 & 31;
#pragma unroll
        for (int ai = 0; ai < 2; ++ai)
#pragma unroll
            for (int m = 0; m < 4; ++m) {
                const int row = row0 + ai * 128 + m * 16; bf16* rowp = base + (size_t)row * ldc + col0;
                const int t = row & (SEQ - 1); const int pos = axis ? (t & 63) : (t >> 6);
                const f32x4 csA = *(const GAS f32x4*)(rope + pos * 32 + f0), csB = *(const GAS f32x4*)(rope + pos * 32 + f0 + 2);
                const f32x2 cs0 = (f32x2){csA.x, csA.y}, cs1 = (f32x2){csA.z, csA.w}, cs2 = (f32x2){csB.x, csB.y}, cs3 = (f32x2){csB.z, csB.w};
#pragma unroll
                for (int bj = 0; bj < 2; ++bj) { f32x4 v0 = acc[ai][bj][m][0], v1 = acc[ai][bj][m][1];
                    if (rot) { f32x4 r0, r1;
                        r0.x = v0.x * cs0.x - v0.y * cs0.y; r0.y = v0.y * cs0.x + v0.x * cs0.y;
                        r0.z = v0.z * cs1.x - v0.w * cs1.y; r0.w = v0.w * cs1.x + v0.z * cs1.y;
                        r1.x = v1.x * cs2.x - v1.y * cs2.y; r1.y = v1.y * cs2.x + v1.x * cs2.y;
                        r1.z = v1.z * cs3.x - v1.w * cs3.y; r1.w = v1.w * cs3.x + v1.z * cs3.y; v0 = r0; v1 = r1; }
                    v4u w; w.x = cvt_pk_bf16(v0.x, v0.y); w.y = cvt_pk_bf16(v0.z, v0.w); w.z = cvt_pk_bf16(v1.x, v1.y); w.w = cvt_pk_bf16(v1.z, v1.w);
                    *(GAS v4u*)(rowp + bj * 128) = w; } }
    }
};

__device__ __forceinline__ float dot2bf(unsigned a, unsigned b, float c) { return __builtin_amdgcn_fdot2_f32_bf16(__builtin_bit_cast(v2bf, a), __builtin_bit_cast(v2bf, b), c, false); }
__device__ __forceinline__ void p3_attn_simple(Frame& F) {
    const bf16* PROJ = (const bf16*)(F.ws + WS_PROJ); const bf16* KVC = (const bf16*)(F.ws + WS_KVC); bf16* Y = (bf16*)(F.ws + WS_Y);
    const float* rpb = FIN(I_RPB); const float* gat = FIN(I_GATTN);
    const float scale = 0.08838834764831845f;
    const int per = (T * NH) / F.G;
    for (int i = F.wave; i < per; i += NWAVES) {
        const int task = F.bid * per + i; const int t = task & (SEQ - 1), bh = task >> 11, h = bh & 7, b = bh >> 3;
        const int r = t >> 6, c = t & 63; int r0 = r - 4; r0 = r0 < 0 ? 0 : (r0 > 24 ? 24 : r0); int cs = c - 8; cs = cs < 0 ? 0 : (cs > 48 ? 48 : cs);
        const unsigned qv = *(const GAS unsigned*)(PROJ + (size_t)(b * SEQ + t) * NPROJ + QOFF + h * HD + 2 * F.lane);
        const bf16* kp[6]; float sc[6];
#pragma unroll
        for (int j = 0; j < 6; ++j) { const int n = F.lane + 64 * j;
            if (j < 2) { const int ii = n >> 4, jj = n & 15; const int tk = (r0 + ii) * GW + cs + jj; kp[j] = PROJ + (size_t)(b * SEQ + tk) * NPROJ + KOFF + h * HD; }
            else kp[j] = KVC + (size_t)(b * LC + (n - 128)) * DM + h * HD;
            sc[j] = 0.f; }
#pragma unroll 4
        for (int pc = 0; pc < 16; ++pc) {
            v4u kk[6];
#pragma unroll
            for (int j = 0; j < 6; ++j) kk[j] = *(const GAS v4u*)(kp[j] + 8 * pc);
            const unsigned q0 = __builtin_amdgcn_readlane(qv, 4 * pc), q1 = __builtin_amdgcn_readlane(qv, 4 * pc + 1), q2 = __builtin_amdgcn_readlane(qv, 4 * pc + 2), q3 = __builtin_amdgcn_readlane(qv, 4 * pc + 3);
#pragma unroll
            for (int j = 0; j < 6; ++j) { sc[j] = dot2bf(q0, kk[j].x, sc[j]); sc[j] = dot2bf(q1, kk[j].y, sc[j]); sc[j] = dot2bf(q2, kk[j].z, sc[j]); sc[j] = dot2bf(q3, kk[j].w, sc[j]); }
        }
        float mx = -1e30f;
#pragma unroll
        for (int j = 0; j < 6; ++j) { sc[j] *= scale;
            if (j < 2) { const int n = F.lane + 64 * j, ii = n >> 4, jj = n & 15; sc[j] += rpb[(h * 15 + (r0 + ii - r + 7)) * 31 + (cs + jj - c + 15)]; }
            mx = fmaxf(mx, sc[j]); }
        mx = wave_max(mx);
        float ps = 0.f;
#pragma unroll
        for (int j = 0; j < 6; ++j) { sc[j] = __expf(sc[j] - mx); ps += sc[j]; }
        ps = wave_sum(ps);
        float o0 = 0.f, o1 = 0.f;
        const bf16* vl = PROJ + (size_t)(b * SEQ) * NPROJ + VOFF + h * HD + 2 * F.lane;
        const bf16* vc = KVC + (size_t)(b * LC) * DM + DC + h * HD + 2 * F.lane;
#pragma unroll
        for (int j = 0; j < 6; ++j) {
#pragma unroll 8
            for (int l = 0; l < 64; ++l) { const int n = l + 64 * j; const float p = __builtin_bit_cast(float, __builtin_amdgcn_readlane(__builtin_bit_cast(unsigned, sc[j]), l));
                unsigned vv;
                if (j < 2) { const int tk = (r0 + (n >> 4)) * GW + cs + (n & 15); vv = *(const GAS unsigned*)(vl + (size_t)tk * NPROJ); }
                else vv = *(const GAS unsigned*)(vc + (size_t)(n - 128) * DM);
                o0 += p * bf_lo(vv); o1 += p * bf_hi(vv); }
        }
        const float inv = 1.0f / ps; o0 *= inv; o1 *= inv;
        const float rstd = 1.0f / sqrtf(wave_sum(o0 * o0 + o1 * o1) * (1.0f / HD) + EPS);
        const f32x2 gg = *(const GAS f32x2*)(gat + h * HD + 2 * F.lane);
        *(GAS unsigned*)(Y + (size_t)(b * SEQ + t) * DM + DC + h * HD + 2 * F.lane) = cvt_pk_bf16(o0 * rstd * gg.x, o1 * rstd * gg.y);
    }
}
__device__ __forceinline__ void p3_conv(Frame& F) {
    const bf16* PROJ = (const bf16*)(F.ws + WS_PROJ); bf16* Y = (bf16*)(F.ws + WS_Y);
    const float* cw = FIN(I_CONVW); const float* cb = FIN(I_CONVB); const float* gc = FIN(I_GCONV);
    const int gw = F.bid * NWAVES + F.wave, NGW = F.G * NWAVES;
    const int ch0 = 16 * F.lane;
    for (int row = gw; row < T; row += NGW) {
        const int t = row & (SEQ - 1);
        const bf16* pr = PROJ + (size_t)row * NPROJ + ch0;
        float pm[16], p0[16], pp[16], ub[16];
#pragma unroll
        for (int hh = 0; hh < 2; ++hh) {
            const v4u vb = *(const GAS v4u*)(pr + 8 * hh), vc0 = *(const GAS v4u*)(pr + 1024 + 8 * hh), vx0 = *(const GAS v4u*)(pr + 2048 + 8 * hh);
            v4u vcm = (v4u){0, 0, 0, 0}, vxm = vcm, vcp = vcm, vxp = vcm;
            if (t > 0) { vcm = *(const GAS v4u*)(pr - NPROJ + 1024 + 8 * hh); vxm = *(const GAS v4u*)(pr - NPROJ + 2048 + 8 * hh); }
            if (t < SEQ - 1) { vcp = *(const GAS v4u*)(pr + NPROJ + 1024 + 8 * hh); vxp = *(const GAS v4u*)(pr + NPROJ + 2048 + 8 * hh); }
#pragma unroll
            for (int q = 0; q < 4; ++q) { const int e = 8 * hh + 2 * q;
                ub[e] = bf_lo(vb[q]); ub[e + 1] = bf_hi(vb[q]);
                p0[e] = bf_lo(vc0[q]) * bf_lo(vx0[q]); p0[e + 1] = bf_hi(vc0[q]) * bf_hi(vx0[q]);
                pm[e] = bf_lo(vcm[q]) * bf_lo(vxm[q]); pm[e + 1] = bf_hi(vcm[q]) * bf_hi(vxm[q]);
                pp[e] = bf_lo(vcp[q]) * bf_lo(vxp[q]); pp[e + 1] = bf_hi(vcp[q]) * bf_hi(vxp[q]); }
        }
        float o[16]; float ss = 0.f;
#pragma unroll
        for (int q = 0; q < 4; ++q) { const f32x4 w0 = *(const GAS f32x4*)(cw + ch0 + 4 * q), w1 = *(const GAS f32x4*)(cw + 1024 + ch0 + 4 * q), w2 = *(const GAS f32x4*)(cw + 2048 + ch0 + 4 * q), bb = *(const GAS f32x4*)(cb + ch0 + 4 * q);
#pragma unroll
            for (int e = 0; e < 4; ++e) { const int k = 4 * q + e; const float cv = pm[k] * w0[e] + p0[k] * w1[e] + pp[k] * w2[e] + bb[e]; o[k] = ub[k] * cv; ss += o[k] * o[k]; } }
        ss += __shfl_xor(ss, 1); ss += __shfl_xor(ss, 2); ss += __shfl_xor(ss, 4);
        const float rstd = 1.0f / sqrtf(ss * (1.0f / 128.0f) + EPS);
        unsigned w[8];
#pragma unroll
        for (int q = 0; q < 4; ++q) { const f32x4 gg = *(const GAS f32x4*)(gc + ch0 + 4 * q);
            w[2 * q] = cvt_pk_bf16(o[4 * q] * rstd * gg[0], o[4 * q + 1] * rstd * gg[1]); w[2 * q + 1] = cvt_pk_bf16(o[4 * q + 2] * rstd * gg[2], o[4 * q + 3] * rstd * gg[3]); }
        *(GAS v4u*)(Y + (size_t)row * DM + ch0) = (v4u){w[0], w[1], w[2], w[3]};
        *(GAS v4u*)(Y + (size_t)row * DM + ch0 + 8) = (v4u){w[4], w[5], w[6], w[7]};
    }
}

struct ProbOut {
    static constexpr int K = DM; static constexpr bool GATHER = false, PERM = true;
    const bf16 *Y, *Wout; bf16* YL; float* SSQ; int G, c;
    __device__ __forceinline__ bool next(int i, pg8::Unit& u) const {
        const int w = pg8::round_unit(i, G, c, 512); if (w < 0) return false;
        u.pm = (w >> 6) * 8 + (w & 7); u.pn = (w & 63) >> 3; u.g = 0; return true; }
    __device__ __forceinline__ const char* a_base(const pg8::Unit& u) const { return (const char*)Y + (size_t)u.pm * 256 * K * 2; }
    __device__ __forceinline__ const char* b_base(const pg8::Unit& u) const { return (const char*)Wout + (size_t)u.pn * 256 * K * 2; }
    __device__ __forceinline__ void rows(const pg8::Unit&, int, LAS unsigned*) const {}
    __device__ __forceinline__ void epi(const f32x4 (&acc)[2][2][4][2], const pg8::Unit& u, int wr, int wc, int fr, int fq) const {
        const int row0 = u.pm * 256 + wr * 64 + fr, col0 = u.pn * 256 + wc * 32 + 8 * fq;
#pragma unroll
        for (int ai = 0; ai < 2; ++ai)
#pragma unroll
            for (int m = 0; m < 4; ++m) { const int row = row0 + ai * 128 + m * 16; bf16* rowp = YL + (size_t)row * DM + col0; float ss = 0.f;
#pragma unroll
                for (int bj = 0; bj < 2; ++bj) { const f32x4 v0 = acc[ai][bj][m][0], v1 = acc[ai][bj][m][1];
                    ss += (v0.x * v0.x + v0.y * v0.y) + (v0.z * v0.z + v0.w * v0.w) + (v1.x * v1.x + v1.y * v1.y) + (v1.z * v1.z + v1.w * v1.w);
                    v4u w; w.x = cvt_pk_bf16(v0.x, v0.y); w.y = cvt_pk_bf16(v0.z, v0.w); w.z = cvt_pk_bf16(v1.x, v1.y); w.w = cvt_pk_bf16(v1.z, v1.w);
                    *(GAS v4u*)(rowp + bj * 128) = w; }
                ss += __shfl_xor(ss, 16); ss += __shfl_xor(ss, 32);
                if (fq == 0) SSQ[(size_t)row * 32 + u.pn * 4 + wc] = ss; }
    }
};

__device__ __forceinline__ void p5_route(Frame& F) {
    const float* MOD = (const float*)(F.ws + WS_MOD);
    const bf16* YL = (const bf16*)(F.ws + WS_YL); const float* SSQ = (const float*)(F.ws + WS_SSQ);
    bf16* H2 = (bf16*)(F.ws + WS_HL); bf16* H2L = (bf16*)(F.ws + WS_H2LO);
    const bf16* WRH = (const bf16*)(F.ws + WS_WRH); const bf16* WRL = (const bf16*)(F.ws + WS_WRL);
    unsigned* gcnt = (unsigned*)(F.ws + WS_CTL) + CW_CNT;
    v2u* LIST = (v2u*)(F.ws + WS_LIST);
    LAS float* logit = (LAS float*)F.lds;
    LAS unsigned* lcnt = (LAS unsigned*)(F.lds + 16384);
    LAS unsigned* lbase = (LAS unsigned*)(F.lds + 16384 + 256);
    LAS unsigned* ent = (LAS unsigned*)(F.lds + 16384 + 512);
    for (int blk = F.bid; blk < T / 64; blk += F.G) {
        const int row0 = blk * 64;
        if (F.tid < 64) lcnt[F.tid] = 0u;
        for (int rr = F.wave; rr < 64; rr += NWAVES) {
            const int row = row0 + rr, b = row >> 11; const float* md = MOD + (size_t)b * 12288;
            const float* xr = FIN(I_X) + (size_t)row * DM; const bf16* yr = YL + (size_t)row * DM;
            float sq = F.lane < 32 ? SSQ[(size_t)row * 32 + F.lane] : 0.f; sq = wave_sum(sq);
            const float rstd1 = 1.0f / sqrtf(sq * (1.0f / DM) + EPS);
            f32x4 v[8]; float ss = 0.f;
#pragma unroll
            for (int j = 0; j < 8; ++j) { const int c = 4 * F.lane + 256 * j;
                const f32x4 xv = *(const GAS f32x4*)(xr + c); const v2u yv = *(const GAS v2u*)(yr + c);
                const f32x4 gp = *(const GAS f32x4*)(FIN(I_GPOSTMIX) + c), gt = *(const GAS f32x4*)(md + 4096 + c);
                const f32x4 yl = (f32x4){bf_lo(yv.x), bf_hi(yv.x), bf_lo(yv.y), bf_hi(yv.y)};
                v[j] = xv + gt * (yl * rstd1 * gp);
                *(GAS f32x4*)(FOUT + (size_t)row * DM + c) = v[j];
                ss += (v[j].x * v[j].x + v[j].y * v[j].y) + (v[j].z * v[j].z + v[j].w * v[j].w); }
            const float rstd2 = 1.0f / sqrtf(wave_sum(ss) * (1.0f / DM) + EPS);
#pragma unroll
            for (int j = 0; j < 8; ++j) { const int c = 4 * F.lane + 256 * j;
                const f32x4 gg = *(const GAS f32x4*)(FIN(I_GPREFFN) + c), sh = *(const GAS f32x4*)(md + 6144 + c), sc = *(const GAS f32x4*)(md + 8192 + c);
                const f32x4 h = (v[j] * rstd2) * gg * (sc + 1.0f) + sh;
                const unsigned h0 = cvt_pk_bf16(h.x, h.y), h1 = cvt_pk_bf16(h.z, h.w);
                const unsigned l0 = cvt_pk_bf16(h.x - bf_lo(h0), h.y - bf_hi(h0)), l1 = cvt_pk_bf16(h.z - bf_lo(h1), h.w - bf_hi(h1));
                *(GAS v2u*)(H2 + (size_t)row * DM + c) = (v2u){h0, h1}; *(GAS v2u*)(H2L + (size_t)row * DM + c) = (v2u){l0, l1}; }
        }
        VM_WAIT(); __syncthreads();
        {
            const int rt = F.wave & 3, nh = F.wave >> 2, fr = F.lane & 15, fq = F.lane >> 4;
            const bf16* ah = H2 + (size_t)(row0 + rt * 16 + fr) * DM + 8 * fq; const bf16* al = H2L + (size_t)(row0 + rt * 16 + fr) * DM + 8 * fq;
            f32x4 acc[2] = {(f32x4){0.f, 0.f, 0.f, 0.f}, (f32x4){0.f, 0.f, 0.f, 0.f}};
#pragma unroll 2
            for (int s = 0; s < 64; ++s) {
                const bf16x8 a_h = *(const GAS bf16x8*)(ah + 32 * s), a_l = *(const GAS bf16x8*)(al + 32 * s);
#pragma unroll
                for (int n2 = 0; n2 < 2; ++n2) { const size_t eo = (size_t)(nh * 32 + n2 * 16 + fr) * DM + 32 * s + 8 * fq;
                    const bf16x8 b_h = *(const GAS bf16x8*)(WRH + eo), b_l = *(const GAS bf16x8*)(WRL + eo);
                    acc[n2] = __builtin_amdgcn_mfma_f32_16x16x32_bf16(a_l, b_h, acc[n2], 0, 0, 0);
                    acc[n2] = __builtin_amdgcn_mfma_f32_16x16x32_bf16(a_h, b_l, acc[n2], 0, 0, 0);
                    acc[n2] = __builtin_amdgcn_mfma_f32_16x16x32_bf16(a_h, b_h, acc[n2], 0, 0, 0); }
            }
#pragma unroll
            for (int n2 = 0; n2 < 2; ++n2)
#pragma unroll
                for (int r = 0; r < 4; ++r) logit[(rt * 16 + 4 * fq + r) * 64 + nh * 32 + n2 * 16 + fr] = acc[n2][r];
        }
        __syncthreads();
        for (int rr = F.wave; rr < 64; rr += NWAVES) {
            const int row = row0 + rr; const int e = F.lane;
            const float lg = logit[rr * 64 + e]; const float score = 1.0f / (1.0f + expf(-lg)); const float sel = score + FIN(I_RBIAS)[e];
            float m1 = sel; m1 = fmaxf(m1, __shfl_xor(m1, 1)); m1 = fmaxf(m1, __shfl_xor(m1, 2)); m1 = fmaxf(m1, __shfl_xor(m1, 4));
            int i1 = (sel == m1) ? e : 1000; i1 = min(i1, __shfl_xor(i1, 1)); i1 = min(i1, __shfl_xor(i1, 2)); i1 = min(i1, __shfl_xor(i1, 4));
            float s2 = (e == i1) ? -INFINITY : sel; s2 = fmaxf(s2, __shfl_xor(s2, 1)); s2 = fmaxf(s2, __shfl_xor(s2, 2)); s2 = fmaxf(s2, __shfl_xor(s2, 4));
            const float gs = m1 + s2; const int g = e >> 3; int grank = 0;
#pragma unroll
            for (int g2 = 0; g2 < 8; ++g2) { const float o = __builtin_bit_cast(float, __builtin_amdgcn_readlane(__builtin_bit_cast(unsigned, gs), 8 * g2)); grank += (o > gs || (o == gs && g2 < g)) ? 1 : 0; }
            const float ms = grank < 4 ? sel : -INFINITY; int rank = 0;
#pragma unroll 4
            for (int e2 = 0; e2 < 64; ++e2) { const float o = __builtin_bit_cast(float, __builtin_amdgcn_readlane(__builtin_bit_cast(unsigned, ms), e2)); rank += (o > ms || (o == ms && e2 < e)) ? 1 : 0; }
            const bool chosen = rank < 8;
            const float ssum = wave_sum(chosen ? score : 0.f);
            const float w = score / ssum * 2.5f;
            if (chosen) { const unsigned lp = __hip_atomic_fetch_add(lcnt + e, 1u, __ATOMIC_RELAXED, __HIP_MEMORY_SCOPE_WORKGROUP);
                LAS unsigned* en = ent + (rr * 8 + rank) * 4; en[0] = (unsigned)e; en[1] = lp; en[2] = (unsigned)row * 16u + (unsigned)rank; en[3] = __builtin_bit_cast(unsigned, w); }
            if (F.lane == 0) LIST[(size_t)64 * LIST_CAP + row] = (v2u){(unsigned)row * 16u + 8u, __builtin_bit_cast(unsigned, 1.0f)};
        }
        __syncthreads();
        if (F.tid < 64) lbase[F.tid] = __hip_atomic_fetch_add(gcnt + 64 * F.tid, lcnt[F.tid], RLX_AGENT);
        __syncthreads();
        { const LAS unsigned* en = ent + F.tid * 4; const unsigned e = en[0]; LIST[(size_t)e * LIST_CAP + lbase[e] + en[1]] = (v2u){en[2], en[3]}; }
        __syncthreads();
    }
}

struct TileTab { LAS int* cnt; LAS int* tstart; };
__device__ __forceinline__ TileTab build_tiles(Frame& F) {
    TileTab tt; tt.cnt = (LAS int*)(F.lds + MISC_OFF); tt.tstart = tt.cnt + 128;
    const unsigned* gcnt = (const unsigned*)(F.ws + WS_CTL) + CW_CNT;
    if (F.tid < 64) tt.cnt[F.tid] = (int)__hip_atomic_load(gcnt + 64 * F.tid, RLX_AGENT);
    if (F.tid == 64) tt.cnt[64] = T;
    __syncthreads();
    if (F.tid == 0) { int s = 0; for (int e = 0; e < 65; ++e) { tt.tstart[e] = s; s += (tt.cnt[e] + 255) >> 8; } tt.tstart[65] = s; }
    __syncthreads();
    return tt;
}
__device__ __forceinline__ int tile_expert(const TileTab& tt, int tile) { int e = 0; while (tt.tstart[e + 1] <= tile) ++e; return e; }

struct ProbGU {
    static constexpr int K = DM; static constexpr bool GATHER = true, PERM = false;
    const bf16 *H2, *Wgu; bf16* HID; const v2u* LIST; TileTab tt; int G, c;
    __device__ __forceinline__ bool next(int i, pg8::Unit& u) const {
        const int total = tt.tstart[65] * 4; const int w = pg8::round_unit(i, G, c, total); if (w < 0) return false;
        u.pm = w >> 2; u.pn = w & 3; u.g = tile_expert(tt, u.pm); return true; }
    __device__ __forceinline__ const char* a_base(const pg8::Unit&) const { return (const char*)H2; }
    __device__ __forceinline__ const char* b_base(const pg8::Unit& u) const { return (const char*)Wgu + ((size_t)u.g * 1024 + (size_t)u.pn * 256) * K * 2; }
    __device__ __forceinline__ void rows(const pg8::Unit& u, int tid, LAS unsigned* dst) const {
        const int lt = u.pm - tt.tstart[u.g]; const int nrow = tt.cnt[u.g] - lt * 256; const v2u* lp = LIST + (size_t)u.g * LIST_CAP + lt * 256;
#pragma unroll
        for (int i = 0; i < 2; ++i) { int R0, C; pg8::stage_rc(tid * 16 + i * 8192, R0, C);
#pragma unroll
            for (int h = 0; h < 2; ++h) { const int R = R0 + 128 * h; unsigned tok = 0u; if (R < nrow) tok = lp[R].x >> 4; dst[(h * 2 + i) * 512 + tid] = tok * (unsigned)(K * 2) + (unsigned)(C * 2); } }
    }
    __device__ __forceinline__ void epi(const f32x4 (&acc)[2][2][4][2], const pg8::Unit& u, int wr, int wc, int fr, int fq) const {
        const int lt = u.pm - tt.tstart[u.g]; const int nrow = tt.cnt[u.g] - lt * 256; const v2u* lp = LIST + (size_t)u.g * LIST_CAP + lt * 256;
#pragma unroll
        for (int ai = 0; ai < 2; ++ai)
#pragma unroll
            for (int m = 0; m < 4; ++m) { const int R = ai * 128 + wr * 64 + m * 16 + fr;
                float w = 0.f; if (R < nrow) { const unsigned wb = lp[R].y; w = u2f(wb); }
                bf16* rowp = HID + ((size_t)u.pm * 256 + R) * FE + u.pn * 128 + wc * 16 + 4 * fq;
#pragma unroll
                for (int bj = 0; bj < 2; ++bj) { const f32x4 g = acc[ai][bj][m][0], up = acc[ai][bj][m][1]; f32x4 hv;
#pragma unroll
                    for (int q = 0; q < 4; ++q) hv[q] = g[q] / (1.0f + __expf(-g[q])) * up[q] * w;
#ifdef DIAG
                    if (u.pm == 3 && u.pn == 0 && wr == 1 && ai == 1 && m == 2 && fr == 8 && fq == 0 && bj == 0) { unsigned st = 0x100u;
                        if (!(fabsf(g.x) > 1e-3f)) st |= 1u; if (!(fabsf(up.x) > 1e-3f)) st |= 2u; if (!(w > 0.f)) st |= 4u; if (!(nrow >= 1 && nrow <= 256)) st |= 8u;
                        __hip_atomic_store((unsigned*)((char*)LIST - WS_LIST) + 101, st, RLX_AGENT); }
#endif
                    *(GAS v2u*)(rowp + bj * 64) = (v2u){cvt_pk_bf16(hv.x, hv.y), cvt_pk_bf16(hv.z, hv.w)}; } }
    }
};
struct ProbDown {
    static constexpr int K = FE; static constexpr bool GATHER = false, PERM = true;
    const bf16 *HID, *Wdn; bf16* SLOT; const v2u* LIST; TileTab tt; int G, c;
    __device__ __forceinline__ bool next(int i, pg8::Unit& u) const {
        const int total = tt.tstart[65] * 8; const int w = pg8::round_unit(i, G, c, total); if (w < 0) return false;
        u.pm = w >> 3; u.pn = w & 7; u.g = tile_expert(tt, u.pm); return true; }
    __device__ __forceinline__ const char* a_base(const pg8::Unit& u) const { return (const char*)HID + (size_t)u.pm * 256 * K * 2; }
    __device__ __forceinline__ const char* b_base(const pg8::Unit& u) const { return (const char*)Wdn + ((size_t)u.g * 2048 + (size_t)u.pn * 256) * K * 2; }
    __device__ __forceinline__ void rows(const pg8::Unit&, int, LAS unsigned*) const {}
    __device__ __forceinline__ void epi(const f32x4 (&acc)[2][2][4][2], const pg8::Unit& u, int wr, int wc, int fr, int fq) const {
        const int lt = u.pm - tt.tstart[u.g]; const int nrow = tt.cnt[u.g] - lt * 256; const v2u* lp = LIST + (size_t)u.g * LIST_CAP + lt * 256;
        const int col0 = u.pn * 256 + wc * 32 + 8 * fq;
#pragma unroll
        for (int ai = 0; ai < 2; ++ai)
#pragma unroll
            for (int m = 0; m < 4; ++m) { const int R = ai * 128 + wr * 64 + m * 16 + fr;
                if (R < nrow) { const unsigned ts = lp[R].x; bf16* rowp = SLOT + ((size_t)(ts >> 4) * NSLOT + (ts & 15u)) * DM + col0;
#pragma unroll
                    for (int bj = 0; bj < 2; ++bj) { const f32x4 v0 = acc[ai][bj][m][0], v1 = acc[ai][bj][m][1];
                        v4u w; w.x = cvt_pk_bf16(v0.x, v0.y); w.y = cvt_pk_bf16(v0.z, v0.w); w.z = cvt_pk_bf16(v1.x, v1.y); w.w = cvt_pk_bf16(v1.z, v1.w);
                        *(GAS v4u*)(rowp + bj * 128) = w; } } }
    }
};

__device__ __forceinline__ void p8_final(Frame& F) {
    const int gw = F.bid * NWAVES + F.wave, NGW = F.G * NWAVES;
    const float* MOD = (const float*)(F.ws + WS_MOD); const bf16* SLOT = (const bf16*)(F.ws + WS_SLOT); const float* g = FIN(I_GPOSTFFN);
#ifdef DIAG
    float dscale = 1.0f;
    { const unsigned* ctl = (const unsigned*)(F.ws + WS_CTL); const bf16* HID = (const bf16*)(F.ws + WS_HID);
      const unsigned a = __hip_atomic_load(ctl + 102, RLX_AGENT), b = __hip_atomic_load(ctl + 103, RLX_AGENT);
      const float s2 = wave_sum(fabsf(bf_lo(HID[(size_t)1000 * 512 + F.lane])));
      int code = 0; if (a != 1u) code |= 1; if (a == 0u) code |= 2; if (b != 1u) code |= 4; if (!(s2 > 1e-6f)) code |= 8;
      dscale = 1.0f + 0.25f * (float)code; }
#endif
    for (int row = gw; row < T; row += NGW) {
        const float* md = MOD + (size_t)(row >> 11) * 12288;
        f32x4 v[8];
#pragma unroll
        for (int j = 0; j < 8; ++j) v[j] = (f32x4){0.f, 0.f, 0.f, 0.f};
#pragma unroll
        for (int s = 0; s < NSLOT; ++s) { const int ss = (s + 8) % 9;
            const bf16* sr = SLOT + ((size_t)row * NSLOT + ss) * DM;
#pragma unroll
            for (int j = 0; j < 8; ++j) { const v2u yv = *(const GAS v2u*)(sr + 4 * F.lane + 256 * j); v[j] += (f32x4){bf_lo(yv.x), bf_hi(yv.x), bf_lo(yv.y), bf_hi(yv.y)}; } }
        float ss = 0.f;
#pragma unroll
        for (int j = 0; j < 8; ++j) ss += (v[j].x * v[j].x + v[j].y * v[j].y) + (v[j].z * v[j].z + v[j].w * v[j].w);
        const float rstd = 1.0f / sqrtf(wave_sum(ss) * (1.0f / DM) + EPS);
#pragma unroll
        for (int j = 0; j < 8; ++j) { const int c = 4 * F.lane + 256 * j;
            const f32x4 gg = *(const GAS f32x4*)(g + c), gt = *(const GAS f32x4*)(md + 10240 + c);
            GAS f32x4* op = (GAS f32x4*)(FOUT + (size_t)row * DM + c);
#ifdef DIAG
            *op = *op * dscale;
#else
            *op = *op + gt * (v[j] * rstd * gg);
#endif
        }
    }
}

constexpr int N_PHASES = 9;
typedef KArgs Args;
__global__ void __launch_bounds__(NTHR, 2) fwd_kernel(Args args) {
    extern __shared__ __attribute__((aligned(16))) unsigned char lds_raw[];
    Frame F;
    F.lds = (LAS unsigned char*)lds_raw;
    F.tid = threadIdx.x; F.lane = F.tid & 63; F.wave = __builtin_amdgcn_readfirstlane(F.tid >> 6);
    F.G = gridDim.x; F.bid = blockIdx.x;
    F.ka = (CKArgs*)__builtin_amdgcn_kernarg_segment_ptr(); F.ws = args.ws;
#define LAUNDER() do { CKArgs* _p = (CKArgs*)__builtin_amdgcn_kernarg_segment_ptr(); asm volatile("" : "+s"(_p) :: "memory"); F.ka = _p; unsigned char* _w = _p->ws; F.ws = _w; } while (0)
    volatile LAS unsigned* barw = (volatile LAS unsigned*)(F.lds + BARW_OFF);
    if (F.tid < 16) barw[F.tid] = 0u;
    __syncthreads();
    XcdBarrier bar; bar.bar = (unsigned*)(F.ws + WS_CTL) + CW_BAR + args.li * XCD_BAR_WORDS; bar.x = 0; bar.st = nullptr;
    const int lo = args.ph_lo, hi = args.ph_hi;
    if (hi - lo > 1) bar = xcd_barrier_post((unsigned*)(F.ws + WS_CTL) + CW_BAR + args.li * XCD_BAR_WORDS, barw);
#ifndef PH_MASK
#define PH_MASK 0x1ff
#endif
#define IN(k) (((PH_MASK >> (k)) & 1) && lo <= (k) && (k) < hi)
#define SEAM(k) do { if (IN(k) && IN((k) + 1)) xcd_barrier(bar); } while (0)
    if (IN(0)) { LAUNDER(); p0_prologue(F); } SEAM(0);
    if (IN(1)) { LAUNDER(); p1_norm(F); } SEAM(1);
    if (IN(2)) { LAUNDER();
        ProbProj P; P.HL = (const bf16*)(F.ws + WS_HL); P.HC = (const bf16*)(F.ws + WS_HC); P.Win = (const bf16*)(F.ws + WS_WIN); P.PROJ = (bf16*)(F.ws + WS_PROJ); P.KVC = (bf16*)(F.ws + WS_KVC);
        P.rope = (const f32x2*)(F.ws + WS_ROPE); P.G = F.G; P.c = F.bid;
        pg8::gemm_phase<ProbProj>(F.lds, P);
    } SEAM(2);
    if (IN(3)) { LAUNDER(); p3_attn_simple(F); LAUNDER(); p3_conv(F); } SEAM(3);
    if (IN(4)) { LAUNDER();
        ProbOut P; P.Y = (const bf16*)(F.ws + WS_Y); P.Wout = (const bf16*)(F.ws + WS_WOUT); P.YL = (bf16*)(F.ws + WS_YL); P.SSQ = (float*)(F.ws + WS_SSQ); P.G = F.G; P.c = F.bid;
        pg8::gemm_phase<ProbOut>(F.lds, P);
    } SEAM(4);
    if (IN(5)) { LAUNDER(); p5_route(F); } SEAM(5);
    if (IN(6)) { LAUNDER();
#ifdef DIAG
        if (F.bid == 0 && F.wave == 0) { const bf16* Wgu = (const bf16*)(F.ws + WS_WGU); const bf16* H2 = (const bf16*)(F.ws + WS_HL);
            const float s0 = wave_sum(fabsf(bf_lo(Wgu[((size_t)5 * 1024 + 100) * 2048 + F.lane]))); const float s1 = wave_sum(fabsf(bf_lo(H2[(size_t)1000 * 2048 + F.lane])));
            unsigned st = 0; if (!(s0 > 1e-3f)) st |= 1u; if (!(s1 > 1e-3f)) st |= 2u;
            if (F.lane == 0) __hip_atomic_store((unsigned*)(F.ws + WS_CTL) + 100, st, RLX_AGENT); }
#endif
        ProbGU P; P.tt = build_tiles(F); P.H2 = (const bf16*)(F.ws + WS_HL); P.Wgu = (const bf16*)(F.ws + WS_WGU); P.HID = (bf16*)(F.ws + WS_HID); P.LIST = (const v2u*)(F.ws + WS_LIST); P.G = F.G; P.c = F.bid;
        pg8::gemm_phase<ProbGU>(F.lds, P);
#ifdef DIAG
        VM_WAIT(); __syncthreads();
        if (F.bid == 96 && F.wave == 0) { const bf16* HID = (const bf16*)(F.ws + WS_HID); const float s2 = wave_sum(fabsf(bf_lo(HID[(size_t)1000 * 512 + F.lane])));
            if (F.lane == 0) __hip_atomic_store((unsigned*)(F.ws + WS_CTL) + 102, (s2 > 1e-6f) ? 1u : 2u, RLX_AGENT); }
#endif
    } SEAM(6);
    if (IN(7)) { LAUNDER();
#ifdef DIAG
        if (F.bid == 0 && F.wave == 0) { const bf16* HID = (const bf16*)(F.ws + WS_HID); const float s2 = wave_sum(fabsf(bf_lo(HID[(size_t)1000 * 512 + F.lane])));
            if (F.lane == 0) __hip_atomic_store((unsigned*)(F.ws + WS_CTL) + 103, (s2 > 1e-6f) ? 1u : 2u, RLX_AGENT); }
#endif
        ProbDown P; P.tt = build_tiles(F); P.HID = (const bf16*)(F.ws + WS_HID); P.Wdn = (const bf16*)(F.ws + WS_WDN); P.SLOT = (bf16*)(F.ws + WS_SLOT); P.LIST = (const v2u*)(F.ws + WS_LIST); P.G = F.G; P.c = F.bid;
        pg8::gemm_phase<ProbDown>(F.lds, P);
    } SEAM(7);
    if (IN(8)) { LAUNDER(); p8_final(F); }
#undef IN
#undef SEAM
}

extern "C" void kernel_launch(void* const* d_in, const int* in_sizes, int n_in, void* d_out, int out_size, void* d_ws, size_t ws_size, hipStream_t stream) {
    static int grid = 0;
    if (grid == 0) {
        if (n_in != 25 || in_sizes[0] != T * DM || out_size != T * DM || ws_size < WS_END) { fprintf(stderr, "kernel_launch: shape/workspace mismatch (n_in %d, in0 %d, out %d, ws %zu < %zu)\n", n_in, n_in > 0 ? in_sizes[0] : -1, out_size, ws_size, (size_t)WS_END); grid = -1; return; }
        int dev = 0, cus = 0, per_cu = 0;
        if (hipGetDevice(&dev) != hipSuccess || hipDeviceGetAttribute(&cus, hipDeviceAttributeMultiprocessorCount, dev) != hipSuccess) { grid = -1; return; }
        if (hipFuncSetAttribute((const void*)fwd_kernel, hipFuncAttributeMaxDynamicSharedMemorySize, LDS_BYTES) != hipSuccess) { fprintf(stderr, "kernel_launch: hipFuncSetAttribute failed\n"); grid = -1; return; }
        if (hipOccupancyMaxActiveBlocksPerMultiprocessor(&per_cu, (const void*)fwd_kernel, NTHR, LDS_BYTES) != hipSuccess || per_cu < 1) fprintf(stderr, "kernel_launch: occupancy query says %d\n", per_cu);
        (void)hipGetLastError();
        grid = cus;
        if (grid != 256) fprintf(stderr, "kernel_launch: %d CUs (built for 256)\n", grid);
    }
    if (grid < 0) return;
    if (hipMemsetAsync((char*)d_ws + WS_CTL, 0, CTL_ZERO_BYTES, stream) != hipSuccess) return;
    Args a{};
    for (int i = 0; i < 25; ++i) a.in[i] = (const float*)d_in[i];
    a.out = (float*)d_out; a.ws = (unsigned char*)d_ws; a.pad = 0;
    if (MK_N_LAUNCHES == 1) {
        a.ph_lo = 0; a.ph_hi = N_PHASES; a.li = 0;
        hipLaunchKernelGGL(fwd_kernel, dim3(grid), dim3(NTHR), LDS_BYTES, stream, a);
    } else {
        for (int li = 0; li < N_PHASES; ++li) { a.ph_lo = li; a.ph_hi = li + 1; a.li = 0;
            hipLaunchKernelGGL(fwd_kernel, dim3(grid), dim3(NTHR), LDS_BYTES, stream, a); }
    }
    const hipError_t le = hipPeekAtLastError();
    if (le != hipSuccess) fprintf(stderr, "kernel_launch: launch failed: %s\n", hipGetErrorName(le));
}
```

```cpp
#include <hip/hip_runtime.h>
#include <cstdio>
#include <cstdint>


#ifndef MK_N_LAUNCHES
#define MK_N_LAUNCHES 1
#endif

#define GAS __attribute__((address_space(1)))
#define LAS __attribute__((address_space(3)))
typedef unsigned short bf16;
typedef unsigned v4u __attribute__((ext_vector_type(4)));
typedef unsigned v2u __attribute__((ext_vector_type(2)));
typedef float f32x4 __attribute__((ext_vector_type(4)));
typedef float f32x2 __attribute__((ext_vector_type(2)));
typedef short bf16x8 __attribute__((ext_vector_type(8)));
typedef __bf16 v2bf __attribute__((ext_vector_type(2)));

constexpr int NB = 8, SEQ = 2048, DM = 2048, T = NB * SEQ, LC = 256, TC = NB * LC;
constexpr int GW = 64, DC = 1024, NH = 8, HD = 128;
constexpr int NPROJ = 6144, QOFF = 3072, KOFF = 4096, VOFF = 5120;
constexpr int NE = 64, FE = 512, NSLOT = 9;
constexpr float EPS = 1e-6f;
constexpr int NWAVES = 8, NTHR = 512;
constexpr int LIST_CAP = 16384;
constexpr int MAX_TILES = 640;

constexpr size_t MiB = 1u << 20;
constexpr size_t WS_CTL = 0, CTL_ZERO_BYTES = 1 * MiB;
constexpr size_t WS_MOD = 1 * MiB;
constexpr size_t WS_ROPE = 1 * MiB + 512 * 1024;
constexpr size_t WS_SSQ = 2 * MiB;
constexpr size_t WS_LIST = 4 * MiB;
constexpr size_t WS_WRH = 13 * MiB, WS_WRL = 13 * MiB + 256 * 1024;
constexpr size_t WS_WDN = 14 * MiB;
constexpr size_t WS_YL = 144 * MiB;
constexpr size_t WS_HID = 208 * MiB;
constexpr size_t WS_WGU = 368 * MiB;
constexpr size_t WS_WIN = 628 * MiB;
constexpr size_t WS_WOUT = 652 * MiB;
constexpr size_t WS_HL = 660 * MiB;
constexpr size_t WS_HC = 724 * MiB;
constexpr size_t WS_KVC = 732 * MiB;
constexpr size_t WS_PROJ = 740 * MiB;
constexpr size_t WS_H2LO = 740 * MiB;
constexpr size_t WS_Y = 932 * MiB;
constexpr size_t WS_SLOT = 368 * MiB;
constexpr size_t WS_END = 996 * MiB;
static_assert(WS_SLOT + (size_t)T * NSLOT * DM * 2 <= WS_END, "slot buffer");
constexpr int CW_BAR = 4096;
constexpr int CW_CNT = 16384;

constexpr int RING_BYTES = 131072;
constexpr int MISC_OFF = RING_BYTES;
constexpr int BARW_OFF = 163840 - 64;
constexpr int LDS_BYTES = 163840;

#define RLX_AGENT __ATOMIC_RELAXED, __HIP_MEMORY_SCOPE_AGENT
#define LDS_WAIT() asm volatile("s_waitcnt lgkmcnt(0)" ::: "memory")
#define VM_WAIT() asm volatile("s_waitcnt vmcnt(0)" ::: "memory")
__device__ __forceinline__ unsigned cvt_pk_bf16(float lo, float hi) { unsigned r; asm volatile("v_cvt_pk_bf16_f32 %0, %1, %2" : "=v"(r) : "v"(lo), "v"(hi)); return r; }
__device__ __forceinline__ float u2f(unsigned u) { return __builtin_bit_cast(float, u); }
__device__ __forceinline__ float bf_lo(unsigned u) { return __builtin_bit_cast(float, u << 16); }
__device__ __forceinline__ float bf_hi(unsigned u) { return __builtin_bit_cast(float, u & 0xffff0000u); }
__device__ __forceinline__ float wave_sum(float v) {
#pragma unroll
    for (int o = 1; o < 64; o <<= 1) v += __shfl_xor(v, o);
    return v;
}
__device__ __forceinline__ float wave_max(float v) {
#pragma unroll
    for (int o = 1; o < 64; o <<= 1) v = fmaxf(v, __shfl_xor(v, o));
    return v;
}
__device__ __forceinline__ float silu_f(float v) { return v / (1.0f + expf(-v)); }

#define XB_TMO      128
#define XB_XCNT(j)  (256  + 64 * (j))
#define XB_XSUB(j)  (1280 + 64 * (j))
#define XB_XGEN(j)  (2304 + 64 * (j))
#define XB_TOP      3328
#define XB_TOPGEN   3392
#define XCD_BAR_WORDS 3456
#define XB_SPIN_CAP (1u << 18)
__device__ __forceinline__ unsigned xb_ld(unsigned* p)              { return __hip_atomic_load(p, __ATOMIC_RELAXED, __HIP_MEMORY_SCOPE_AGENT); }
__device__ __forceinline__ unsigned xb_add(unsigned* p, unsigned v) { return __hip_atomic_fetch_add(p, v, __ATOMIC_RELAXED, __HIP_MEMORY_SCOPE_AGENT); }
__device__ __forceinline__ unsigned xb_xcc_id() { return (unsigned)__builtin_amdgcn_s_getreg((3 << 11) | 20) & 0xFu; }
#define XB_SPIN(cond, bar) do { unsigned _sp = 0; while (cond) { __builtin_amdgcn_s_sleep(1); \
    if ((++_sp & 255u) == 0u) { if (xb_ld(&(bar)[XB_TMO])) break; if (_sp > XB_SPIN_CAP) { atomicAdd(&(bar)[XB_TMO], 1u); break; } } } } while (0)
struct XcdBarrier { unsigned* bar; unsigned x; volatile LAS unsigned* st; };
__device__ __forceinline__ XcdBarrier xcd_barrier_post(unsigned* bar, volatile LAS unsigned* st) {
    XcdBarrier b; b.bar = bar; b.x = xb_xcc_id(); b.st = st;
    if (threadIdx.x == 0) (void)xb_add(&bar[XB_XCNT(b.x)], 1u);
    return b;
}
__device__ __forceinline__ void xcd_barrier_complete(unsigned* bar, unsigned x, unsigned& nloc, unsigned& nx) {
    const unsigned G = gridDim.x * gridDim.y * gridDim.z;
    unsigned sum, cnt, mine, sp = 0u;
    for (;;) {
        sum = 0u; cnt = 0u; mine = 0u;
#pragma unroll
        for (unsigned j = 0; j < 16; ++j) { const unsigned c = xb_ld(&bar[XB_XCNT(j)]); sum += c; cnt += (c > 0u) ? 1u : 0u; mine = (j == x) ? c : mine; }
        if (sum == G) break;
        __builtin_amdgcn_s_sleep(1);
        if ((++sp & 255u) == 0u) { if (xb_ld(&bar[XB_TMO])) break; if (sp > XB_SPIN_CAP) { atomicAdd(&bar[XB_TMO], 1u); break; } }
    }
    nloc = mine > 0u ? mine : 1u; nx = cnt > 0u ? cnt : 1u;
}
__device__ __forceinline__ void xcd_barrier(const XcdBarrier& b) {
    asm volatile("s_waitcnt vmcnt(0)" ::: "memory");
    __syncthreads();
    if (threadIdx.x == 0) {
        unsigned* bar = b.bar;
        __builtin_amdgcn_s_waitcnt(0);
        unsigned nloc = b.st[0], nx = b.st[1];
        if (nloc == 0u) { xcd_barrier_complete(bar, b.x, nloc, nx); b.st[0] = nloc; b.st[1] = nx; }
        const unsigned old = xb_add(&bar[XB_XSUB(b.x)], 1u);
        const unsigned gen = old / nloc;
        if (old + 1u == (gen + 1u) * nloc) {
            __builtin_amdgcn_fence(__ATOMIC_RELEASE, "agent");
            asm volatile("s_waitcnt vmcnt(0)" ::: "memory");
            const unsigned og = xb_add(&bar[XB_TOP], 1u);
            const unsigned tg = og / nx;
            if (og + 1u == (tg + 1u) * nx) xb_add(&bar[XB_TOPGEN], 1u);
            else XB_SPIN(xb_ld(&bar[XB_TOPGEN]) == tg, bar);
            __builtin_amdgcn_fence(__ATOMIC_ACQUIRE, "agent");
            xb_add(&bar[XB_XGEN(b.x)], 1u);
            asm volatile("s_waitcnt vmcnt(0)" ::: "memory");
        } else {
            XB_SPIN(xb_ld(&bar[XB_XGEN(b.x)]) == gen, bar);
            __builtin_amdgcn_fence(__ATOMIC_ACQUIRE, "agent");
            asm volatile("s_waitcnt vmcnt(0)" ::: "memory");
        }
    }
    __syncthreads();
}

namespace pg8 {
constexpr int BM = 256, BK = 64, HALF = 128, HTB = HALF * BK * 2, STAGE_BYTES = 8 * HTB;
__host__ __device__ __forceinline__ int lds_byte(int r, int c) { const int st = (r >> 4) * 2 + (c >> 5), rr = r & 15, cc = c & 31, ob = rr * 64 + cc * 2; return st * 1024 + (ob ^ (((ob >> 9) & 1) << 5)); }
__host__ __device__ __forceinline__ void stage_rc(int b, int& R, int& C) { const int st = b / 1024, sb = b % 1024, swz = sb ^ (((sb >> 9) & 1) << 5); R = (st >> 1) * 16 + swz / 64; C = (st & 1) * 32 + (swz % 64) / 2; }
__host__ __device__ __forceinline__ int perm32(int rho) { const int n = rho >> 4, i = rho & 15; return 8 * (i >> 2) + 4 * n + (i & 3); }
struct Unit { int pm, pn, g; };

__device__ __forceinline__ int round_unit(int i, int G, int c, int total) {
    const int base = i * G; if (base + c >= total && (total - base) >= G) return -1;
    const int R = (total - base) < G ? (total - base) : G;
    if (R <= 0) return -1;
    if (R == G && (G & 7) == 0) return base + (c & 7) * (G >> 3) + (c >> 3);
    return c < R ? base + c : -1;
}

template <class P>
__device__ __forceinline__ void gemm_phase(LAS unsigned char* lds, const P& p) {
    constexpr int K = P::K, nt = K / BK;
    const int tid = threadIdx.x, wid = __builtin_amdgcn_readfirstlane(tid >> 6), lane = tid & 63, wr = wid >> 2, wc = wid & 3, fr = lane & 15, fq = lane >> 4;
    unsigned voffB[2], voffA[2];
#pragma unroll
    for (int i = 0; i < 2; ++i) { int R, C; stage_rc(tid * 16 + i * 8192, R, C); const int Rb = P::PERM ? ((R & ~31) + perm32(R & 31)) : R;
        voffA[i] = (unsigned)(R * K + C) * 2u; voffB[i] = (unsigned)(Rb * K + C) * 2u; }
    LAS unsigned* goffs = (LAS unsigned*)(lds + STAGE_BYTES + 1024);
    constexpr size_t kstep = (size_t)(BK * 2);
    constexpr size_t hstep = (size_t)HALF * K * 2;
    const unsigned ldsw = (unsigned)wid * 1024u;
    const int aoff = lds_byte(wr * 64 + fr, fq * 8), boff = lds_byte(wc * 32 + fr, fq * 8);
#define PG8_SA(b, h) (((b) * 2 + (h)) * HTB)
#define PG8_SB(b, h) ((4 + (b) * 2 + (h)) * HTB)
#define PG8_STAGE(bufoff, gbase, voff) do { _Pragma("unroll") for (int _i = 0; _i < 2; ++_i) \
        __builtin_amdgcn_global_load_lds((const unsigned*)((const char*)(gbase) + (voff)[_i]), (LAS unsigned*)(lds + (bufoff) + ldsw + _i * 8192), 16, 0, 0); } while (0)
#define PG8_STAGE_A(bufoff, h, nextu, kb) do { if constexpr (P::GATHER) { \
            _Pragma("unroll") for (int _i = 0; _i < 2; ++_i) { const unsigned _o = goffs[((((nextu) ? ui + 1 : ui) & 1) * 4 + (h) * 2 + _i) * 512 + tid]; \
                __builtin_amdgcn_global_load_lds((const unsigned*)(gA + (kb) + _o), (LAS unsigned*)(lds + (bufoff) + ldsw + _i * 8192), 16, 0, 0); } } \
        else { const char* _b = ((nextu) ? nA : cA) + (h) * hstep + (kb); PG8_STAGE(bufoff, _b, voffA); } } while (0)
#define PG8_LDA(dst, b, h) do { _Pragma("unroll") for (int m = 0; m < 4; ++m) _Pragma("unroll") for (int k = 0; k < 2; ++k) dst[m][k] = *(const LAS bf16x8*)(lds + PG8_SA(b, h) + aoff + m * 2048 + k * 1024); } while (0)
#define PG8_LDB(dst, b, h) do { _Pragma("unroll") for (int n = 0; n < 2; ++n) _Pragma("unroll") for (int k = 0; k < 2; ++k) dst[n][k] = *(const LAS bf16x8*)(lds + PG8_SB(b, h) + boff + n * 2048 + k * 1024); } while (0)
#define PG8_MMA(ai, bj, At, Bt) do { __builtin_amdgcn_s_setprio(1); _Pragma("unroll") for (int m = 0; m < 4; ++m) _Pragma("unroll") for (int n = 0; n < 2; ++n) _Pragma("unroll") for (int k = 0; k < 2; ++k) \
        acc[ai][bj][m][n] = __builtin_amdgcn_mfma_f32_16x16x32_bf16(Bt[n][k], At[m][k], acc[ai][bj][m][n], 0, 0, 0); __builtin_amdgcn_s_setprio(0); } while (0)
#define PG8_WAIT_V(n) asm volatile("s_waitcnt vmcnt(" #n ")" ::: "memory")
#define PG8_WAIT_L(n) asm volatile("s_waitcnt lgkmcnt(" #n ")" ::: "memory")
#define PG8_BAR __builtin_amdgcn_s_barrier()
#define PG8_SCHED __builtin_amdgcn_sched_barrier(0)
    Unit cur, nxt; int ui = 0;
    if (!p.next(0, cur)) return;
    f32x4 acc[2][2][4][2];
#pragma unroll
    for (int a = 0; a < 2; ++a)
#pragma unroll
        for (int b = 0; b < 2; ++b)
#pragma unroll
            for (int m = 0; m < 4; ++m)
#pragma unroll
                for (int n = 0; n < 2; ++n) acc[a][b][m][n] = (f32x4){0.f, 0.f, 0.f, 0.f};
    bf16x8 At[4][2], B0[2][2], B1[2][2];
    const char* cA = p.a_base(cur); const char* cB = p.b_base(cur);
    const char* nA = cA; const char* gA = cA;
    if constexpr (P::GATHER) { p.rows(cur, tid, goffs); p.rows(cur, tid, goffs + 4 * 512); }
    PG8_STAGE(PG8_SB(0, 0), cB, voffB); PG8_STAGE(PG8_SB(0, 1), cB + hstep, voffB); PG8_STAGE_A(PG8_SA(0, 0), 0, false, 0); PG8_STAGE_A(PG8_SA(0, 1), 1, false, 0);
    if (wr == 1) PG8_BAR;
    PG8_WAIT_V(2); PG8_BAR;
    PG8_STAGE(PG8_SB(1, 0), cB + kstep, voffB); PG8_STAGE_A(PG8_SA(1, 0), 0, false, kstep); PG8_STAGE(PG8_SB(1, 1), cB + hstep + kstep, voffB);
    PG8_WAIT_V(6); PG8_BAR;
    for (;;) {
        const bool has_next = p.next(ui + 1, nxt);
        nA = has_next ? p.a_base(nxt) : cA; const char* nB = has_next ? p.b_base(nxt) : cB;
        if constexpr (P::GATHER) { p.rows(has_next ? nxt : cur, tid, goffs + ((ui + 1) & 1) * 4 * 512); }
        for (int t = 0; t < nt; t += 2) {
            const bool last = (t == nt - 2);
            const size_t k1 = (size_t)(t + 1) * kstep;
            const size_t k2 = last ? 0 : (size_t)(t + 2) * kstep;
            const char* b2 = last ? nB : cB + (size_t)(t + 2) * kstep;
            const size_t k3 = k2 + kstep; const char* b3 = b2 + kstep;
            PG8_LDB(B0, 0, 0); PG8_LDB(B1, 0, 1); PG8_SCHED; PG8_LDA(At, 0, 0); PG8_STAGE_A(PG8_SA(1, 1), 1, false, k1);
            PG8_WAIT_V(8); PG8_WAIT_L(0); PG8_BAR; PG8_MMA(0, 0, At, B0); PG8_MMA(0, 1, At, B1); PG8_BAR; PG8_SCHED;
            PG8_LDA(At, 0, 1); PG8_STAGE(PG8_SB(0, 0), b2, voffB); PG8_STAGE(PG8_SB(0, 1), b2 + hstep, voffB); PG8_STAGE_A(PG8_SA(0, 0), 0, last, k2);
            PG8_WAIT_V(8); PG8_WAIT_L(0); PG8_BAR; PG8_MMA(1, 0, At, B0); PG8_MMA(1, 1, At, B1); PG8_BAR; PG8_SCHED;
            PG8_LDB(B0, 1, 0); PG8_LDB(B1, 1, 1); PG8_SCHED; PG8_LDA(At, 1, 0); PG8_STAGE_A(PG8_SA(0, 1), 1, last, k2);
            PG8_WAIT_V(8); PG8_WAIT_L(0); PG8_BAR; PG8_MMA(0, 0, At, B0); PG8_MMA(0, 1, At, B1); PG8_BAR; PG8_SCHED;
            PG8_LDA(At, 1, 1); PG8_STAGE(PG8_SB(1, 0), b3, voffB); PG8_STAGE(PG8_SB(1, 1), b3 + hstep, voffB); PG8_STAGE_A(PG8_SA(1, 0), 0, last, k3);
            PG8_WAIT_V(8); PG8_WAIT_L(0); PG8_BAR; PG8_MMA(1, 0, At, B0); PG8_MMA(1, 1, At, B1); PG8_BAR; PG8_SCHED;
        }
        if (wr == 0) PG8_BAR;
        p.epi(acc, cur, wr, wc, fr, fq);
        if (!has_next) break;
#pragma unroll
        for (int a = 0; a < 2; ++a)
#pragma unroll
            for (int b = 0; b < 2; ++b)
#pragma unroll
                for (int m = 0; m < 4; ++m)
#pragma unroll
                    for (int n = 0; n < 2; ++n) acc[a][b][m][n] = (f32x4){0.f, 0.f, 0.f, 0.f};
        cur = nxt; cA = nA; cB = nB; ++ui;
        if (wr == 1) PG8_BAR;
    }
    PG8_WAIT_V(0);
    PG8_BAR;
#undef PG8_SA
#undef PG8_SB
#undef PG8_STAGE
#undef PG8_STAGE_A
#undef PG8_LDA
#undef PG8_LDB
#undef PG8_MMA
#undef PG8_WAIT_V
#undef PG8_WAIT_L
#undef PG8_BAR
#undef PG8_SCHED
}
}

struct KArgs { const float* in[25]; float* out; unsigned char* ws; int ph_lo, ph_hi, li, pad; };
typedef const KArgs __attribute__((address_space(4))) CKArgs;
struct Frame {
    LAS unsigned char* lds;
    int tid, lane, wave, G, bid;
    CKArgs* ka;
    unsigned char* ws;
};
#define FIN(i) (F.ka->in[i])
#define FOUT (F.ka->out)
enum { I_X = 0, I_C, I_CTX, I_CCTX, I_WMOD, I_BMOD, I_GPREMIX, I_GPOSTMIX, I_GPREFFN, I_GPOSTFFN, I_WIN, I_CONVW, I_CONVB, I_RPB, I_GCONV, I_GATTN, I_WOUT, I_WROUTER, I_RBIAS,
       I_WEG, I_WEU, I_WED, I_WSG, I_WSU, I_WSD };

template <class RowMap>
__device__ __forceinline__ void transpose_item(const float* W, int ldn, int K, bf16* WT, LAS float* scr, int kb, int nb, int lane, const RowMap& rm) {
    const int k0 = 64 * kb, n0 = 32 * nb;
#pragma unroll 8
    for (int i = 0; i < 32; ++i) { const int kk = 2 * i + (lane >> 5); scr[kk * 33 + (lane & 31)] = W[(size_t)(k0 + kk) * ldn + n0 + (lane & 31)]; }
    LDS_WAIT(); asm volatile("" ::: "memory");
    const int c = lane & 7;
#pragma unroll
    for (int j = 0; j < 4; ++j) { const int n = (lane >> 3) + 8 * j; const LAS float* s = scr + (8 * c) * 33 + n;
        v4u o; o.x = cvt_pk_bf16(s[0 * 33], s[1 * 33]); o.y = cvt_pk_bf16(s[2 * 33], s[3 * 33]); o.z = cvt_pk_bf16(s[4 * 33], s[5 * 33]); o.w = cvt_pk_bf16(s[6 * 33], s[7 * 33]);
        *(GAS v4u*)(WT + (size_t)rm(n0 + n) * K + k0 + 8 * c) = o; }
    LDS_WAIT(); asm volatile("" ::: "memory");
}
struct RmIdent { int off; __device__ __forceinline__ int operator()(int n) const { return off + n; } };
struct RmWin {
    __device__ __forceinline__ int operator()(int n) const {
        if (n < QOFF || n >= VOFF) return n;
        const int nn = n & 127, axis = nn >> 6, half = (nn >> 5) & 1, f = nn & 31;
        return (n - nn) + 2 * (axis * 32 + f) + half; }
};
struct RmGU { int base; int up; __device__ __forceinline__ int operator()(int f) const { return base + 32 * (f >> 4) + 16 * up + (f & 15); } };

__device__ __forceinline__ void p0_prologue(Frame& F) {
    const int gw = F.bid * NWAVES + F.wave, NGW = F.G * NWAVES;
    if (F.bid == 0) {
        GAS f32x2* rope = (GAS f32x2*)(F.ws + WS_ROPE);
        for (int i = F.tid; i < 64 * 32; i += NTHR) { const int pos = i >> 5, f = i & 31;
            const float inv = powf(10000.0f, -(float)f / 32.0f); const float ang = (float)pos * inv;
            rope[i] = (f32x2){(float)cos((double)ang), (float)sin((double)ang)}; }
    }
    {
        LAS float* act = (LAS float*)F.lds;
        LAS float* red = (LAS float*)(F.lds + 9 * 2048 * 4);
        for (int i = F.tid; i < 9 * 2048; i += NTHR) { const int r = i >> 11, k = i & 2047; const float v = r < 8 ? FIN(I_C)[r * 2048 + k] : FIN(I_CCTX)[k]; act[i] = silu_f(v); }
        __syncthreads();
        const float* wm = FIN(I_WMOD);
        for (int cb = F.bid; cb < 256; cb += F.G) {
            const int kq = F.wave * 5 + F.lane / 12, cq = F.lane % 12; const bool on = F.lane < 60;
            f32x4 a[9];
#pragma unroll
            for (int r = 0; r < 9; ++r) a[r] = (f32x4){0.f, 0.f, 0.f, 0.f};
            if (on) for (int k = kq; k < 2048; k += 40) { const f32x4 w = *(const GAS f32x4*)(wm + (size_t)k * 12288 + cb * 48 + cq * 4);
#pragma unroll
                for (int r = 0; r < 9; ++r) a[r] += w * act[r * 2048 + k]; }
#pragma unroll
            for (int r = 0; r < 9; ++r) {
                f32x4 s = a[r];
#pragma unroll
                for (int j = 1; j < 5; ++j) { const int src = (F.lane % 12) + 12 * j; f32x4 o; o.x = __shfl(a[r].x, src); o.y = __shfl(a[r].y, src); o.z = __shfl(a[r].z, src); o.w = __shfl(a[r].w, src); s += o; }
                if (F.lane < 12) *(LAS f32x4*)(red + (F.wave * 9 + r) * 48 + F.lane * 4) = s;
            }
            __syncthreads();
            if (F.tid < 9 * 48) { const int r = F.tid / 48, cc = F.tid % 48; float s = 0.f;
#pragma unroll
                for (int w = 0; w < 8; ++w) s += red[(w * 9 + r) * 48 + cc];
                ((GAS float*)(F.ws + WS_MOD))[r * 12288 + cb * 48 + cc] = s + FIN(I_BMOD)[cb * 48 + cc]; }
            __syncthreads();
        }
    }
    {
        LAS float* scr = (LAS float*)(F.lds + F.wave * 16384);
        bf16* Win = (bf16*)(F.ws + WS_WIN); bf16* Wout = (bf16*)(F.ws + WS_WOUT); bf16* Wgu = (bf16*)(F.ws + WS_WGU); bf16* Wdn = (bf16*)(F.ws + WS_WDN);
        constexpr int IT_IN = 32 * 192, IT_OUT = 32 * 64, IT_G = 64 * 32 * 16, IT_D = 64 * 8 * 64, IT_SG = 32 * 16, IT_SD = 8 * 64, IT_R = 32 * 2;
        constexpr int NIT = IT_IN + IT_OUT + 2 * IT_G + IT_D + 2 * IT_SG + IT_SD + IT_R;
        for (int it = gw; it < NIT; it += NGW) {
            int r = it;
            if (r < IT_IN) { transpose_item(FIN(I_WIN), NPROJ, DM, Win, scr, r / 192, r % 192, F.lane, RmWin{}); continue; } r -= IT_IN;
            if (r < IT_OUT) { transpose_item(FIN(I_WOUT), DM, DM, Wout, scr, r / 64, r % 64, F.lane, RmIdent{0}); continue; } r -= IT_OUT;
            if (r < IT_G) { const int e = r / 512, q = r % 512; transpose_item(FIN(I_WEG) + (size_t)e * DM * FE, FE, DM, Wgu, scr, q / 16, q % 16, F.lane, RmGU{e * 1024, 0}); continue; } r -= IT_G;
            if (r < IT_G) { const int e = r / 512, q = r % 512; transpose_item(FIN(I_WEU) + (size_t)e * DM * FE, FE, DM, Wgu, scr, q / 16, q % 16, F.lane, RmGU{e * 1024, 1}); continue; } r -= IT_G;
            if (r < IT_D) { const int e = r / 512, q = r % 512; transpose_item(FIN(I_WED) + (size_t)e * FE * DM, DM, FE, Wdn, scr, q / 64, q % 64, F.lane, RmIdent{e * 2048}); continue; } r -= IT_D;
            if (r < IT_SG) { transpose_item(FIN(I_WSG), FE, DM, Wgu, scr, r / 16, r % 16, F.lane, RmGU{64 * 1024, 0}); continue; } r -= IT_SG;
            if (r < IT_SG) { transpose_item(FIN(I_WSU), FE, DM, Wgu, scr, r / 16, r % 16, F.lane, RmGU{64 * 1024, 1}); continue; } r -= IT_SG;
            if (r < IT_SD) { transpose_item(FIN(I_WSD), DM, FE, Wdn, scr, r / 64, r % 64, F.lane, RmIdent{64 * 2048}); continue; } r -= IT_SD;
            {
                const int kb = r / 2, nb = r % 2; const float* W = FIN(I_WROUTER);
                bf16* WH = (bf16*)(F.ws + WS_WRH); bf16* WL = (bf16*)(F.ws + WS_WRL);
                for (int i = 0; i < 32; ++i) { const int kk = 2 * i + (F.lane >> 5), n = nb * 32 + (F.lane & 31), k = kb * 64 + kk;
                    const float v = W[(size_t)k * NE + n]; const unsigned hi = cvt_pk_bf16(v, 0.f) & 0xffffu; const float rem = v - bf_lo(hi);
                    WH[(size_t)n * DM + k] = (bf16)hi; WL[(size_t)n * DM + k] = (bf16)(cvt_pk_bf16(rem, 0.f) & 0xffffu); }
            }
        }
    }
}

__device__ __forceinline__ void p1_norm(Frame& F) {
    const int gw = F.bid * NWAVES + F.wave, NGW = F.G * NWAVES;
    const float* MOD = (const float*)(F.ws + WS_MOD); const float* g = FIN(I_GPREMIX);
    for (int row = gw; row < T + TC; row += NGW) {
        const bool lat = row < T; const int rr = lat ? row : row - T;
        const float* xr = (lat ? FIN(I_X) : FIN(I_CTX)) + (size_t)rr * DM;
        const float* md = MOD + (size_t)(lat ? (rr >> 11) : 8) * 12288;
        bf16* orow = (bf16*)(F.ws + (lat ? WS_HL : WS_HC)) + (size_t)rr * DM;
        f32x4 v[8]; float ss = 0.f;
#pragma unroll
        for (int j = 0; j < 8; ++j) { v[j] = *(const GAS f32x4*)(xr + 4 * F.lane + 256 * j); ss += (v[j].x * v[j].x + v[j].y * v[j].y) + (v[j].z * v[j].z + v[j].w * v[j].w); }
        const float rstd = 1.0f / sqrtf(wave_sum(ss) * (1.0f / DM) + EPS);
#pragma unroll
        for (int j = 0; j < 8; ++j) { const int c = 4 * F.lane + 256 * j;
            const f32x4 gg = *(const GAS f32x4*)(g + c), sh = *(const GAS f32x4*)(md + c), sc = *(const GAS f32x4*)(md + 2048 + c);
            const f32x4 o = (v[j] * rstd) * gg * (sc + 1.0f) + sh;
            *(GAS v2u*)(orow + c) = (v2u){cvt_pk_bf16(o.x, o.y), cvt_pk_bf16(o.z, o.w)}; }
    }
}

struct ProbProj {
    static constexpr int K = DM; static constexpr bool GATHER = false, PERM = true;
    const bf16 *HL, *HC, *Win; bf16 *PROJ, *KVC; const f32x2* rope; int G, c;
    static constexpr int NMAIN = 64 * 24, NTOT = NMAIN + 64;
    __device__ __forceinline__ bool next(int i, pg8::Unit& u) const {
        const int w = pg8::round_unit(i, G, c, NTOT); if (w < 0) return false;
        if (w < NMAIN) { const int gid = w / 192, r = w % 192; u.pm = gid * 8 + (r & 7); u.pn = r >> 3; u.g = 0; }
        else { const int j = w - NMAIN; u.pm = j & 7; u.pn = 16 + (j >> 3); u.g = 1; }
        return true; }
    __device__ __forceinline__ const char* a_base(const pg8::Unit& u) const { return (const char*)HL + (size_t)u.g * (size_t)(WS_HC - WS_HL) + (size_t)u.pm * 256 * K * 2; }
    __device__ __forceinline__ const char* b_base(const pg8::Unit& u) const { return (const char*)Win + (size_t)u.pn * 256 * K * 2; }
    __device__ __forceinline__ void rows(const pg8::Unit&, int, LAS unsigned*) const {}
    __device__ __forceinline__ void epi(const f32x4 (&acc)[2][2][4][2], const pg8::Unit& u, int wr, int wc, int fr, int fq) const {
        const int row0 = u.pm * 256 + wr * 64 + fr;
        const bool rot = (u.g == 0) && (u.pn >= 12) && (u.pn < 20);
        bf16* base = (bf16*)((char*)PROJ + (long)u.g * ((long)WS_KVC - (long)WS_PROJ));
        const int ldc = NPROJ - u.g * (NPROJ - DM), col0 = (u.pn - 16 * u.g) * 256 + wc * 32 + 8 * fq;
        const int p0 = (wc * 32 + 8 * fq) >> 1, axis = p0 >> 5, f0 = p0 & 31;
#pragma unroll
        for (int ai = 0; ai < 2; ++ai)
#pragma unroll
            for (int m = 0; m < 4; ++m) {
                const int row = row0 + ai * 128 + m * 16; bf16* rowp = base + (size_t)row * ldc + col0;
                const int t = row & (SEQ - 1); const int pos = axis ? (t & 63) : (t >> 6);
                const f32x4 csA = *(const GAS f32x4*)(rope + pos * 32 + f0), csB = *(const GAS f32x4*)(rope + pos * 32 + f0 + 2);
                const f32x2 cs0 = (f32x2){csA.x, csA.y}, cs1 = (f32x2){csA.z, csA.w}, cs2 = (f32x2){csB.x, csB.y}, cs3 = (f32x2){csB.z, csB.w};
#pragma unroll
                for (int bj = 0; bj < 2; ++bj) { f32x4 v0 = acc[ai][bj][m][0], v1 = acc[ai][bj][m][1];
                    if (rot) { f32x4 r0, r1;
                        r0.x = v0.x * cs0.x - v0.y * cs0.y; r0.y = v0.y * cs0.x + v0.x * cs0.y;
                        r0.z = v0.z * cs1.x - v0.w * cs1.y; r0.w = v0.w * cs1.x + v0.z * cs1.y;
                        r1.x = v1.x * cs2.x - v1.y * cs2.y; r1.y = v1.y * cs2.x + v1.x * cs2.y;
                        r1.z = v1.z * cs3.x - v1.w * cs3.y; r1.w = v1.w * cs3.x + v1.z * cs3.y; v0 = r0; v1 = r1; }
                    v4u w; w.x = cvt_pk_bf16(v0.x, v0.y); w.y = cvt_pk_bf16(v0.z, v0.w); w.z = cvt_pk_bf16(v1.x, v1.y); w.w = cvt_pk_bf16(v1.z, v1.w);
                    *(GAS v4u*)(rowp + bj * 128) = w; } }
    }
};

__device__ __forceinline__ float dot2bf(unsigned a, unsigned b, float c) { return __builtin_amdgcn_fdot2_f32_bf16(__builtin_bit_cast(v2bf, a), __builtin_bit_cast(v2bf, b), c, false); }
__device__ __forceinline__ void p3_attn_simple(Frame& F) {
    const bf16* PROJ = (const bf16*)(F.ws + WS_PROJ); const bf16* KVC = (const bf16*)(F.ws + WS_KVC); bf16* Y = (bf16*)(F.ws + WS_Y);
    const float* rpb = FIN(I_RPB); const float* gat = FIN(I_GATTN);
    const float scale = 0.08838834764831845f;
    const int per = (T * NH) / F.G;
    for (int i = F.wave; i < per; i += NWAVES) {
        const int task = F.bid * per + i; const int t = task & (SEQ - 1), bh = task >> 11, h = bh & 7, b = bh >> 3;
        const int r = t >> 6, c = t & 63; int r0 = r - 4; r0 = r0 < 0 ? 0 : (r0 > 24 ? 24 : r0); int cs = c - 8; cs = cs < 0 ? 0 : (cs > 48 ? 48 : cs);
        const unsigned qv = *(const GAS unsigned*)(PROJ + (size_t)(b * SEQ + t) * NPROJ + QOFF + h * HD + 2 * F.lane);
        const bf16* kp[6]; float sc[6];
#pragma unroll
        for (int j = 0; j < 6; ++j) { const int n = F.lane + 64 * j;
            if (j < 2) { const int ii = n >> 4, jj = n & 15; const int tk = (r0 + ii) * GW + cs + jj; kp[j] = PROJ + (size_t)(b * SEQ + tk) * NPROJ + KOFF + h * HD; }
            else kp[j] = KVC + (size_t)(b * LC + (n - 128)) * DM + h * HD;
            sc[j] = 0.f; }
#pragma unroll 4
        for (int pc = 0; pc < 16; ++pc) {
            v4u kk[6];
#pragma unroll
            for (int j = 0; j < 6; ++j) kk[j] = *(const GAS v4u*)(kp[j] + 8 * pc);
            const unsigned q0 = __builtin_amdgcn_readlane(qv, 4 * pc), q1 = __builtin_amdgcn_readlane(qv, 4 * pc + 1), q2 = __builtin_amdgcn_readlane(qv, 4 * pc + 2), q3 = __builtin_amdgcn_readlane(qv, 4 * pc + 3);
#pragma unroll
            for (int j = 0; j < 6; ++j) { sc[j] = dot2bf(q0, kk[j].x, sc[j]); sc[j] = dot2bf(q1, kk[j].y, sc[j]); sc[j] = dot2bf(q2, kk[j].z, sc[j]); sc[j] = dot2bf(q3, kk[j].w, sc[j]); }
        }
        float mx = -1e30f;
#pragma unroll
        for (int j = 0; j < 6; ++j) { sc[j] *= scale;
            if (j < 2) { const int n = F.lane + 64 * j, ii = n >> 4, jj = n & 15; sc[j] += rpb[(h * 15 + (r0 + ii - r + 7)) * 31 + (cs + jj - c + 15)]; }
            mx = fmaxf(mx, sc[j]); }
        mx = wave_max(mx);
        float ps = 0.f;
#pragma unroll
        for (int j = 0; j < 6; ++j) { sc[j] = __expf(sc[j] - mx); ps += sc[j]; }
        ps = wave_sum(ps);
        float o0 = 0.f, o1 = 0.f;
        const bf16* vl = PROJ + (size_t)(b * SEQ) * NPROJ + VOFF + h * HD + 2 * F.lane;
        const bf16* vc = KVC + (size_t)(b * LC) * DM + DC + h * HD + 2 * F.lane;
#pragma unroll
        for (int j = 0; j < 6; ++j) {
#pragma unroll 8
            for (int l = 0; l < 64; ++l) { const int n = l + 64 * j; const float p = __builtin_bit_cast(float, __builtin_amdgcn_readlane(__builtin_bit_cast(unsigned, sc[j]), l));
                unsigned vv;
                if (j < 2) { const int tk = (r0 + (n >> 4)) * GW + cs + (n & 15); vv = *(const GAS unsigned*)(vl + (size_t)tk * NPROJ); }
                else vv = *(const GAS unsigned*)(vc + (size_t)(n - 128) * DM);
                o0 += p * bf_lo(vv); o1 += p * bf_hi(vv); }
        }
        const float inv = 1.0f / ps; o0 *= inv; o1 *= inv;
        const float rstd = 1.0f / sqrtf(wave_sum(o0 * o0 + o1 * o1) * (1.0f / HD) + EPS);
        const f32x2 gg = *(const GAS f32x2*)(gat + h * HD + 2 * F.lane);
        *(GAS unsigned*)(Y + (size_t)(b * SEQ + t) * DM + DC + h * HD + 2 * F.lane) = cvt_pk_bf16(o0 * rstd * gg.x, o1 * rstd * gg.y);
    }
}
__device__ __forceinline__ void p3_conv(Frame& F) {
    const bf16* PROJ = (const bf16*)(F.ws + WS_PROJ); bf16* Y = (bf16*)(F.ws + WS_Y);
    const float* cw = FIN(I_CONVW); const float* cb = FIN(I_CONVB); const float* gc = FIN(I_GCONV);
    const int gw = F.bid * NWAVES + F.wave, NGW = F.G * NWAVES;
    const int ch0 = 16 * F.lane;
    for (int row = gw; row < T; row += NGW) {
        const int t = row & (SEQ - 1);
        const bf16* pr = PROJ + (size_t)row * NPROJ + ch0;
        float pm[16], p0[16], pp[16], ub[16];
#pragma unroll
        for (int hh = 0; hh < 2; ++hh) {
            const v4u vb = *(const GAS v4u*)(pr + 8 * hh), vc0 = *(const GAS v4u*)(pr + 1024 + 8 * hh), vx0 = *(const GAS v4u*)(pr + 2048 + 8 * hh);
            v4u vcm = (v4u){0, 0, 0, 0}, vxm = vcm, vcp = vcm, vxp = vcm;
            if (t > 0) { vcm = *(const GAS v4u*)(pr - NPROJ + 1024 + 8 * hh); vxm = *(const GAS v4u*)(pr - NPROJ + 2048 + 8 * hh); }
            if (t < SEQ - 1) { vcp = *(const GAS v4u*)(pr + NPROJ + 1024 + 8 * hh); vxp = *(const GAS v4u*)(pr + NPROJ + 2048 + 8 * hh); }
#pragma unroll
            for (int q = 0; q < 4; ++q) { const int e = 8 * hh + 2 * q;
                ub[e] = bf_lo(vb[q]); ub[e + 1] = bf_hi(vb[q]);
                p0[e] = bf_lo(vc0[q]) * bf_lo(vx0[q]); p0[e + 1] = bf_hi(vc0[q]) * bf_hi(vx0[q]);
                pm[e] = bf_lo(vcm[q]) * bf_lo(vxm[q]); pm[e + 1] = bf_hi(vcm[q]) * bf_hi(vxm[q]);
                pp[e] = bf_lo(vcp[q]) * bf_lo(vxp[q]); pp[e + 1] = bf_hi(vcp[q]) * bf_hi(vxp[q]); }
        }
        float o[16]; float ss = 0.f;
#pragma unroll
        for (int q = 0; q < 4; ++q) { const f32x4 w0 = *(const GAS f32x4*)(cw + ch0 + 4 * q), w1 = *(const GAS f32x4*)(cw + 1024 + ch0 + 4 * q), w2 = *(const GAS f32x4*)(cw + 2048 + ch0 + 4 * q), bb = *(const GAS f32x4*)(cb + ch0 + 4 * q);
#pragma unroll
            for (int e = 0; e < 4; ++e) { const int k = 4 * q + e; const float cv = pm[k] * w0[e] + p0[k] * w1[e] + pp[k] * w2[e] + bb[e]; o[k] = ub[k] * cv; ss += o[k] * o[k]; } }
        ss += __shfl_xor(ss, 1); ss += __shfl_xor(ss, 2); ss += __shfl_xor(ss, 4);
        const float rstd = 1.0f / sqrtf(ss * (1.0f / 128.0f) + EPS);
        unsigned w[8];
#pragma unroll
        for (int q = 0; q < 4; ++q) { const f32x4 gg = *(const GAS f32x4*)(gc + ch0 + 4 * q);
            w[2 * q] = cvt_pk_bf16(o[4 * q] * rstd * gg[0], o[4 * q + 1] * rstd * gg[1]); w[2 * q + 1] = cvt_pk_bf16(o[4 * q + 2] * rstd * gg[2], o[4 * q + 3] * rstd * gg[3]); }
        *(GAS v4u*)(Y + (size_t)row * DM + ch0) = (v4u){w[0], w[1], w[2], w[3]};
        *(GAS v4u*)(Y + (size_t)row * DM + ch0 + 8) = (v4u){w[4], w[5], w[6], w[7]};
    }
}

struct ProbOut {
    static constexpr int K = DM; static constexpr bool GATHER = false, PERM = true;
    const bf16 *Y, *Wout; bf16* YL; float* SSQ; int G, c;
    __device__ __forceinline__ bool next(int i, pg8::Unit& u) const {
        const int w = pg8::round_unit(i, G, c, 512); if (w < 0) return false;
        u.pm = (w >> 6) * 8 + (w & 7); u.pn = (w & 63) >> 3; u.g = 0; return true; }
    __device__ __forceinline__ const char* a_base(const pg8::Unit& u) const { return (const char*)Y + (size_t)u.pm * 256 * K * 2; }
    __device__ __forceinline__ const char* b_base(const pg8::Unit& u) const { return (const char*)Wout + (size_t)u.pn * 256 * K * 2; }
    __device__ __forceinline__ void rows(const pg8::Unit&, int, LAS unsigned*) const {}
    __device__ __forceinline__ void epi(const f32x4 (&acc)[2][2][4][2], const pg8::Unit& u, int wr, int wc, int fr, int fq) const {
        const int row0 = u.pm * 256 + wr * 64 + fr, col0 = u.pn * 256 + wc * 32 + 8 * fq;
#pragma unroll
        for (int ai = 0; ai < 2; ++ai)
#pragma unroll
            for (int m = 0; m < 4; ++m) { const int row = row0 + ai * 128 + m * 16; bf16* rowp = YL + (size_t)row * DM + col0; float ss = 0.f;
#pragma unroll
                for (int bj = 0; bj < 2; ++bj) { const f32x4 v0 = acc[ai][bj][m][0], v1 = acc[ai][bj][m][1];
                    ss += (v0.x * v0.x + v0.y * v0.y) + (v0.z * v0.z + v0.w * v0.w) + (v1.x * v1.x + v1.y * v1.y) + (v1.z * v1.z + v1.w * v1.w);
                    v4u w; w.x = cvt_pk_bf16(v0.x, v0.y); w.y = cvt_pk_bf16(v0.z, v0.w); w.z = cvt_pk_bf16(v1.x, v1.y); w.w = cvt_pk_bf16(v1.z, v1.w);
                    *(GAS v4u*)(rowp + bj * 128) = w; }
                ss += __shfl_xor(ss, 16); ss += __shfl_xor(ss, 32);
                if (fq == 0) SSQ[(size_t)row * 32 + u.pn * 4 + wc] = ss; }
    }
};

__device__ __forceinline__ void p5_route(Frame& F) {
    const float* MOD = (const float*)(F.ws + WS_MOD);
    const bf16* YL = (const bf16*)(F.ws + WS_YL); const float* SSQ = (const float*)(F.ws + WS_SSQ);
    bf16* H2 = (bf16*)(F.ws + WS_HL); bf16* H2L = (bf16*)(F.ws + WS_H2LO);
    const bf16* WRH = (const bf16*)(F.ws + WS_WRH); const bf16* WRL = (const bf16*)(F.ws + WS_WRL);
    unsigned* gcnt = (unsigned*)(F.ws + WS_CTL) + CW_CNT;
    v2u* LIST = (v2u*)(F.ws + WS_LIST);
    LAS float* logit = (LAS float*)F.lds;
    LAS unsigned* lcnt = (LAS unsigned*)(F.lds + 16384);
    LAS unsigned* lbase = (LAS unsigned*)(F.lds + 16384 + 256);
    LAS unsigned* ent = (LAS unsigned*)(F.lds + 16384 + 512);
    for (int blk = F.bid; blk < T / 64; blk += F.G) {
        const int row0 = blk * 64;
        if (F.tid < 64) lcnt[F.tid] = 0u;
        for (int rr = F.wave; rr < 64; rr += NWAVES) {
            const int row = row0 + rr, b = row >> 11; const float* md = MOD + (size_t)b * 12288;
            const float* xr = FIN(I_X) + (size_t)row * DM; const bf16* yr = YL + (size_t)row * DM;
            float sq = F.lane < 32 ? SSQ[(size_t)row * 32 + F.lane] : 0.f; sq = wave_sum(sq);
            const float rstd1 = 1.0f / sqrtf(sq * (1.0f / DM) + EPS);
            f32x4 v[8]; float ss = 0.f;
#pragma unroll
            for (int j = 0; j < 8; ++j) { const int c = 4 * F.lane + 256 * j;
                const f32x4 xv = *(const GAS f32x4*)(xr + c); const v2u yv = *(const GAS v2u*)(yr + c);
                const f32x4 gp = *(const GAS f32x4*)(FIN(I_GPOSTMIX) + c), gt = *(const GAS f32x4*)(md + 4096 + c);
                const f32x4 yl = (f32x4){bf_lo(yv.x), bf_hi(yv.x), bf_lo(yv.y), bf_hi(yv.y)};
                v[j] = xv + gt * (yl * rstd1 * gp);
                *(GAS f32x4*)(FOUT + (size_t)row * DM + c) = v[j];
                ss += (v[j].x * v[j].x + v[j].y * v[j].y) + (v[j].z * v[j].z + v[j].w * v[j].w); }
            const float rstd2 = 1.0f / sqrtf(wave_sum(ss) * (1.0f / DM) + EPS);
#pragma unroll
            for (int j = 0; j < 8; ++j) { const int c = 4 * F.lane + 256 * j;
                const f32x4 gg = *(const GAS f32x4*)(FIN(I_GPREFFN) + c), sh = *(const GAS f32x4*)(md + 6144 + c), sc = *(const GAS f32x4*)(md + 8192 + c);
                const f32x4 h = (v[j] * rstd2) * gg * (sc + 1.0f) + sh;
                const unsigned h0 = cvt_pk_bf16(h.x, h.y), h1 = cvt_pk_bf16(h.z, h.w);
                const unsigned l0 = cvt_pk_bf16(h.x - bf_lo(h0), h.y - bf_hi(h0)), l1 = cvt_pk_bf16(h.z - bf_lo(h1), h.w - bf_hi(h1));
                *(GAS v2u*)(H2 + (size_t)row * DM + c) = (v2u){h0, h1}; *(GAS v2u*)(H2L + (size_t)row * DM + c) = (v2u){l0, l1}; }
        }
        VM_WAIT(); __syncthreads();
        {
            const int rt = F.wave & 3, nh = F.wave >> 2, fr = F.lane & 15, fq = F.lane >> 4;
            const bf16* ah = H2 + (size_t)(row0 + rt * 16 + fr) * DM + 8 * fq; const bf16* al = H2L + (size_t)(row0 + rt * 16 + fr) * DM + 8 * fq;
            f32x4 acc[2] = {(f32x4){0.f, 0.f, 0.f, 0.f}, (f32x4){0.f, 0.f, 0.f, 0.f}};
#pragma unroll 2
            for (int s = 0; s < 64; ++s) {
                const bf16x8 a_h = *(const GAS bf16x8*)(ah + 32 * s), a_l = *(const GAS bf16x8*)(al + 32 * s);
#pragma unroll
                for (int n2 = 0; n2 < 2; ++n2) { const size_t eo = (size_t)(nh * 32 + n2 * 16 + fr) * DM + 32 * s + 8 * fq;
                    const bf16x8 b_h = *(const GAS bf16x8*)(WRH + eo), b_l = *(const GAS bf16x8*)(WRL + eo);
                    acc[n2] = __builtin_amdgcn_mfma_f32_16x16x32_bf16(a_l, b_h, acc[n2], 0, 0, 0);
                    acc[n2] = __builtin_amdgcn_mfma_f32_16x16x32_bf16(a_h, b_l, acc[n2], 0, 0, 0);
                    acc[n2] = __builtin_amdgcn_mfma_f32_16x16x32_bf16(a_h, b_h, acc[n2], 0, 0, 0); }
            }
#pragma unroll
            for (int n2 = 0; n2 < 2; ++n2)
#pragma unroll
                for (int r = 0; r < 4; ++r) logit[(rt * 16 + 4 * fq + r) * 64 + nh * 32 + n2 * 16 + fr] = acc[n2][r];
        }
        __syncthreads();
        for (int rr = F.wave; rr < 64; rr += NWAVES) {
            const int row = row0 + rr; const int e = F.lane;
            const float lg = logit[rr * 64 + e]; const float score = 1.0f / (1.0f + expf(-lg)); const float sel = score + FIN(I_RBIAS)[e];
            float m1 = sel; m1 = fmaxf(m1, __shfl_xor(m1, 1)); m1 = fmaxf(m1, __shfl_xor(m1, 2)); m1 = fmaxf(m1, __shfl_xor(m1, 4));
            int i1 = (sel == m1) ? e : 1000; i1 = min(i1, __shfl_xor(i1, 1)); i1 = min(i1, __shfl_xor(i1, 2)); i1 = min(i1, __shfl_xor(i1, 4));
            float s2 = (e == i1) ? -INFINITY : sel; s2 = fmaxf(s2, __shfl_xor(s2, 1)); s2 = fmaxf(s2, __shfl_xor(s2, 2)); s2 = fmaxf(s2, __shfl_xor(s2, 4));
            const float gs = m1 + s2; const int g = e >> 3; int grank = 0;
#pragma unroll
            for (int g2 = 0; g2 < 8; ++g2) { const float o = __builtin_bit_cast(float, __builtin_amdgcn_readlane(__builtin_bit_cast(unsigned, gs), 8 * g2)); grank += (o > gs || (o == gs && g2 < g)) ? 1 : 0; }
            const float ms = grank < 4 ? sel : -INFINITY; int rank = 0;
#pragma unroll 4
            for (int e2 = 0; e2 < 64; ++e2) { const float o = __builtin_bit_cast(float, __builtin_amdgcn_readlane(__builtin_bit_cast(unsigned, ms), e2)); rank += (o > ms || (o == ms && e2 < e)) ? 1 : 0; }
            const bool chosen = rank < 8;
            const float ssum = wave_sum(chosen ? score : 0.f);
            const float w = score / ssum * 2.5f;
            if (chosen) { const unsigned lp = __hip_atomic_fetch_add(lcnt + e, 1u, __ATOMIC_RELAXED, __HIP_MEMORY_SCOPE_WORKGROUP);
                LAS unsigned* en = ent + (rr * 8 + rank) * 4; en[0] = (unsigned)e; en[1] = lp; en[2] = (unsigned)row * 16u + (unsigned)rank; en[3] = __builtin_bit_cast(unsigned, w); }
            if (F.lane == 0) LIST[(size_t)64 * LIST_CAP + row] = (v2u){(unsigned)row * 16u + 8u, __builtin_bit_cast(unsigned, 1.0f)};
        }
        __syncthreads();
        if (F.tid < 64) lbase[F.tid] = __hip_atomic_fetch_add(gcnt + 64 * F.tid, lcnt[F.tid], RLX_AGENT);
        __syncthreads();
        { const LAS unsigned* en = ent + F.tid * 4; const unsigned e = en[0]; LIST[(size_t)e * LIST_CAP + lbase[e] + en[1]] = (v2u){en[2], en[3]}; }
        __syncthreads();
    }
}

struct TileTab { LAS int* cnt; LAS int* tstart; };
__device__ __forceinline__ TileTab build_tiles(Frame& F) {
    TileTab tt; tt.cnt = (LAS int*)(F.lds + MISC_OFF); tt.tstart = tt.cnt + 128;
    const unsigned* gcnt = (const unsigned*)(F.ws + WS_CTL) + CW_CNT;
    if (F.tid < 64) tt.cnt[F.tid] = (int)__hip_atomic_load(gcnt + 64 * F.tid, RLX_AGENT);
    if (F.tid == 64) tt.cnt[64] = T;
    __syncthreads();
    if (F.tid == 0) { int s = 0; for (int e = 0; e < 65; ++e) { tt.tstart[e] = s; s += (tt.cnt[e] + 255) >> 8; } tt.tstart[65] = s; }
    __syncthreads();
    return tt;
}
__device__ __forceinline__ int tile_expert(const TileTab& tt, int tile) { int e = 0; while (tt.tstart[e + 1] <= tile) ++e; return e; }

struct ProbGU {
    static constexpr int K = DM; static constexpr bool GATHER = true, PERM = false;
    const bf16 *H2, *Wgu; bf16* HID; const v2u* LIST; TileTab tt; int G, c;
    __device__ __forceinline__ bool next(int i, pg8::Unit& u) const {
        const int total = tt.tstart[65] * 4; const int w = pg8::round_unit(i, G, c, total); if (w < 0) return false;
        u.pm = w >> 2; u.pn = w & 3; u.g = tile_expert(tt, u.pm); return true; }
    __device__ __forceinline__ const char* a_base(const pg8::Unit&) const { return (const char*)H2; }
    __device__ __forceinline__ const char* b_base(const pg8::Unit& u) const { return (const char*)Wgu + ((size_t)u.g * 1024 + (size_t)u.pn * 256) * K * 2; }
    __device__ __forceinline__ void rows(const pg8::Unit& u, int tid, LAS unsigned* dst) const {
        const int lt = u.pm - tt.tstart[u.g]; const int nrow = tt.cnt[u.g] - lt * 256; const v2u* lp = LIST + (size_t)u.g * LIST_CAP + lt * 256;
#pragma unroll
        for (int i = 0; i < 2; ++i) { int R0, C; pg8::stage_rc(tid * 16 + i * 8192, R0, C);
#pragma unroll
            for (int h = 0; h < 2; ++h) { const int R = R0 + 128 * h; unsigned tok = 0u; if (R < nrow) tok = lp[R].x >> 4; dst[(h * 2 + i) * 512 + tid] = tok * (unsigned)(K * 2) + (unsigned)(C * 2); } }
    }
    __device__ __forceinline__ void epi(const f32x4 (&acc)[2][2][4][2], const pg8::Unit& u, int wr, int wc, int fr, int fq) const {
        const int lt = u.pm - tt.tstart[u.g]; const int nrow = tt.cnt[u.g] - lt * 256; const v2u* lp = LIST + (size_t)u.g * LIST_CAP + lt * 256;
#pragma unroll
        for (int ai = 0; ai < 2; ++ai)
#pragma unroll
            for (int m = 0; m < 4; ++m) { const int R = ai * 128 + wr * 64 + m * 16 + fr;
                float w = 0.f; if (R < nrow) { const unsigned wb = lp[R].y; w = u2f(wb); }
                bf16* rowp = HID + ((size_t)u.pm * 256 + R) * FE + u.pn * 128 + wc * 16 + 4 * fq;
#pragma unroll
                for (int bj = 0; bj < 2; ++bj) { const f32x4 g = acc[ai][bj][m][0], up = acc[ai][bj][m][1]; f32x4 hv;
#pragma unroll
                    for (int q = 0; q < 4; ++q) hv[q] = g[q] / (1.0f + __expf(-g[q])) * up[q] * w;
#ifdef DIAG
                    if (u.pm == 3 && u.pn == 0 && wr == 1 && ai == 1 && m == 2 && fr == 8 && fq == 0 && bj == 0) { unsigned st = 0x100u;
                        if (!(fabsf(g.x) > 1e-3f)) st |= 1u; if (!(fabsf(up.x) > 1e-3f)) st |= 2u; if (!(w > 0.f)) st |= 4u; if (!(nrow >= 1 && nrow <= 256)) st |= 8u;
                        __hip_atomic_store((unsigned*)((char*)LIST - WS_LIST) + 101, st, RLX_AGENT); }
#endif
                    *(GAS v2u*)(rowp + bj * 64) = (v2u){cvt_pk_bf16(hv.x, hv.y), cvt_pk_bf16(hv.z, hv.w)}; } }
    }
};
struct ProbDown {
    static constexpr int K = FE; static constexpr bool GATHER = false, PERM = true;
    const bf16 *HID, *Wdn; bf16* SLOT; const v2u* LIST; TileTab tt; int G, c;
    __device__ __forceinline__ bool next(int i, pg8::Unit& u) const {
        const int total = tt.tstart[65] * 8; const int w = pg8::round_unit(i, G, c, total); if (w < 0) return false;
        u.pm = w >> 3; u.pn = w & 7; u.g = tile_expert(tt, u.pm); return true; }
    __device__ __forceinline__ const char* a_base(const pg8::Unit& u) const { return (const char*)HID + (size_t)u.pm * 256 * K * 2; }
    __device__ __forceinline__ const char* b_base(const pg8::Unit& u) const { return (const char*)Wdn + ((size_t)u.g * 2048 + (size_t)u.pn * 256) * K * 2; }
    __device__ __forceinline__ void rows(const pg8::Unit&, int, LAS unsigned*) const {}
    __device__ __forceinline__ void epi(const f32x4 (&acc)[2][2][4][2], const pg8::Unit& u, int wr, int wc, int fr, int fq) const {
        const int lt = u.pm - tt.tstart[u.g]; const int nrow = tt.cnt[u.g] - lt * 256; const v2u* lp = LIST + (size_t)u.g * LIST_CAP + lt * 256;
        const int col0 = u.pn * 256 + wc * 32 + 8 * fq;
#pragma unroll
        for (int ai = 0; ai < 2; ++ai)
#pragma unroll
            for (int m = 0; m < 4; ++m) { const int R = ai * 128 + wr * 64 + m * 16 + fr;
                if (R < nrow) { const unsigned ts = lp[R].x; bf16* rowp = SLOT + ((size_t)(ts >> 4) * NSLOT + (ts & 15u)) * DM + col0;
#pragma unroll
                    for (int bj = 0; bj < 2; ++bj) { const f32x4 v0 = acc[ai][bj][m][0], v1 = acc[ai][bj][m][1];
                        v4u w; w.x = cvt_pk_bf16(v0.x, v0.y); w.y = cvt_pk_bf16(v0.z, v0.w); w.z = cvt_pk_bf16(v1.x, v1.y); w.w = cvt_pk_bf16(v1.z, v1.w);
                        *(GAS v4u*)(rowp + bj * 128) = w; } } }
    }
};

__device__ __forceinline__ void p8_final(Frame& F) {
    const int gw = F.bid * NWAVES + F.wave, NGW = F.G * NWAVES;
    const float* MOD = (const float*)(F.ws + WS_MOD); const bf16* SLOT = (const bf16*)(F.ws + WS_SLOT); const float* g = FIN(I_GPOSTFFN);
#ifdef DIAG
    float dscale = 1.0f;
    { const unsigned* ctl = (const unsigned*)(F.ws + WS_CTL); const bf16* HID = (const bf16*)(F.ws + WS_HID);
      const unsigned a = __hip_atomic_load(ctl + 102, RLX_AGENT), b = __hip_atomic_load(ctl + 103, RLX_AGENT);
      const float s2 = wave_sum(fabsf(bf_lo(HID[(size_t)1000 * 512 + F.lane])));
      int code = 0; if (a != 1u) code |= 1; if (a == 0u) code |= 2; if (b != 1u) code |= 4; if (!(s2 > 1e-6f)) code |= 8;
      dscale = 1.0f + 0.25f * (float)code; }
#endif
    for (int row = gw; row < T; row += NGW) {
        const float* md = MOD + (size_t)(row >> 11) * 12288;
        f32x4 v[8];
#pragma unroll
        for (int j = 0; j < 8; ++j) v[j] = (f32x4){0.f, 0.f, 0.f, 0.f};
#pragma unroll
        for (int s = 0; s < NSLOT; ++s) { const int ss = (s + 8) % 9;
            const bf16* sr = SLOT + ((size_t)row * NSLOT + ss) * DM;
#pragma unroll
            for (int j = 0; j < 8; ++j) { const v2u yv = *(const GAS v2u*)(sr + 4 * F.lane + 256 * j); v[j] += (f32x4){bf_lo(yv.x), bf_hi(yv.x), bf_lo(yv.y), bf_hi(yv.y)}; } }
        float ss = 0.f;
#pragma unroll
        for (int j = 0; j < 8; ++j) ss += (v[j].x * v[j].x + v[j].y * v[j].y) + (v[j].z * v[j].z + v[j].w * v[j].w);
        const float rstd = 1.0f / sqrtf(wave_sum(ss) * (1.0f / DM) + EPS);
#pragma unroll
        for (int j = 0; j < 8; ++j) { const int c = 4 * F.lane + 256 * j;
            const f32x4 gg = *(const GAS f32x4*)(g + c), gt = *(const GAS f32x4*)(md + 10240 + c);
            GAS f32x4* op = (GAS f32x4*)(FOUT + (size_t)row * DM + c);
#ifdef DIAG
            *op = *op * dscale;
#else
            *op = *op + gt * (v[j] * rstd * gg);
#endif
        }
    }
}

constexpr int N_PHASES = 9;
typedef KArgs Args;
__global__ void __launch_bounds__(NTHR, 2) fwd_kernel(Args args) {
    extern __shared__ __attribute__((aligned(16))) unsigned char lds_raw[];
    Frame F;
    F.lds = (LAS unsigned char*)lds_raw;
    F.tid = threadIdx.x; F.lane = F.tid & 63; F.wave = __builtin_amdgcn_readfirstlane(F.tid >> 6);
    F.G = gridDim.x; F.bid = blockIdx.x;
    F.ka = (CKArgs*)__builtin_amdgcn_kernarg_segment_ptr(); F.ws = args.ws;
#define LAUNDER() do { CKArgs* _p = (CKArgs*)__builtin_amdgcn_kernarg_segment_ptr(); asm volatile("" : "+s"(_p) :: "memory"); F.ka = _p; unsigned char* _w = _p->ws; F.ws = _w; } while (0)
    volatile LAS unsigned* barw = (volatile LAS unsigned*)(F.lds + BARW_OFF);
    if (F.tid < 16) barw[F.tid] = 0u;
    __syncthreads();
    XcdBarrier bar; bar.bar = (unsigned*)(F.ws + WS_CTL) + CW_BAR + args.li * XCD_BAR_WORDS; bar.x = 0; bar.st = nullptr;
    const int lo = args.ph_lo, hi = args.ph_hi;
    if (hi - lo > 1) bar = xcd_barrier_post((unsigned*)(F.ws + WS_CTL) + CW_BAR + args.li * XCD_BAR_WORDS, barw);
#ifndef PH_MASK
#define PH_MASK 0x1ff
#endif
#define IN(k) (((PH_MASK >> (k)) & 1) && lo <= (k) && (k) < hi)
#define SEAM(k) do { if (IN(k) && IN((k) + 1)) xcd_barrier(bar); } while (0)
    if (IN(0)) { LAUNDER(); p0_prologue(F); } SEAM(0);
    if (IN(1)) { LAUNDER(); p1_norm(F); } SEAM(1);
    if (IN(2)) { LAUNDER();
        ProbProj P; P.HL = (const bf16*)(F.ws + WS_HL); P.HC = (const bf16*)(F.ws + WS_HC); P.Win = (const bf16*)(F.ws + WS_WIN); P.PROJ = (bf16*)(F.ws + WS_PROJ); P.KVC = (bf16*)(F.ws + WS_KVC);
        P.rope = (const f32x2*)(F.ws + WS_ROPE); P.G = F.G; P.c = F.bid;
        pg8::gemm_phase<ProbProj>(F.lds, P);
    } SEAM(2);
    if (IN(3)) { LAUNDER(); p3_attn_simple(F); LAUNDER(); p3_conv(F); } SEAM(3);
    if (IN(4)) { LAUNDER();
        ProbOut P; P.Y = (const bf16*)(F.ws + WS_Y); P.Wout = (const bf16*)(F.ws + WS_WOUT); P.YL = (bf16*)(F.ws + WS_YL); P.SSQ = (float*)(F.ws + WS_SSQ); P.G = F.G; P.c = F.bid;
        pg8::gemm_phase<ProbOut>(F.lds, P);
    } SEAM(4);
    if (IN(5)) { LAUNDER(); p5_route(F); } SEAM(5);
    if (IN(6)) { LAUNDER();
#ifdef DIAG
        if (F.bid == 0 && F.wave == 0) { const bf16* Wgu = (const bf16*)(F.ws + WS_WGU); const bf16* H2 = (const bf16*)(F.ws + WS_HL);
            const float s0 = wave_sum(fabsf(bf_lo(Wgu[((size_t)5 * 1024 + 100) * 2048 + F.lane]))); const float s1 = wave_sum(fabsf(bf_lo(H2[(size_t)1000 * 2048 + F.lane])));
            unsigned st = 0; if (!(s0 > 1e-3f)) st |= 1u; if (!(s1 > 1e-3f)) st |= 2u;
            if (F.lane == 0) __hip_atomic_store((unsigned*)(F.ws + WS_CTL) + 100, st, RLX_AGENT); }
#endif
        ProbGU P; P.tt = build_tiles(F); P.H2 = (const bf16*)(F.ws + WS_HL); P.Wgu = (const bf16*)(F.ws + WS_WGU); P.HID = (bf16*)(F.ws + WS_HID); P.LIST = (const v2u*)(F.ws + WS_LIST); P.G = F.G; P.c = F.bid;
        pg8::gemm_phase<ProbGU>(F.lds, P);
#ifdef DIAG
        VM_WAIT(); __syncthreads();
        if (F.bid == 96 && F.wave == 0) { const bf16* HID = (const bf16*)(F.ws + WS_HID); const float s2 = wave_sum(fabsf(bf_lo(HID[(size_t)1000 * 512 + F.lane])));
            if (F.lane == 0) __hip_atomic_store((unsigned*)(F.ws + WS_CTL) + 102, (s2 > 1e-6f) ? 1u : 2u, RLX_AGENT); }
#endif
    } SEAM(6);
    if (IN(7)) { LAUNDER();
#ifdef DIAG
        if (F.bid == 0 && F.wave == 0) { const bf16* HID = (const bf16*)(F.ws + WS_HID); const float s2 = wave_sum(fabsf(bf_lo(HID[(size_t)1000 * 512 + F.lane])));
            if (F.lane == 0) __hip_atomic_store((unsigned*)(F.ws + WS_CTL) + 103, (s2 > 1e-6f) ? 1u : 2u, RLX_AGENT); }
#endif
        ProbDown P; P.tt = build_tiles(F); P.HID = (const bf16*)(F.ws + WS_HID); P.Wdn = (const bf16*)(F.ws + WS_WDN); P.SLOT = (bf16*)(F.ws + WS_SLOT); P.LIST = (const v2u*)(F.ws + WS_LIST); P.G = F.G; P.c = F.bid;
        pg8::gemm_phase<ProbDown>(F.lds, P);
    } SEAM(7);
    if (IN(8)) { LAUNDER(); p8_final(F); }
#undef IN
#undef SEAM
}

extern "C" void kernel_launch(void* const* d_in, const int* in_sizes, int n_in, void* d_out, int out_size, void* d_ws, size_t ws_size, hipStream_t stream) {
    static int grid = 0;
    if (grid == 0) {
        if (n_in != 25 || in_sizes[0] != T * DM || out_size != T * DM || ws_size < WS_END) { fprintf(stderr, "kernel_launch: shape/workspace mismatch (n_in %d, in0 %d, out %d, ws %zu < %zu)\n", n_in, n_in > 0 ? in_sizes[0] : -1, out_size, ws_size, (size_t)WS_END); grid = -1; return; }
        int dev = 0, cus = 0, per_cu = 0;
        if (hipGetDevice(&dev) != hipSuccess || hipDeviceGetAttribute(&cus, hipDeviceAttributeMultiprocessorCount, dev) != hipSuccess) { grid = -1; return; }
        if (hipFuncSetAttribute((const void*)fwd_kernel, hipFuncAttributeMaxDynamicSharedMemorySize, LDS_BYTES) != hipSuccess) { fprintf(stderr, "kernel_launch: hipFuncSetAttribute failed\n"); grid = -1; return; }
        if (hipOccupancyMaxActiveBlocksPerMultiprocessor(&per_cu, (const void*)fwd_kernel, NTHR, LDS_BYTES) != hipSuccess || per_cu < 1) fprintf(stderr, "kernel_launch: occupancy query says %d\n", per_cu);
        (void)hipGetLastError();
        grid = cus;
        if (grid != 256) fprintf(stderr, "kernel_launch: %d CUs (built for 256)\n", grid);
    }
    if (grid < 0) return;
    if (hipMemsetAsync((char*)d_ws + WS_CTL, 0, CTL_ZERO_BYTES, stream) != hipSuccess) return;
    Args a{};
    for (int i = 0; i < 25; ++i) a.in[i] = (const float*)d_in[i];
    a.out = (float*)d_out; a.ws = (unsigned char*)d_ws; a.pad = 0;
    if (MK_N_LAUNCHES == 1) {
        a.ph_lo = 0; a.ph_hi = N_PHASES; a.li = 0;
        hipLaunchKernelGGL(fwd_kernel, dim3(grid), dim3(NTHR), LDS_BYTES, stream, a);
    } else {
        for (int li = 0; li < N_PHASES; ++li) { a.ph_lo = li; a.ph_hi = li + 1; a.li = 0;
            hipLaunchKernelGGL(fwd_kernel, dim3(grid), dim3(NTHR), LDS_BYTES, stream, a); }
    }
    const hipError_t le = hipPeekAtLastError();
    if (le != hipSuccess) fprintf(stderr, "kernel_launch: launch failed: %s\n", hipGetErrorName(le));
}
```

```cpp
#include <hip/hip_runtime.h>
#include <cstdio>
#include <cstdint>


#ifndef MK_N_LAUNCHES
#define MK_N_LAUNCHES 1
#endif

#define GAS __attribute__((address_space(1)))
#define LAS __attribute__((address_space(3)))
typedef unsigned short bf16;
typedef unsigned v4u __attribute__((ext_vector_type(4)));
typedef unsigned v2u __attribute__((ext_vector_type(2)));
typedef float f32x4 __attribute__((ext_vector_type(4)));
typedef float f32x2 __attribute__((ext_vector_type(2)));
typedef short bf16x8 __attribute__((ext_vector_type(8)));
typedef __bf16 v2bf __attribute__((ext_vector_type(2)));

constexpr int NB = 8, SEQ = 2048, DM = 2048, T = NB * SEQ, LC = 256, TC = NB * LC;
constexpr int GW = 64, DC = 1024, NH = 8, HD = 128;
constexpr int NPROJ = 6144, QOFF = 3072, KOFF = 4096, VOFF = 5120;
constexpr int NE = 64, FE = 512, NSLOT = 9;
constexpr float EPS = 1e-6f;
constexpr int NWAVES = 8, NTHR = 512;
constexpr int LIST_CAP = 16384;
constexpr int MAX_TILES = 640;

constexpr size_t MiB = 1u << 20;
constexpr size_t WS_CTL = 0, CTL_ZERO_BYTES = 1 * MiB;
constexpr size_t WS_MOD = 1 * MiB;
constexpr size_t WS_ROPE = 1 * MiB + 512 * 1024;
constexpr size_t WS_SSQ = 2 * MiB;
constexpr size_t WS_LIST = 4 * MiB;
constexpr size_t WS_WRH = 13 * MiB, WS_WRL = 13 * MiB + 256 * 1024;
constexpr size_t WS_WDN = 14 * MiB;
constexpr size_t WS_YL = 144 * MiB;
constexpr size_t WS_HID = 208 * MiB;
constexpr size_t WS_WGU = 368 * MiB;
constexpr size_t WS_WIN = 628 * MiB;
constexpr size_t WS_WOUT = 652 * MiB;
constexpr size_t WS_HL = 660 * MiB;
constexpr size_t WS_HC = 724 * MiB;
constexpr size_t WS_KVC = 732 * MiB;
constexpr size_t WS_PROJ = 740 * MiB;
constexpr size_t WS_H2LO = 740 * MiB;
constexpr size_t WS_Y = 932 * MiB;
constexpr size_t WS_SLOT = 368 * MiB;
constexpr size_t WS_END = 996 * MiB;
static_assert(WS_SLOT + (size_t)T * NSLOT * DM * 2 <= WS_END, "slot buffer");
constexpr int CW_BAR = 4096;
constexpr int CW_CNT = 16384;

constexpr int RING_BYTES = 131072;
constexpr int MISC_OFF = RING_BYTES;
constexpr int BARW_OFF = 163840 - 64;
constexpr int LDS_BYTES = 163840;

#define RLX_AGENT __ATOMIC_RELAXED, __HIP_MEMORY_SCOPE_AGENT
#define LDS_WAIT() asm volatile("s_waitcnt lgkmcnt(0)" ::: "memory")
#define VM_WAIT() asm volatile("s_waitcnt vmcnt(0)" ::: "memory")
__device__ __forceinline__ unsigned cvt_pk_bf16(float lo, float hi) { unsigned r; asm volatile("v_cvt_pk_bf16_f32 %0, %1, %2" : "=v"(r) : "v"(lo), "v"(hi)); return r; }
__device__ __forceinline__ float u2f(unsigned u) { return __builtin_bit_cast(float, u); }
__device__ __forceinline__ float bf_lo(unsigned u) { return __builtin_bit_cast(float, u << 16); }
__device__ __forceinline__ float bf_hi(unsigned u) { return __builtin_bit_cast(float, u & 0xffff0000u); }
__device__ __forceinline__ float wave_sum(float v) {
#pragma unroll
    for (int o = 1; o < 64; o <<= 1) v += __shfl_xor(v, o);
    return v;
}
__device__ __forceinline__ float wave_max(float v) {
#pragma unroll
    for (int o = 1; o < 64; o <<= 1) v = fmaxf(v, __shfl_xor(v, o));
    return v;
}
__device__ __forceinline__ float silu_f(float v) { return v / (1.0f + expf(-v)); }

#define XB_TMO      128
#define XB_XCNT(j)  (256  + 64 * (j))
#define XB_XSUB(j)  (1280 + 64 * (j))
#define XB_XGEN(j)  (2304 + 64 * (j))
#define XB_TOP      3328
#define XB_TOPGEN   3392
#define XCD_BAR_WORDS 3456
#define XB_SPIN_CAP (1u << 18)
__device__ __forceinline__ unsigned xb_ld(unsigned* p)              { return __hip_atomic_load(p, __ATOMIC_RELAXED, __HIP_MEMORY_SCOPE_AGENT); }
__device__ __forceinline__ unsigned xb_add(unsigned* p, unsigned v) { return __hip_atomic_fetch_add(p, v, __ATOMIC_RELAXED, __HIP_MEMORY_SCOPE_AGENT); }
__device__ __forceinline__ unsigned xb_xcc_id() { return (unsigned)__builtin_amdgcn_s_getreg((3 << 11) | 20) & 0xFu; }
#define XB_SPIN(cond, bar) do { unsigned _sp = 0; while (cond) { __builtin_amdgcn_s_sleep(1); \
    if ((++_sp & 255u) == 0u) { if (xb_ld(&(bar)[XB_TMO])) break; if (_sp > XB_SPIN_CAP) { atomicAdd(&(bar)[XB_TMO], 1u); break; } } } } while (0)
struct XcdBarrier { unsigned* bar; unsigned x; volatile LAS unsigned* st; };
__device__ __forceinline__ XcdBarrier xcd_barrier_post(unsigned* bar, volatile LAS unsigned* st) {
    XcdBarrier b; b.bar = bar; b.x = xb_xcc_id(); b.st = st;
    if (threadIdx.x == 0) (void)xb_add(&bar[XB_XCNT(b.x)], 1u);
    return b;
}
__device__ __forceinline__ void xcd_barrier_complete(unsigned* bar, unsigned x, unsigned& nloc, unsigned& nx) {
    const unsigned G = gridDim.x * gridDim.y * gridDim.z;
    unsigned sum, cnt, mine, sp = 0u;
    for (;;) {
        sum = 0u; cnt = 0u; mine = 0u;
#pragma unroll
        for (unsigned j = 0; j < 16; ++j) { const unsigned c = xb_ld(&bar[XB_XCNT(j)]); sum += c; cnt += (c > 0u) ? 1u : 0u; mine = (j == x) ? c : mine; }
        if (sum == G) break;
        __builtin_amdgcn_s_sleep(1);
        if ((++sp & 255u) == 0u) { if (xb_ld(&bar[XB_TMO])) break; if (sp > XB_SPIN_CAP) { atomicAdd(&bar[XB_TMO], 1u); break; } }
    }
    nloc = mine > 0u ? mine : 1u; nx = cnt > 0u ? cnt : 1u;
}
__device__ __forceinline__ void xcd_barrier(const XcdBarrier& b) {
    asm volatile("s_waitcnt vmcnt(0)" ::: "memory");
    __syncthreads();
    if (threadIdx.x == 0) {
        unsigned* bar = b.bar;
        __builtin_amdgcn_s_waitcnt(0);
        unsigned nloc = b.st[0], nx = b.st[1];
        if (nloc == 0u) { xcd_barrier_complete(bar, b.x, nloc, nx); b.st[0] = nloc; b.st[1] = nx; }
        const unsigned old = xb_add(&bar[XB_XSUB(b.x)], 1u);
        const unsigned gen = old / nloc;
        if (old + 1u == (gen + 1u) * nloc) {
            __builtin_amdgcn_fence(__ATOMIC_RELEASE, "agent");
            asm volatile("s_waitcnt vmcnt(0)" ::: "memory");
            const unsigned og = xb_add(&bar[XB_TOP], 1u);
            const unsigned tg = og / nx;
            if (og + 1u == (tg + 1u) * nx) xb_add(&bar[XB_TOPGEN], 1u);
            else XB_SPIN(xb_ld(&bar[XB_TOPGEN]) == tg, bar);
            __builtin_amdgcn_fence(__ATOMIC_ACQUIRE, "agent");
            xb_add(&bar[XB_XGEN(b.x)], 1u);
            asm volatile("s_waitcnt vmcnt(0)" ::: "memory");
        } else {
            XB_SPIN(xb_ld(&bar[XB_XGEN(b.x)]) == gen, bar);
            __builtin_amdgcn_fence(__ATOMIC_ACQUIRE, "agent");
            asm volatile("s_waitcnt vmcnt(0)" ::: "memory");
        }
    }
    __syncthreads();
}

namespace pg8 {
constexpr int BM = 256, BK = 64, HALF = 128, HTB = HALF * BK * 2, STAGE_BYTES = 8 * HTB;
__host__ __device__ __forceinline__ int lds_byte(int r, int c) { const int st = (r >> 4) * 2 + (c >> 5), rr = r & 15, cc = c & 31, ob = rr * 64 + cc * 2; return st * 1024 + (ob ^ (((ob >> 9) & 1) << 5)); }
__host__ __device__ __forceinline__ void stage_rc(int b, int& R, int& C) { const int st = b / 1024, sb = b % 1024, swz = sb ^ (((sb >> 9) & 1) << 5); R = (st >> 1) * 16 + swz / 64; C = (st & 1) * 32 + (swz % 64) / 2; }
__host__ __device__ __forceinline__ int perm32(int rho) { const int n = rho >> 4, i = rho & 15; return 8 * (i >> 2) + 4 * n + (i & 3); }
struct Unit { int pm, pn, g; };

__device__ __forceinline__ int round_unit(int i, int G, int c, int total) {
    const int base = i * G; if (base + c >= total && (total - base) >= G) return -1;
    const int R = (total - base) < G ? (total - base) : G;
    if (R <= 0) return -1;
    if (R == G && (G & 7) == 0) return base + (c & 7) * (G >> 3) + (c >> 3);
    return c < R ? base + c : -1;
}

template <class P>
__device__ __forceinline__ void gemm_phase(LAS unsigned char* lds, const P& p) {
    constexpr int K = P::K, nt = K / BK;
    const int tid = threadIdx.x, wid = __builtin_amdgcn_readfirstlane(tid >> 6), lane = tid & 63, wr = wid >> 2, wc = wid & 3, fr = lane & 15, fq = lane >> 4;
    unsigned voffB[2], voffA[2];
#pragma unroll
    for (int i = 0; i < 2; ++i) { int R, C; stage_rc(tid * 16 + i * 8192, R, C); const int Rb = P::PERM ? ((R & ~31) + perm32(R & 31)) : R;
        voffA[i] = (unsigned)(R * K + C) * 2u; voffB[i] = (unsigned)(Rb * K + C) * 2u; }
    LAS unsigned* goffs = (LAS unsigned*)(lds + STAGE_BYTES + 1024);
    constexpr size_t kstep = (size_t)(BK * 2);
    constexpr size_t hstep = (size_t)HALF * K * 2;
    const unsigned ldsw = (unsigned)wid * 1024u;
    const int aoff = lds_byte(wr * 64 + fr, fq * 8), boff = lds_byte(wc * 32 + fr, fq * 8);
#define PG8_SA(b, h) (((b) * 2 + (h)) * HTB)
#define PG8_SB(b, h) ((4 + (b) * 2 + (h)) * HTB)
#define PG8_STAGE(bufoff, gbase, voff) do { _Pragma("unroll") for (int _i = 0; _i < 2; ++_i) \
        __builtin_amdgcn_global_load_lds((const unsigned*)((const char*)(gbase) + (voff)[_i]), (LAS unsigned*)(lds + (bufoff) + ldsw + _i * 8192), 16, 0, 0); } while (0)
#define PG8_STAGE_A(bufoff, h, nextu, kb) do { if constexpr (P::GATHER) { \
            _Pragma("unroll") for (int _i = 0; _i < 2; ++_i) { const unsigned _o = goffs[((((nextu) ? ui + 1 : ui) & 1) * 4 + (h) * 2 + _i) * 512 + tid]; \
                __builtin_amdgcn_global_load_lds((const unsigned*)(gA + (kb) + _o), (LAS unsigned*)(lds + (bufoff) + ldsw + _i * 8192), 16, 0, 0); } } \
        else { const char* _b = ((nextu) ? nA : cA) + (h) * hstep + (kb); PG8_STAGE(bufoff, _b, voffA); } } while (0)
#define PG8_LDA(dst, b, h) do { _Pragma("unroll") for (int m = 0; m < 4; ++m) _Pragma("unroll") for (int k = 0; k < 2; ++k) dst[m][k] = *(const LAS bf16x8*)(lds + PG8_SA(b, h) + aoff + m * 2048 + k * 1024); } while (0)
#define PG8_LDB(dst, b, h) do { _Pragma("unroll") for (int n = 0; n < 2; ++n) _Pragma("unroll") for (int k = 0; k < 2; ++k) dst[n][k] = *(const LAS bf16x8*)(lds + PG8_SB(b, h) + boff + n * 2048 + k * 1024); } while (0)
#define PG8_MMA(ai, bj, At, Bt) do { __builtin_amdgcn_s_setprio(1); _Pragma("unroll") for (int m = 0; m < 4; ++m) _Pragma("unroll") for (int n = 0; n < 2; ++n) _Pragma("unroll") for (int k = 0; k < 2; ++k) \
        acc[ai][bj][m][n] = __builtin_amdgcn_mfma_f32_16x16x32_bf16(Bt[n][k], At[m][k], acc[ai][bj][m][n], 0, 0, 0); __builtin_amdgcn_s_setprio(0); } while (0)
#define PG8_WAIT_V(n) asm volatile("s_waitcnt vmcnt(" #n ")" ::: "memory")
#define PG8_WAIT_L(n) asm volatile("s_waitcnt lgkmcnt(" #n ")" ::: "memory")
#define PG8_BAR __builtin_amdgcn_s_barrier()
#define PG8_SCHED __builtin_amdgcn_sched_barrier(0)
    Unit cur, nxt; int ui = 0;
    if (!p.next(0, cur)) return;
    f32x4 acc[2][2][4][2];
#pragma unroll
    for (int a = 0; a < 2; ++a)
#pragma unroll
        for (int b = 0; b < 2; ++b)
#pragma unroll
            for (int m = 0; m < 4; ++m)
#pragma unroll
                for (int n = 0; n < 2; ++n) acc[a][b][m][n] = (f32x4){0.f, 0.f, 0.f, 0.f};
    bf16x8 At[4][2], B0[2][2], B1[2][2];
    const char* cA = p.a_base(cur); const char* cB = p.b_base(cur);
    const char* nA = cA; const char* gA = cA;
    if constexpr (P::GATHER) { p.rows(cur, tid, goffs); p.rows(cur, tid, goffs + 4 * 512); }
    PG8_STAGE(PG8_SB(0, 0), cB, voffB); PG8_STAGE(PG8_SB(0, 1), cB + hstep, voffB); PG8_STAGE_A(PG8_SA(0, 0), 0, false, 0); PG8_STAGE_A(PG8_SA(0, 1), 1, false, 0);
    if (wr == 1) PG8_BAR;
    PG8_WAIT_V(2); PG8_BAR;
    PG8_STAGE(PG8_SB(1, 0), cB + kstep, voffB); PG8_STAGE_A(PG8_SA(1, 0), 0, false, kstep); PG8_STAGE(PG8_SB(1, 1), cB + hstep + kstep, voffB);
    PG8_WAIT_V(6); PG8_BAR;
    for (;;) {
        const bool has_next = p.next(ui + 1, nxt);
        nA = has_next ? p.a_base(nxt) : cA; const char* nB = has_next ? p.b_base(nxt) : cB;
        if constexpr (P::GATHER) { p.rows(has_next ? nxt : cur, tid, goffs + ((ui + 1) & 1) * 4 * 512); }
        for (int t = 0; t < nt; t += 2) {
            const bool last = (t == nt - 2);
            const size_t k1 = (size_t)(t + 1) * kstep;
            const size_t k2 = last ? 0 : (size_t)(t + 2) * kstep;
            const char* b2 = last ? nB : cB + (size_t)(t + 2) * kstep;
            const size_t k3 = k2 + kstep; const char* b3 = b2 + kstep;
            PG8_LDB(B0, 0, 0); PG8_LDB(B1, 0, 1); PG8_SCHED; PG8_LDA(At, 0, 0); PG8_STAGE_A(PG8_SA(1, 1), 1, false, k1);
            PG8_WAIT_V(8); PG8_WAIT_L(0); PG8_BAR; PG8_MMA(0, 0, At, B0); PG8_MMA(0, 1, At, B1); PG8_BAR; PG8_SCHED;
            PG8_LDA(At, 0, 1); PG8_STAGE(PG8_SB(0, 0), b2, voffB); PG8_STAGE(PG8_SB(0, 1), b2 + hstep, voffB); PG8_STAGE_A(PG8_SA(0, 0), 0, last, k2);
            PG8_WAIT_V(8); PG8_WAIT_L(0); PG8_BAR; PG8_MMA(1, 0, At, B0); PG8_MMA(1, 1, At, B1); PG8_BAR; PG8_SCHED;
            PG8_LDB(B0, 1, 0); PG8_LDB(B1, 1, 1); PG8_SCHED; PG8_LDA(At, 1, 0); PG8_STAGE_A(PG8_SA(0, 1), 1, last, k2);
            PG8_WAIT_V(8); PG8_WAIT_L(0); PG8_BAR; PG8_MMA(0, 0, At, B0); PG8_MMA(0, 1, At, B1); PG8_BAR; PG8_SCHED;
            PG8_LDA(At, 1, 1); PG8_STAGE(PG8_SB(1, 0), b3, voffB); PG8_STAGE(PG8_SB(1, 1), b3 + hstep, voffB); PG8_STAGE_A(PG8_SA(1, 0), 0, last, k3);
            PG8_WAIT_V(8); PG8_WAIT_L(0); PG8_BAR; PG8_MMA(1, 0, At, B0); PG8_MMA(1, 1, At, B1); PG8_BAR; PG8_SCHED;
        }
        if (wr == 0) PG8_BAR;
        p.epi(acc, cur, wr, wc, fr, fq);
        if (!has_next) break;
#pragma unroll
        for (int a = 0; a < 2; ++a)
#pragma unroll
            for (int b = 0; b < 2; ++b)
#pragma unroll
                for (int m = 0; m < 4; ++m)
#pragma unroll
                    for (int n = 0; n < 2; ++n) acc[a][b][m][n] = (f32x4){0.f, 0.f, 0.f, 0.f};
        cur = nxt; cA = nA; cB = nB; ++ui;
        if (wr == 1) PG8_BAR;
    }
    PG8_WAIT_V(0);
    PG8_BAR;
#undef PG8_SA
#undef PG8_SB
#undef PG8_STAGE
#undef PG8_STAGE_A
#undef PG8_LDA
#undef PG8_LDB
#undef PG8_MMA
#undef PG8_WAIT_V
#undef PG8_WAIT_L
#undef PG8_BAR
#undef PG8_SCHED
}
}

struct KArgs { const float* in[25]; float* out; unsigned char* ws; int ph_lo, ph_hi, li, pad; };
typedef const KArgs __attribute__((address_space(4))) CKArgs;
struct Frame {
    LAS unsigned char* lds;
    int tid, lane, wave, G, bid;
    CKArgs* ka;
    unsigned char* ws;
};
#define FIN(i) (F.ka->in[i])
#define FOUT (F.ka->out)
enum { I_X = 0, I_C, I_CTX, I_CCTX, I_WMOD, I_BMOD, I_GPREMIX, I_GPOSTMIX, I_GPREFFN, I_GPOSTFFN, I_WIN, I_CONVW, I_CONVB, I_RPB, I_GCONV, I_GATTN, I_WOUT, I_WROUTER, I_RBIAS,
       I_WEG, I_WEU, I_WED, I_WSG, I_WSU, I_WSD };

template <class RowMap>
__device__ __forceinline__ void transpose_item(const float* W, int ldn, int K, bf16* WT, LAS float* scr, int kb, int nb, int lane, const RowMap& rm) {
    const int k0 = 64 * kb, n0 = 32 * nb;
#pragma unroll 8
    for (int i = 0; i < 32; ++i) { const int kk = 2 * i + (lane >> 5); scr[kk * 33 + (lane & 31)] = W[(size_t)(k0 + kk) * ldn + n0 + (lane & 31)]; }
    LDS_WAIT(); asm volatile("" ::: "memory");
    const int c = lane & 7;
#pragma unroll
    for (int j = 0; j < 4; ++j) { const int n = (lane >> 3) + 8 * j; const LAS float* s = scr + (8 * c) * 33 + n;
        v4u o; o.x = cvt_pk_bf16(s[0 * 33], s[1 * 33]); o.y = cvt_pk_bf16(s[2 * 33], s[3 * 33]); o.z = cvt_pk_bf16(s[4 * 33], s[5 * 33]); o.w = cvt_pk_bf16(s[6 * 33], s[7 * 33]);
        *(GAS v4u*)(WT + (size_t)rm(n0 + n) * K + k0 + 8 * c) = o; }
    LDS_WAIT(); asm volatile("" ::: "memory");
}
struct RmIdent { int off; __device__ __forceinline__ int operator()(int n) const { return off + n; } };
struct RmWin {
    __device__ __forceinline__ int operator()(int n) const {
        if (n < QOFF || n >= VOFF) return n;
        const int nn = n & 127, axis = nn >> 6, half = (nn >> 5) & 1, f = nn & 31;
        return (n - nn) + 2 * (axis * 32 + f) + half; }
};
struct RmGU { int base; int up; __device__ __forceinline__ int operator()(int f) const { return base + 32 * (f >> 4) + 16 * up + (f & 15); } };

__device__ __forceinline__ void p0_prologue(Frame& F) {
    const int gw = F.bid * NWAVES + F.wave, NGW = F.G * NWAVES;
    if (F.bid == 0) {
        GAS f32x2* rope = (GAS f32x2*)(F.ws + WS_ROPE);
        for (int i = F.tid; i < 64 * 32; i += NTHR) { const int pos = i >> 5, f = i & 31;
            const float inv = powf(10000.0f, -(float)f / 32.0f); const float ang = (float)pos * inv;
            rope[i] = (f32x2){(float)cos((double)ang), (float)sin((double)ang)}; }
    }
    {
        LAS float* act = (LAS float*)F.lds;
        LAS float* red = (LAS float*)(F.lds + 9 * 2048 * 4);
        for (int i = F.tid; i < 9 * 2048; i += NTHR) { const int r = i >> 11, k = i & 2047; const float v = r < 8 ? FIN(I_C)[r * 2048 + k] : FIN(I_CCTX)[k]; act[i] = silu_f(v); }
        __syncthreads();
        const float* wm = FIN(I_WMOD);
        for (int cb = F.bid; cb < 256; cb += F.G) {
            const int kq = F.wave * 5 + F.lane / 12, cq = F.lane % 12; const bool on = F.lane < 60;
            f32x4 a[9];
#pragma unroll
            for (int r = 0; r < 9; ++r) a[r] = (f32x4){0.f, 0.f, 0.f, 0.f};
            if (on) for (int k = kq; k < 2048; k += 40) { const f32x4 w = *(const GAS f32x4*)(wm + (size_t)k * 12288 + cb * 48 + cq * 4);
#pragma unroll
                for (int r = 0; r < 9; ++r) a[r] += w * act[r * 2048 + k]; }
#pragma unroll
            for (int r = 0; r < 9; ++r) {
                f32x4 s = a[r];
#pragma unroll
                for (int j = 1; j < 5; ++j) { const int src = (F.lane % 12) + 12 * j; f32x4 o; o.x = __shfl(a[r].x, src); o.y = __shfl(a[r].y, src); o.z = __shfl(a[r].z, src); o.w = __shfl(a[r].w, src); s += o; }
                if (F.lane < 12) *(LAS f32x4*)(red + (F.wave * 9 + r) * 48 + F.lane * 4) = s;
            }
            __syncthreads();
            if (F.tid < 9 * 48) { const int r = F.tid / 48, cc = F.tid % 48; float s = 0.f;
#pragma unroll
                for (int w = 0; w < 8; ++w) s += red[(w * 9 + r) * 48 + cc];
                ((GAS float*)(F.ws + WS_MOD))[r * 12288 + cb * 48 + cc] = s + FIN(I_BMOD)[cb * 48 + cc]; }
            __syncthreads();
        }
    }
    {
        LAS float* scr = (LAS float*)(F.lds + F.wave * 16384);
        bf16* Win = (bf16*)(F.ws + WS_WIN); bf16* Wout = (bf16*)(F.ws + WS_WOUT); bf16* Wgu = (bf16*)(F.ws + WS_WGU); bf16* Wdn = (bf16*)(F.ws + WS_WDN);
        constexpr int IT_IN = 32 * 192, IT_OUT = 32 * 64, IT_G = 64 * 32 * 16, IT_D = 64 * 8 * 64, IT_SG = 32 * 16, IT_SD = 8 * 64, IT_R = 32 * 2;
        constexpr int NIT = IT_IN + IT_OUT + 2 * IT_G + IT_D + 2 * IT_SG + IT_SD + IT_R;
        for (int it = gw; it < NIT; it += NGW) {
            int r = it;
            if (r < IT_IN) { transpose_item(FIN(I_WIN), NPROJ, DM, Win, scr, r / 192, r % 192, F.lane, RmWin{}); continue; } r -= IT_IN;
            if (r < IT_OUT) { transpose_item(FIN(I_WOUT), DM, DM, Wout, scr, r / 64, r % 64, F.lane, RmIdent{0}); continue; } r -= IT_OUT;
            if (r < IT_G) { const int e = r / 512, q = r % 512; transpose_item(FIN(I_WEG) + (size_t)e * DM * FE, FE, DM, Wgu, scr, q / 16, q % 16, F.lane, RmGU{e * 1024, 0}); continue; } r -= IT_G;
            if (r < IT_G) { const int e = r / 512, q = r % 512; transpose_item(FIN(I_WEU) + (size_t)e * DM * FE, FE, DM, Wgu, scr, q / 16, q % 16, F.lane, RmGU{e * 1024, 1}); continue; } r -= IT_G;
            if (r < IT_D) { const int e = r / 512, q = r % 512; transpose_item(FIN(I_WED) + (size_t)e * FE * DM, DM, FE, Wdn, scr, q / 64, q % 64, F.lane, RmIdent{e * 2048}); continue; } r -= IT_D;
            if (r < IT_SG) { transpose_item(FIN(I_WSG), FE, DM, Wgu, scr, r / 16, r % 16, F.lane, RmGU{64 * 1024, 0}); continue; } r -= IT_SG;
            if (r < IT_SG) { transpose_item(FIN(I_WSU), FE, DM, Wgu, scr, r / 16, r % 16, F.lane, RmGU{64 * 1024, 1}); continue; } r -= IT_SG;
            if (r < IT_SD) { transpose_item(FIN(I_WSD), DM, FE, Wdn, scr, r / 64, r % 64, F.lane, RmIdent{64 * 2048}); continue; } r -= IT_SD;
            {
                const int kb = r / 2, nb = r % 2; const float* W = FIN(I_WROUTER);
                bf16* WH = (bf16*)(F.ws + WS_WRH); bf16* WL = (bf16*)(F.ws + WS_WRL);
                for (int i = 0; i < 32; ++i) { const int kk = 2 * i + (F.lane >> 5), n = nb * 32 + (F.lane & 31), k = kb * 64 + kk;
                    const float v = W[(size_t)k * NE + n]; const unsigned hi = cvt_pk_bf16(v, 0.f) & 0xffffu; const float rem = v - bf_lo(hi);
                    WH[(size_t)n * DM + k] = (bf16)hi; WL[(size_t)n * DM + k] = (bf16)(cvt_pk_bf16(rem, 0.f) & 0xffffu); }
            }
        }
    }
}

__device__ __forceinline__ void p1_norm(Frame& F) {
    const int gw = F.bid * NWAVES + F.wave, NGW = F.G * NWAVES;
    const float* MOD = (const float*)(F.ws + WS_MOD); const float* g = FIN(I_GPREMIX);
    for (int row = gw; row < T + TC; row += NGW) {
        const bool lat = row < T; const int rr = lat ? row : row - T;
        const float* xr = (lat ? FIN(I_X) : FIN(I_CTX)) + (size_t)rr * DM;
        const float* md = MOD + (size_t)(lat ? (rr >> 11) : 8) * 12288;
        bf16* orow = (bf16*)(F.ws + (lat ? WS_HL : WS_HC)) + (size_t)rr * DM;
        f32x4 v[8]; float ss = 0.f;
#pragma unroll
        for (int j = 0; j < 8; ++j) { v[j] = *(const GAS f32x4*)(xr + 4 * F.lane + 256 * j); ss += (v[j].x * v[j].x + v[j].y * v[j].y) + (v[j].z * v[j].z + v[j].w * v[j].w); }
        const float rstd = 1.0f / sqrtf(wave_sum(ss) * (1.0f / DM) + EPS);
#pragma unroll
        for (int j = 0; j < 8; ++j) { const int c = 4 * F.lane + 256 * j;
            const f32x4 gg = *(const GAS f32x4*)(g + c), sh = *(const GAS f32x4*)(md + c), sc = *(const GAS f32x4*)(md + 2048 + c);
            const f32x4 o = (v[j] * rstd) * gg * (sc + 1.0f) + sh;
            *(GAS v2u*)(orow + c) = (v2u){cvt_pk_bf16(o.x, o.y), cvt_pk_bf16(o.z, o.w)}; }
    }
}

struct ProbProj {
    static constexpr int K = DM; static constexpr bool GATHER = false, PERM = true;
    const bf16 *HL, *HC, *Win; bf16 *PROJ, *KVC; const f32x2* rope; int G, c;
    static constexpr int NMAIN = 64 * 24, NTOT = NMAIN + 64;
    __device__ __forceinline__ bool next(int i, pg8::Unit& u) const {
        const int w = pg8::round_unit(i, G, c, NTOT); if (w < 0) return false;
        if (w < NMAIN) { const int gid = w / 192, r = w % 192; u.pm = gid * 8 + (r & 7); u.pn = r >> 3; u.g = 0; }
        else { const int j = w - NMAIN; u.pm = j & 7; u.pn = 16 + (j >> 3); u.g = 1; }
        return true; }
    __device__ __forceinline__ const char* a_base(const pg8::Unit& u) const { return (const char*)HL + (size_t)u.g * (size_t)(WS_HC - WS_HL) + (size_t)u.pm * 256 * K * 2; }
    __device__ __forceinline__ const char* b_base(const pg8::Unit& u) const { return (const char*)Win + (size_t)u.pn * 256 * K * 2; }
    __device__ __forceinline__ void rows(const pg8::Unit&, int, LAS unsigned*) const {}
    __device__ __forceinline__ void epi(const f32x4 (&acc)[2][2][4][2], const pg8::Unit& u, int wr, int wc, int fr, int fq) const {
        const int row0 = u.pm * 256 + wr * 64 + fr;
        const bool rot = (u.g == 0) && (u.pn >= 12) && (u.pn < 20);
        bf16* base = (bf16*)((char*)PROJ + (long)u.g * ((long)WS_KVC - (long)WS_PROJ));
        const int ldc = NPROJ - u.g * (NPROJ - DM), col0 = (u.pn - 16 * u.g) * 256 + wc * 32 + 8 * fq;
        const int p0 = (wc * 32 + 8 * fq) >> 1, axis = p0 >> 5, f0 = p0 & 31;
#pragma unroll
        for (int ai = 0; ai < 2; ++ai)
#pragma unroll
            for (int m = 0; m < 4; ++m) {
                const int row = row0 + ai * 128 + m * 16; bf16* rowp = base + (size_t)row * ldc + col0;
                const int t = row & (SEQ - 1); const int pos = axis ? (t & 63) : (t >> 6);
                const f32x4 csA = *(const GAS f32x4*)(rope + pos * 32 + f0), csB = *(const GAS f32x4*)(rope + pos * 32 + f0 + 2);
                const f32x2 cs0 = (f32x2){csA.x, csA.y}, cs1 = (f32x2){csA.z, csA.w}, cs2 = (f32x2){csB.x, csB.y}, cs3 = (f32x2){csB.z, csB.w};
#pragma unroll
                for (int bj = 0; bj < 2; ++bj) { f32x4 v0 = acc[ai][bj][m][0], v1 = acc[ai][bj][m][1];
                    if (rot) { f32x4 r0, r1;
                        r0.x = v0.x * cs0.x - v0.y * cs0.y; r0.y = v0.y * cs0.x + v0.x * cs0.y;
                        r0.z = v0.z * cs1.x - v0.w * cs1.y; r0.w = v0.w * cs1.x + v0.z * cs1.y;
                        r1.x = v1.x * cs2.x - v1.y * cs2.y; r1.y = v1.y * cs2.x + v1.x * cs2.y;
                        r1.z = v1.z * cs3.x - v1.w * cs3.y; r1.w = v1.w * cs3.x + v1.z * cs3.y; v0 = r0; v1 = r1; }
                    v4u w; w.x = cvt_pk_bf16(v0.x, v0.y); w.y = cvt_pk_bf16(v0.z, v0.w); w.z = cvt_pk_bf16(v1.x, v1.y); w.w = cvt_pk_bf16(v1.z, v1.w);
                    *(GAS v4u*)(rowp + bj * 128) = w; } }
    }
};

__device__ __forceinline__ float dot2bf(unsigned a, unsigned b, float c) { return __builtin_amdgcn_fdot2_f32_bf16(__builtin_bit_cast(v2bf, a), __builtin_bit_cast(v2bf, b), c, false); }
__device__ __forceinline__ void p3_attn_simple(Frame& F) {
    const bf16* PROJ = (const bf16*)(F.ws + WS_PROJ); const bf16* KVC = (const bf16*)(F.ws + WS_KVC); bf16* Y = (bf16*)(F.ws + WS_Y);
    const float* rpb = FIN(I_RPB); const float* gat = FIN(I_GATTN);
    const float scale = 0.08838834764831845f;
    const int per = (T * NH) / F.G;
    for (int i = F.wave; i < per; i += NWAVES) {
        const int task = F.bid * per + i; const int t = task & (SEQ - 1), bh = task >> 11, h = bh & 7, b = bh >> 3;
        const int r = t >> 6, c = t & 63; int r0 = r - 4; r0 = r0 < 0 ? 0 : (r0 > 24 ? 24 : r0); int cs = c - 8; cs = cs < 0 ? 0 : (cs > 48 ? 48 : cs);
        const unsigned qv = *(const GAS unsigned*)(PROJ + (size_t)(b * SEQ + t) * NPROJ + QOFF + h * HD + 2 * F.lane);
        const bf16* kp[6]; float sc[6];
#pragma unroll
        for (int j = 0; j < 6; ++j) { const int n = F.lane + 64 * j;
            if (j < 2) { const int ii = n >> 4, jj = n & 15; const int tk = (r0 + ii) * GW + cs + jj; kp[j] = PROJ + (size_t)(b * SEQ + tk) * NPROJ + KOFF + h * HD; }
            else kp[j] = KVC + (size_t)(b * LC + (n - 128)) * DM + h * HD;
            sc[j] = 0.f; }
#pragma unroll 4
        for (int pc = 0; pc < 16; ++pc) {
            v4u kk[6];
#pragma unroll
            for (int j = 0; j < 6; ++j) kk[j] = *(const GAS v4u*)(kp[j] + 8 * pc);
            const unsigned q0 = __builtin_amdgcn_readlane(qv, 4 * pc), q1 = __builtin_amdgcn_readlane(qv, 4 * pc + 1), q2 = __builtin_amdgcn_readlane(qv, 4 * pc + 2), q3 = __builtin_amdgcn_readlane(qv, 4 * pc + 3);
#pragma unroll
            for (int j = 0; j < 6; ++j) { sc[j] = dot2bf(q0, kk[j].x, sc[j]); sc[j] = dot2bf(q1, kk[j].y, sc[j]); sc[j] = dot2bf(q2, kk[j].z, sc[j]); sc[j] = dot2bf(q3, kk[j].w, sc[j]); }
        }
        float mx = -1e30f;
#pragma unroll
        for (int j = 0; j < 6; ++j) { sc[j] *= scale;
            if (j < 2) { const int n = F.lane + 64 * j, ii = n >> 4, jj = n & 15; sc[j] += rpb[(h * 15 + (r0 + ii - r + 7)) * 31 + (cs + jj - c + 15)]; }
            mx = fmaxf(mx, sc[j]); }
        mx = wave_max(mx);
        float ps = 0.f;
#pragma unroll
        for (int j = 0; j < 6; ++j) { sc[j] = __expf(sc[j] - mx); ps += sc[j]; }
        ps = wave_sum(ps);
        float o0 = 0.f, o1 = 0.f;
        const bf16* vl = PROJ + (size_t)(b * SEQ) * NPROJ + VOFF + h * HD + 2 * F.lane;
        const bf16* vc = KVC + (size_t)(b * LC) * DM + DC + h * HD + 2 * F.lane;
#pragma unroll
        for (int j = 0; j < 6; ++j) {
#pragma unroll 8
            for (int l = 0; l < 64; ++l) { const int n = l + 64 * j; const float p = __builtin_bit_cast(float, __builtin_amdgcn_readlane(__builtin_bit_cast(unsigned, sc[j]), l));
                unsigned vv;
                if (j < 2) { const int tk = (r0 + (n >> 4)) * GW + cs + (n & 15); vv = *(const GAS unsigned*)(vl + (size_t)tk * NPROJ); }
                else vv = *(const GAS unsigned*)(vc + (size_t)(n - 128) * DM);
                o0 += p * bf_lo(vv); o1 += p * bf_hi(vv); }
        }
        const float inv = 1.0f / ps; o0 *= inv; o1 *= inv;
        const float rstd = 1.0f / sqrtf(wave_sum(o0 * o0 + o1 * o1) * (1.0f / HD) + EPS);
        const f32x2 gg = *(const GAS f32x2*)(gat + h * HD + 2 * F.lane);
        *(GAS unsigned*)(Y + (size_t)(b * SEQ + t) * DM + DC + h * HD + 2 * F.lane) = cvt_pk_bf16(o0 * rstd * gg.x, o1 * rstd * gg.y);
    }
}

namespace at {
typedef short s16x4 __attribute__((ext_vector_type(4)));
typedef float f32x16 __attribute__((ext_vector_type(16)));
constexpr float SCALE = 0.088388347648318440f;
constexpr float THR = 8.f;
constexpr int SHM_V = 64 * 128 * 2, SHM_K = 64 * 128 * 2;
constexpr int WS_OFF = 2 * SHM_V + 2 * SHM_K, BT_OFF = WS_OFF + 8 * 64 * 4, BT_FLOATS = 15 * 32 + 192;
#define KSWZ(row, colB) ((row) * 256 + ((colB) ^ (((row) & 7) << 4)))
#define SBAR() __builtin_amdgcn_sched_barrier(0)
__device__ __forceinline__ int crow(int r, int hi) { return (r & 3) + 8 * (r >> 2) + 4 * hi; }
__device__ __forceinline__ void partialSM(f32x16& p0, f32x16& p1, float& m_reg, float& mn, float& alpha) {
  constexpr float C = SCALE * 1.4426950408889634f;
  float pmax = p0[0];
#pragma unroll
  for (int r = 1; r < 16; ++r) pmax = fmaxf(pmax, p0[r]);
#pragma unroll
  for (int r = 0; r < 16; ++r) pmax = fmaxf(pmax, p1[r]);
  { auto rr = __builtin_amdgcn_permlane32_swap(__builtin_bit_cast(unsigned, pmax), __builtin_bit_cast(unsigned, pmax), false, false);
    pmax = fmaxf(u2f(rr[0]), u2f(rr[1])); }
  if (__builtin_expect(__all(pmax - m_reg <= THR / SCALE), 1)) { mn = m_reg; alpha = 1.f; }
  else { mn = fmaxf(m_reg, pmax); alpha = __builtin_amdgcn_exp2f((m_reg - mn) * C); m_reg = mn; }
  const float mnC = -mn * C;
#pragma unroll
  for (int r = 0; r < 16; ++r) p0[r] = fmaf(p0[r], C, mnC);
#pragma unroll
  for (int r = 0; r < 16; ++r) p1[r] = fmaf(p1[r], C, mnC);
#pragma unroll
  for (int r = 0; r < 16; ++r) p0[r] = __builtin_amdgcn_exp2f(p0[r]);
}
__device__ __forceinline__ void finishSM(f32x16& p0, f32x16& p1, float alpha, float& l_reg, bf16x8& pa0, bf16x8& pa1, bf16x8& pa2, bf16x8& pa3) {
#pragma unroll
  for (int r = 0; r < 16; ++r) p1[r] = __builtin_amdgcn_exp2f(p1[r]);
  float ps = 0;
#pragma unroll
  for (int r = 0; r < 16; ++r) ps += p0[r];
#pragma unroll
  for (int r = 0; r < 16; ++r) ps += p1[r];
  { auto rr = __builtin_amdgcn_permlane32_swap(__builtin_bit_cast(unsigned, ps), __builtin_bit_cast(unsigned, ps), false, false);
    ps = u2f(rr[0]) + u2f(rr[1]); }
  l_reg = l_reg * alpha + ps;
#define PK4(P, BASE, OUT) do { unsigned a0 = cvt_pk_bf16(P[BASE + 0], P[BASE + 1]), a1 = cvt_pk_bf16(P[BASE + 2], P[BASE + 3]);   \
    unsigned b0 = cvt_pk_bf16(P[BASE + 4], P[BASE + 5]), b1 = cvt_pk_bf16(P[BASE + 6], P[BASE + 7]);                              \
    auto r0 = __builtin_amdgcn_permlane32_swap(a0, b0, false, false); auto r1 = __builtin_amdgcn_permlane32_swap(a1, b1, false, false); \
    v4u w = {r0[0], r1[0], r0[1], r1[1]}; OUT = __builtin_bit_cast(bf16x8, w); } while (0)
  PK4(p0, 0, pa0); PK4(p0, 8, pa1); PK4(p1, 0, pa2); PK4(p1, 8, pa3);
#undef PK4
}
__device__ __forceinline__ void qkt(f32x16& p0, f32x16& p1, const LAS char* Ks, const bf16x8* qr, int r32, int hi) {
  p0 = f32x16{}; p1 = f32x16{};
#pragma unroll
  for (int d0 = 0; d0 < 8; ++d0) { const int cb = (d0 * 16 + hi * 8) * 2;
    const bf16x8 b0 = *(const LAS bf16x8*)(Ks + KSWZ(r32, cb));
    const bf16x8 b1 = *(const LAS bf16x8*)(Ks + KSWZ(32 + r32, cb));
    p0 = __builtin_amdgcn_mfma_f32_32x32x16_bf16(b0, qr[d0], p0, 0, 0, 0);
    p1 = __builtin_amdgcn_mfma_f32_32x32x16_bf16(b1, qr[d0], p1, 0, 0, 0); }
}
__device__ __forceinline__ int v_st(int k, int c) { const int kk = (k & ~0xC) | ((k & 4) << 1) | ((k & 8) >> 1); return ((kk >> 3) * 4 + (c >> 5)) * 512 + ((kk & 7) * 32 + (c & 31)) * 2; }
__device__ __forceinline__ int v_rd_base(int lane) { return ((lane & 3) << 3) | (((lane >> 2) & 3) << 6) | (((lane >> 4) & 1) << 5) | (((lane >> 5) & 1) << 8); }
constexpr int v_rd_off(int d0, int ks, int half) { return d0 * 512 + ks * 4096 + half * 2048; }
template <int OFF> __device__ __forceinline__ s16x4 tr_read(int vb) {
  s16x4 r; asm volatile("ds_read_b64_tr_b16 %0, %1 offset:%2" : "=&v"(r) : "v"(vb), "i"(OFF) : "memory"); return r;
}
template <int D0> __device__ __forceinline__ void pv_one(f32x16& od, int vb, bf16x8 pa0, bf16x8 pa1, bf16x8 pa2, bf16x8 pa3) {
  const s16x4 l0 = tr_read<v_rd_off(D0, 0, 0)>(vb), h0 = tr_read<v_rd_off(D0, 0, 1)>(vb), l1 = tr_read<v_rd_off(D0, 1, 0)>(vb), h1 = tr_read<v_rd_off(D0, 1, 1)>(vb);
  const s16x4 l2 = tr_read<v_rd_off(D0, 2, 0)>(vb), h2 = tr_read<v_rd_off(D0, 2, 1)>(vb), l3 = tr_read<v_rd_off(D0, 3, 0)>(vb), h3 = tr_read<v_rd_off(D0, 3, 1)>(vb);
  asm volatile("s_waitcnt lgkmcnt(0)" ::: "memory"); SBAR();
#define PK(L, H) (bf16x8){L[0], L[1], L[2], L[3], H[0], H[1], H[2], H[3]}
  od = __builtin_amdgcn_mfma_f32_32x32x16_bf16(pa0, PK(l0, h0), od, 0, 0, 0);
  od = __builtin_amdgcn_mfma_f32_32x32x16_bf16(pa1, PK(l1, h1), od, 0, 0, 0);
  od = __builtin_amdgcn_mfma_f32_32x32x16_bf16(pa2, PK(l2, h2), od, 0, 0, 0);
  od = __builtin_amdgcn_mfma_f32_32x32x16_bf16(pa3, PK(l3, h3), od, 0, 0, 0);
#undef PK
}
__device__ __forceinline__ void pv_d0(f32x16* o, int vb, bf16x8 pa0, bf16x8 pa1, bf16x8 pa2, bf16x8 pa3) {
  pv_one<0>(o[0], vb, pa0, pa1, pa2, pa3); pv_one<1>(o[1], vb, pa0, pa1, pa2, pa3); pv_one<2>(o[2], vb, pa0, pa1, pa2, pa3); pv_one<3>(o[3], vb, pa0, pa1, pa2, pa3);
}
__device__ __forceinline__ void bias_mask(f32x16& p0, f32x16& p1, const LAS float* bt, int j, int kr_lo, int rq, int r0w, int c, int cs, int hi) {
  if (j < 4) return;
  const int kr = kr_lo + (j - 4);
  if (kr < r0w || kr > r0w + 7) {
#pragma unroll
    for (int r = 0; r < 16; ++r) { p0[r] = -1e30f; p1[r] = -1e30f; }
    return; }
  const LAS float* bp = bt + 64 + (kr - rq + 7) * 32 + 15 - c + 4 * hi;
  const int kc0 = 4 * hi - cs;
#pragma unroll
  for (int r = 0; r < 16; ++r) { const int KC = (r & 3) + 8 * (r >> 2);
    const float b0 = bp[KC], b1 = bp[KC + 32];
    p0[r] = ((unsigned)(kc0 + KC) < 16u) ? p0[r] + b0 : -1e30f;
    p1[r] = ((unsigned)(kc0 + KC + 32) < 16u) ? p1[r] + b1 : -1e30f;
    if ((r & 3) == 3) asm volatile("" ::: "memory"); }
}
}

__device__ __forceinline__ void attn_unit(Frame& F, int b, int h, int g) {
  using namespace at;
  const bf16* PROJ = (const bf16*)(F.ws + WS_PROJ); const bf16* KVC = (const bf16*)(F.ws + WS_KVC); bf16* Y = (bf16*)(F.ws + WS_Y);
  const int tid = F.tid, wid = F.wave, lane = F.lane, r32 = lane & 31, hi = lane >> 5;
  const LAS char* ldsc = (const LAS char*)F.lds;
  LAS char* V_lds = (LAS char*)F.lds; LAS char* K_lds = (LAS char*)F.lds + 2 * SHM_V;
  LAS float* wsl = (LAS float*)(F.lds + WS_OFF) + wid * 64; LAS float* li_l = wsl; LAS float* al_l = wsl + 32;
  LAS float* bt = (LAS float*)(F.lds + BT_OFF);
  const int nloc = (g == 0 || g == 7) ? 8 : 12; const int kr_lo = (g == 0) ? 0 : (g == 7 ? 24 : 4 * g - 4); const int NT = 4 + nloc;
  const int rq = 4 * g + (wid >> 1); int r0w = rq - 4; r0w = r0w < 0 ? 0 : (r0w > 24 ? 24 : r0w);
  const int c = (wid & 1) * 32 + r32; int cs = c - 8; cs = cs < 0 ? 0 : (cs > 48 ? 48 : cs);
  __syncthreads();
  for (int i = tid; i < BT_FLOATS; i += NTHR) { const int k = i - 64; float v = 0.f;
    if (k >= 0 && k < 15 * 32 && (k & 31) < 31) v = FIN(I_RPB)[(h * 15 + (k >> 5)) * 31 + (k & 31)] * (1.0f / SCALE);
    bt[i] = v; }
  float m_reg = -1e30f, l_reg = 0; f32x16 o[4] = {}; bf16x8 qr[8];
  const bf16* Qw = PROJ + (size_t)(b * SEQ + rq * GW + c) * NPROJ + QOFF + h * HD + hi * 8;
#pragma unroll
  for (int d0 = 0; d0 < 8; ++d0) qr[d0] = *(const GAS bf16x8*)(Qw + d0 * 16);
  const int sr = tid >> 4, sc = (tid & 15) * 8, vst0 = v_st(sr, sc), vst1 = v_st(32 + sr, sc);
  const int vb0 = (int)(uintptr_t)V_lds + v_rd_base(lane);
  const GAS char* Kc = (const GAS char*)(KVC + (size_t)(b * LC) * DM + h * HD);
  const GAS char* Kl = (const GAS char*)(PROJ + (size_t)(b * SEQ) * NPROJ + KOFF + h * HD);
  const unsigned vo_c = (unsigned)(sr * DM + sc) * 2u, vo_l = (unsigned)(sr * NPROJ + sc) * 2u;
  struct { bf16x8 vs0, vs1, ks0, ks1; } st_;
#define SLOAD(j) do { const int _j = (j); const GAS char* _k; unsigned _vo; size_t _h; \
    if (_j < 4) { _k = Kc + (size_t)(_j * 64) * DM * 2; _vo = vo_c; _h = (size_t)32 * DM * 2; } else { _k = Kl + (size_t)((kr_lo + _j - 4) * GW) * NPROJ * 2; _vo = vo_l; _h = (size_t)32 * NPROJ * 2; } \
    st_.ks0 = *(const GAS bf16x8*)(_k + _vo); st_.ks1 = *(const GAS bf16x8*)(_k + _h + _vo); \
    st_.vs0 = *(const GAS bf16x8*)(_k + 2048 + _vo); st_.vs1 = *(const GAS bf16x8*)(_k + _h + 2048 + _vo); } while (0)
#define SWRITE(bb) do { *(LAS bf16x8*)(V_lds + (bb) * SHM_V + vst0) = st_.vs0; *(LAS bf16x8*)(V_lds + (bb) * SHM_V + vst1) = st_.vs1; const int kc = sc * 2; \
    *(LAS bf16x8*)(K_lds + (bb) * SHM_K + KSWZ(sr, kc)) = st_.ks0; *(LAS bf16x8*)(K_lds + (bb) * SHM_K + KSWZ(32 + sr, kc)) = st_.ks1; } while (0)
#define RESC(a) do { if (__any((a) < 1.f)) { if (hi == 0) al_l[r32] = (a); asm volatile("s_waitcnt lgkmcnt(0)" ::: "memory"); \
    _Pragma("unroll") for (int d = 0; d < 4; ++d) _Pragma("unroll") for (int r = 0; r < 16; ++r) o[d][r] *= al_l[crow(r, hi)]; } } while (0)
#define BIAS(P0, P1, j) bias_mask(P0, P1, bt, (j), kr_lo, rq, r0w, c, cs, hi)
  f32x16 p0, p1; float mn, al; bf16x8 pa0, pa1, pa2, pa3;
#define STEP(j, B) do { SWRITE(B); if ((j) + 1 < NT) SLOAD((j) + 1); __syncthreads(); \
    qkt(p0, p1, K_lds + (B) * SHM_K, qr, r32, hi); BIAS(p0, p1, (j)); partialSM(p0, p1, m_reg, mn, al); RESC(al); \
    finishSM(p0, p1, al, l_reg, pa0, pa1, pa2, pa3); SBAR(); pv_d0(o, vb0 + (B) * SHM_V, pa0, pa1, pa2, pa3); } while (0)
  SLOAD(0);
  for (int j = 0; j < NT; j += 2) { STEP(j, 0); STEP(j + 1, 1); }
#undef STEP
  asm volatile("s_waitcnt vmcnt(0)" ::: "memory");
  if (hi == 0) li_l[r32] = l_reg; asm volatile("s_waitcnt lgkmcnt(0)" ::: "memory");
  const float* ga = FIN(I_GATTN) + h * HD;
  float gg[4];
#pragma unroll
  for (int d0 = 0; d0 < 4; ++d0) gg[d0] = ga[d0 * 32 + r32];
  bf16* Yw = Y + (size_t)(b * SEQ + rq * GW + (wid & 1) * 32) * DM + DC + h * HD + r32;
#pragma unroll
  for (int r = 0; r < 16; ++r) { const int orow = crow(r, hi); const float rl = 1.0f / li_l[orow];
    float v0 = o[0][r] * rl, v1 = o[1][r] * rl, v2 = o[2][r] * rl, v3 = o[3][r] * rl;
    float ss = (v0 * v0 + v1 * v1) + (v2 * v2 + v3 * v3);
    ss += __shfl_xor(ss, 1); ss += __shfl_xor(ss, 2); ss += __shfl_xor(ss, 4); ss += __shfl_xor(ss, 8); ss += __shfl_xor(ss, 16);
    const float rstd = 1.0f / sqrtf(ss * (1.0f / HD) + EPS);
    bf16* yr = Yw + (size_t)orow * DM;
    yr[0] = (bf16)(cvt_pk_bf16(v0 * rstd * gg[0], 0.f) & 0xffffu); yr[32] = (bf16)(cvt_pk_bf16(v1 * rstd * gg[1], 0.f) & 0xffffu);
    yr[64] = (bf16)(cvt_pk_bf16(v2 * rstd * gg[2], 0.f) & 0xffffu); yr[96] = (bf16)(cvt_pk_bf16(v3 * rstd * gg[3], 0.f) & 0xffffu); }
#undef SLOAD
#undef SWRITE
#undef RESC
#undef BIAS
}
__device__ __forceinline__ void p3_attn_mfma(Frame& F) {
  const int cx = (F.bid & 7) * 32 + (F.bid >> 3);
  for (int u = cx; u < 512; u += 256) {
    int bh, g;
    if (u < 384) { bh = u / 6; g = 1 + u % 6; } else { const int s = u - 384; bh = s >> 1; g = (s & 1) ? 7 : 0; }
    attn_unit(F, bh >> 3, bh & 7, g);
  }
}

__device__ __forceinline__ void p3_conv(Frame& F) {
    const bf16* PROJ = (const bf16*)(F.ws + WS_PROJ); bf16* Y = (bf16*)(F.ws + WS_Y);
    const float* cw = FIN(I_CONVW); const float* cb = FIN(I_CONVB); const float* gc = FIN(I_GCONV);
    const int gw = F.bid * NWAVES + F.wave, NGW = F.G * NWAVES;
    const int ch0 = 16 * F.lane;
    for (int row = gw; row < T; row += NGW) {
        const int t = row & (SEQ - 1);
        const bf16* pr = PROJ + (size_t)row * NPROJ + ch0;
        float pm[16], p0[16], pp[16], ub[16];
#pragma unroll
        for (int hh = 0; hh < 2; ++hh) {
            const v4u vb = *(const GAS v4u*)(pr + 8 * hh), vc0 = *(const GAS v4u*)(pr + 1024 + 8 * hh), vx0 = *(const GAS v4u*)(pr + 2048 + 8 * hh);
            v4u vcm = (v4u){0, 0, 0, 0}, vxm = vcm, vcp = vcm, vxp = vcm;
            if (t > 0) { vcm = *(const GAS v4u*)(pr - NPROJ + 1024 + 8 * hh); vxm = *(const GAS v4u*)(pr - NPROJ + 2048 + 8 * hh); }
            if (t < SEQ - 1) { vcp = *(const GAS v4u*)(pr + NPROJ + 1024 + 8 * hh); vxp = *(const GAS v4u*)(pr + NPROJ + 2048 + 8 * hh); }
#pragma unroll
            for (int q = 0; q < 4; ++q) { const int e = 8 * hh + 2 * q;
                ub[e] = bf_lo(vb[q]); ub[e + 1] = bf_hi(vb[q]);
                p0[e] = bf_lo(vc0[q]) * bf_lo(vx0[q]); p0[e + 1] = bf_hi(vc0[q]) * bf_hi(vx0[q]);
                pm[e] = bf_lo(vcm[q]) * bf_lo(vxm[q]); pm[e + 1] = bf_hi(vcm[q]) * bf_hi(vxm[q]);
                pp[e] = bf_lo(vcp[q]) * bf_lo(vxp[q]); pp[e + 1] = bf_hi(vcp[q]) * bf_hi(vxp[q]); }
        }
        float o[16]; float ss = 0.f;
#pragma unroll
        for (int q = 0; q < 4; ++q) { const f32x4 w0 = *(const GAS f32x4*)(cw + ch0 + 4 * q), w1 = *(const GAS f32x4*)(cw + 1024 + ch0 + 4 * q), w2 = *(const GAS f32x4*)(cw + 2048 + ch0 + 4 * q), bb = *(const GAS f32x4*)(cb + ch0 + 4 * q);
#pragma unroll
            for (int e = 0; e < 4; ++e) { const int k = 4 * q + e; const float cv = pm[k] * w0[e] + p0[k] * w1[e] + pp[k] * w2[e] + bb[e]; o[k] = ub[k] * cv; ss += o[k] * o[k]; } }
        ss += __shfl_xor(ss, 1); ss += __shfl_xor(ss, 2); ss += __shfl_xor(ss, 4);
        const float rstd = 1.0f / sqrtf(ss * (1.0f / 128.0f) + EPS);
        unsigned w[8];
#pragma unroll
        for (int q = 0; q < 4; ++q) { const f32x4 gg = *(const GAS f32x4*)(gc + ch0 + 4 * q);
            w[2 * q] = cvt_pk_bf16(o[4 * q] * rstd * gg[0], o[4 * q + 1] * rstd * gg[1]); w[2 * q + 1] = cvt_pk_bf16(o[4 * q + 2] * rstd * gg[2], o[4 * q + 3] * rstd * gg[3]); }
        *(GAS v4u*)(Y + (size_t)row * DM + ch0) = (v4u){w[0], w[1], w[2], w[3]};
        *(GAS v4u*)(Y + (size_t)row * DM + ch0 + 8) = (v4u){w[4], w[5], w[6], w[7]};
    }
}

struct ProbOut {
    static constexpr int K = DM; static constexpr bool GATHER = false, PERM = true;
    const bf16 *Y, *Wout; bf16* YL; float* SSQ; int G, c;
    __device__ __forceinline__ bool next(int i, pg8::Unit& u) const {
        const int w = pg8::round_unit(i, G, c, 512); if (w < 0) return false;
        u.pm = (w >> 6) * 8 + (w & 7); u.pn = (w & 63) >> 3; u.g = 0; return true; }
    __device__ __forceinline__ const char* a_base(const pg8::Unit& u) const { return (const char*)Y + (size_t)u.pm * 256 * K * 2; }
    __device__ __forceinline__ const char* b_base(const pg8::Unit& u) const { return (const char*)Wout + (size_t)u.pn * 256 * K * 2; }
    __device__ __forceinline__ void rows(const pg8::Unit&, int, LAS unsigned*) const {}
    __device__ __forceinline__ void epi(const f32x4 (&acc)[2][2][4][2], const pg8::Unit& u, int wr, int wc, int fr, int fq) const {
        const int row0 = u.pm * 256 + wr * 64 + fr, col0 = u.pn * 256 + wc * 32 + 8 * fq;
#pragma unroll
        for (int ai = 0; ai < 2; ++ai)
#pragma unroll
            for (int m = 0; m < 4; ++m) { const int row = row0 + ai * 128 + m * 16; bf16* rowp = YL + (size_t)row * DM + col0; float ss = 0.f;
#pragma unroll
                for (int bj = 0; bj < 2; ++bj) { const f32x4 v0 = acc[ai][bj][m][0], v1 = acc[ai][bj][m][1];
                    ss += (v0.x * v0.x + v0.y * v0.y) + (v0.z * v0.z + v0.w * v0.w) + (v1.x * v1.x + v1.y * v1.y) + (v1.z * v1.z + v1.w * v1.w);
                    v4u w; w.x = cvt_pk_bf16(v0.x, v0.y); w.y = cvt_pk_bf16(v0.z, v0.w); w.z = cvt_pk_bf16(v1.x, v1.y); w.w = cvt_pk_bf16(v1.z, v1.w);
                    *(GAS v4u*)(rowp + bj * 128) = w; }
                ss += __shfl_xor(ss, 16); ss += __shfl_xor(ss, 32);
                if (fq == 0) SSQ[(size_t)row * 32 + u.pn * 4 + wc] = ss; }
    }
};

__device__ __forceinline__ void p5_route(Frame& F) {
    const float* MOD = (const float*)(F.ws + WS_MOD);
    const bf16* YL = (const bf16*)(F.ws + WS_YL); const float* SSQ = (const float*)(F.ws + WS_SSQ);
    bf16* H2 = (bf16*)(F.ws + WS_HL); bf16* H2L = (bf16*)(F.ws + WS_H2LO);
    const bf16* WRH = (const bf16*)(F.ws + WS_WRH); const bf16* WRL = (const bf16*)(F.ws + WS_WRL);
    unsigned* gcnt = (unsigned*)(F.ws + WS_CTL) + CW_CNT;
    v2u* LIST = (v2u*)(F.ws + WS_LIST);
    LAS float* logit = (LAS float*)F.lds;
    LAS unsigned* lcnt = (LAS unsigned*)(F.lds + 16384);
    LAS unsigned* lbase = (LAS unsigned*)(F.lds + 16384 + 256);
    LAS unsigned* ent = (LAS unsigned*)(F.lds + 16384 + 512);
    for (int blk = F.bid; blk < T / 64; blk += F.G) {
        const int row0 = blk * 64;
        if (F.tid < 64) lcnt[F.tid] = 0u;
        for (int rr = F.wave; rr < 64; rr += NWAVES) {
            const int row = row0 + rr, b = row >> 11; const float* md = MOD + (size_t)b * 12288;
            const float* xr = FIN(I_X) + (size_t)row * DM; const bf16* yr = YL + (size_t)row * DM;
            float sq = F.lane < 32 ? SSQ[(size_t)row * 32 + F.lane] : 0.f; sq = wave_sum(sq);
            const float rstd1 = 1.0f / sqrtf(sq * (1.0f / DM) + EPS);
            f32x4 v[8]; float ss = 0.f;
#pragma unroll
            for (int j = 0; j < 8; ++j) { const int c = 4 * F.lane + 256 * j;
                const f32x4 xv = *(const GAS f32x4*)(xr + c); const v2u yv = *(const GAS v2u*)(yr + c);
                const f32x4 gp = *(const GAS f32x4*)(FIN(I_GPOSTMIX) + c), gt = *(const GAS f32x4*)(md + 4096 + c);
                const f32x4 yl = (f32x4){bf_lo(yv.x), bf_hi(yv.x), bf_lo(yv.y), bf_hi(yv.y)};
                v[j] = xv + gt * (yl * rstd1 * gp);
                *(GAS f32x4*)(FOUT + (size_t)row * DM + c) = v[j];
                ss += (v[j].x * v[j].x + v[j].y * v[j].y) + (v[j].z * v[j].z + v[j].w * v[j].w); }
            const float rstd2 = 1.0f / sqrtf(wave_sum(ss) * (1.0f / DM) + EPS);
#pragma unroll
            for (int j = 0; j < 8; ++j) { const int c = 4 * F.lane + 256 * j;
                const f32x4 gg = *(const GAS f32x4*)(FIN(I_GPREFFN) + c), sh = *(const GAS f32x4*)(md + 6144 + c), sc = *(const GAS f32x4*)(md + 8192 + c);
                const f32x4 h = (v[j] * rstd2) * gg * (sc + 1.0f) + sh;
                const unsigned h0 = cvt_pk_bf16(h.x, h.y), h1 = cvt_pk_bf16(h.z, h.w);
                const unsigned l0 = cvt_pk_bf16(h.x - bf_lo(h0), h.y - bf_hi(h0)), l1 = cvt_pk_bf16(h.z - bf_lo(h1), h.w - bf_hi(h1));
                *(GAS v2u*)(H2 + (size_t)row * DM + c) = (v2u){h0, h1}; *(GAS v2u*)(H2L + (size_t)row * DM + c) = (v2u){l0, l1}; }
        }
        VM_WAIT(); __syncthreads();
        {
            const int rt = F.wave & 3, nh = F.wave >> 2, fr = F.lane & 15, fq = F.lane >> 4;
            const bf16* ah = H2 + (size_t)(row0 + rt * 16 + fr) * DM + 8 * fq; const bf16* al = H2L + (size_t)(row0 + rt * 16 + fr) * DM + 8 * fq;
            f32x4 acc[2] = {(f32x4){0.f, 0.f, 0.f, 0.f}, (f32x4){0.f, 0.f, 0.f, 0.f}};
#pragma unroll 2
            for (int s = 0; s < 64; ++s) {
                const bf16x8 a_h = *(const GAS bf16x8*)(ah + 32 * s), a_l = *(const GAS bf16x8*)(al + 32 * s);
#pragma unroll
                for (int n2 = 0; n2 < 2; ++n2) { const size_t eo = (size_t)(nh * 32 + n2 * 16 + fr) * DM + 32 * s + 8 * fq;
                    const bf16x8 b_h = *(const GAS bf16x8*)(WRH + eo), b_l = *(const GAS bf16x8*)(WRL + eo);
                    acc[n2] = __builtin_amdgcn_mfma_f32_16x16x32_bf16(a_l, b_h, acc[n2], 0, 0, 0);
                    acc[n2] = __builtin_amdgcn_mfma_f32_16x16x32_bf16(a_h, b_l, acc[n2], 0, 0, 0);
                    acc[n2] = __builtin_amdgcn_mfma_f32_16x16x32_bf16(a_h, b_h, acc[n2], 0, 0, 0); }
            }
#pragma unroll
            for (int n2 = 0; n2 < 2; ++n2)
#pragma unroll
                for (int r = 0; r < 4; ++r) logit[(rt * 16 + 4 * fq + r) * 64 + nh * 32 + n2 * 16 + fr] = acc[n2][r];
        }
        __syncthreads();
        for (int rr = F.wave; rr < 64; rr += NWAVES) {
            const int row = row0 + rr; const int e = F.lane;
            const float lg = logit[rr * 64 + e]; const float score = 1.0f / (1.0f + expf(-lg)); const float sel = score + FIN(I_RBIAS)[e];
            float m1 = sel; m1 = fmaxf(m1, __shfl_xor(m1, 1)); m1 = fmaxf(m1, __shfl_xor(m1, 2)); m1 = fmaxf(m1, __shfl_xor(m1, 4));
            int i1 = (sel == m1) ? e : 1000; i1 = min(i1, __shfl_xor(i1, 1)); i1 = min(i1, __shfl_xor(i1, 2)); i1 = min(i1, __shfl_xor(i1, 4));
            float s2 = (e == i1) ? -INFINITY : sel; s2 = fmaxf(s2, __shfl_xor(s2, 1)); s2 = fmaxf(s2, __shfl_xor(s2, 2)); s2 = fmaxf(s2, __shfl_xor(s2, 4));
            const float gs = m1 + s2; const int g = e >> 3; int grank = 0;
#pragma unroll
            for (int g2 = 0; g2 < 8; ++g2) { const float o = __builtin_bit_cast(float, __builtin_amdgcn_readlane(__builtin_bit_cast(unsigned, gs), 8 * g2)); grank += (o > gs || (o == gs && g2 < g)) ? 1 : 0; }
            const float ms = grank < 4 ? sel : -INFINITY; int rank = 0;
#pragma unroll 4
            for (int e2 = 0; e2 < 64; ++e2) { const float o = __builtin_bit_cast(float, __builtin_amdgcn_readlane(__builtin_bit_cast(unsigned, ms), e2)); rank += (o > ms || (o == ms && e2 < e)) ? 1 : 0; }
            const bool chosen = rank < 8;
            const float ssum = wave_sum(chosen ? score : 0.f);
            const float w = score / ssum * 2.5f;
            if (chosen) { const unsigned lp = __hip_atomic_fetch_add(lcnt + e, 1u, __ATOMIC_RELAXED, __HIP_MEMORY_SCOPE_WORKGROUP);
                LAS unsigned* en = ent + (rr * 8 + rank) * 4; en[0] = (unsigned)e; en[1] = lp; en[2] = (unsigned)row * 16u + (unsigned)rank; en[3] = __builtin_bit_cast(unsigned, w); }
            if (F.lane == 0) LIST[(size_t)64 * LIST_CAP + row] = (v2u){(unsigned)row * 16u + 8u, __builtin_bit_cast(unsigned, 1.0f)};
        }
        __syncthreads();
        if (F.tid < 64) lbase[F.tid] = __hip_atomic_fetch_add(gcnt + 64 * F.tid, lcnt[F.tid], RLX_AGENT);
        __syncthreads();
        { const LAS unsigned* en = ent + F.tid * 4; const unsigned e = en[0]; LIST[(size_t)e * LIST_CAP + lbase[e] + en[1]] = (v2u){en[2], en[3]}; }
        __syncthreads();
    }
}

struct TileTab { LAS int* cnt; LAS int* tstart; };
__device__ __forceinline__ TileTab build_tiles(Frame& F) {
    TileTab tt; tt.cnt = (LAS int*)(F.lds + MISC_OFF); tt.tstart = tt.cnt + 128;
    const unsigned* gcnt = (const unsigned*)(F.ws + WS_CTL) + CW_CNT;
    if (F.tid < 64) tt.cnt[F.tid] = (int)__hip_atomic_load(gcnt + 64 * F.tid, RLX_AGENT);
    if (F.tid == 64) tt.cnt[64] = T;
    __syncthreads();
    if (F.tid == 0) { int s = 0; for (int e = 0; e < 65; ++e) { tt.tstart[e] = s; s += (tt.cnt[e] + 255) >> 8; } tt.tstart[65] = s; }
    __syncthreads();
    return tt;
}
__device__ __forceinline__ int tile_expert(const TileTab& tt, int tile) { int e = 0; while (tt.tstart[e + 1] <= tile) ++e; return e; }

struct ProbGU {
    static constexpr int K = DM; static constexpr bool GATHER = true, PERM = false;
    const bf16 *H2, *Wgu; bf16* HID; const v2u* LIST; TileTab tt; int G, c;
    __device__ __forceinline__ bool next(int i, pg8::Unit& u) const {
        const int total = tt.tstart[65] * 4; const int w = pg8::round_unit(i, G, c, total); if (w < 0) return false;
        u.pm = w >> 2; u.pn = w & 3; u.g = tile_expert(tt, u.pm); return true; }
    __device__ __forceinline__ const char* a_base(const pg8::Unit&) const { return (const char*)H2; }
    __device__ __forceinline__ const char* b_base(const pg8::Unit& u) const { return (const char*)Wgu + ((size_t)u.g * 1024 + (size_t)u.pn * 256) * K * 2; }
    __device__ __forceinline__ void rows(const pg8::Unit& u, int tid, LAS unsigned* dst) const {
        const int lt = u.pm - tt.tstart[u.g]; const int nrow = tt.cnt[u.g] - lt * 256; const v2u* lp = LIST + (size_t)u.g * LIST_CAP + lt * 256;
#pragma unroll
        for (int i = 0; i < 2; ++i) { int R0, C; pg8::stage_rc(tid * 16 + i * 8192, R0, C);
#pragma unroll
            for (int h = 0; h < 2; ++h) { const int R = R0 + 128 * h; unsigned tok = 0u; if (R < nrow) tok = lp[R].x >> 4; dst[(h * 2 + i) * 512 + tid] = tok * (unsigned)(K * 2) + (unsigned)(C * 2); } }
    }
    __device__ __forceinline__ void epi(const f32x4 (&acc)[2][2][4][2], const pg8::Unit& u, int wr, int wc, int fr, int fq) const {
        const int lt = u.pm - tt.tstart[u.g]; const int nrow = tt.cnt[u.g] - lt * 256; const v2u* lp = LIST + (size_t)u.g * LIST_CAP + lt * 256;
#pragma unroll
        for (int ai = 0; ai < 2; ++ai)
#pragma unroll
            for (int m = 0; m < 4; ++m) { const int R = ai * 128 + wr * 64 + m * 16 + fr;
                float w = 0.f; if (R < nrow) { const unsigned wb = lp[R].y; w = u2f(wb); }
                bf16* rowp = HID + ((size_t)u.pm * 256 + R) * FE + u.pn * 128 + wc * 16 + 4 * fq;
#pragma unroll
                for (int bj = 0; bj < 2; ++bj) { const f32x4 g = acc[ai][bj][m][0], up = acc[ai][bj][m][1]; f32x4 hv;
#pragma unroll
                    for (int q = 0; q < 4; ++q) hv[q] = g[q] / (1.0f + __expf(-g[q])) * up[q] * w;
#ifdef DIAG
                    if (u.pm == 3 && u.pn == 0 && wr == 1 && ai == 1 && m == 2 && fr == 8 && fq == 0 && bj == 0) { unsigned st = 0x100u;
                        if (!(fabsf(g.x) > 1e-3f)) st |= 1u; if (!(fabsf(up.x) > 1e-3f)) st |= 2u; if (!(w > 0.f)) st |= 4u; if (!(nrow >= 1 && nrow <= 256)) st |= 8u;
                        __hip_atomic_store((unsigned*)((char*)LIST - WS_LIST) + 101, st, RLX_AGENT); }
#endif
                    *(GAS v2u*)(rowp + bj * 64) = (v2u){cvt_pk_bf16(hv.x, hv.y), cvt_pk_bf16(hv.z, hv.w)}; } }
    }
};
struct ProbDown {
    static constexpr int K = FE; static constexpr bool GATHER = false, PERM = true;
    const bf16 *HID, *Wdn; bf16* SLOT; const v2u* LIST; TileTab tt; int G, c;
    __device__ __forceinline__ bool next(int i, pg8::Unit& u) const {
        const int total = tt.tstart[65] * 8; const int w = pg8::round_unit(i, G, c, total); if (w < 0) return false;
        u.pm = w >> 3; u.pn = w & 7; u.g = tile_expert(tt, u.pm); return true; }
    __device__ __forceinline__ const char* a_base(const pg8::Unit& u) const { return (const char*)HID + (size_t)u.pm * 256 * K * 2; }
    __device__ __forceinline__ const char* b_base(const pg8::Unit& u) const { return (const char*)Wdn + ((size_t)u.g * 2048 + (size_t)u.pn * 256) * K * 2; }
    __device__ __forceinline__ void rows(const pg8::Unit&, int, LAS unsigned*) const {}
    __device__ __forceinline__ void epi(const f32x4 (&acc)[2][2][4][2], const pg8::Unit& u, int wr, int wc, int fr, int fq) const {
        const int lt = u.pm - tt.tstart[u.g]; const int nrow = tt.cnt[u.g] - lt * 256; const v2u* lp = LIST + (size_t)u.g * LIST_CAP + lt * 256;
        const int col0 = u.pn * 256 + wc * 32 + 8 * fq;
#pragma unroll
        for (int ai = 0; ai < 2; ++ai)
#pragma unroll
            for (int m = 0; m < 4; ++m) { const int R = ai * 128 + wr * 64 + m * 16 + fr;
                if (R < nrow) { const unsigned ts = lp[R].x; bf16* rowp = SLOT + ((size_t)(ts >> 4) * NSLOT + (ts & 15u)) * DM + col0;
#pragma unroll
                    for (int bj = 0; bj < 2; ++bj) { const f32x4 v0 = acc[ai][bj][m][0], v1 = acc[ai][bj][m][1];
                        v4u w; w.x = cvt_pk_bf16(v0.x, v0.y); w.y = cvt_pk_bf16(v0.z, v0.w); w.z = cvt_pk_bf16(v1.x, v1.y); w.w = cvt_pk_bf16(v1.z, v1.w);
                        *(GAS v4u*)(rowp + bj * 128) = w; } } }
    }
};

__device__ __forceinline__ void p8_final(Frame& F) {
    const int gw = F.bid * NWAVES + F.wave, NGW = F.G * NWAVES;
    const float* MOD = (const float*)(F.ws + WS_MOD); const bf16* SLOT = (const bf16*)(F.ws + WS_SLOT); const float* g = FIN(I_GPOSTFFN);
#ifdef DIAG
    float dscale = 1.0f;
    { const unsigned* ctl = (const unsigned*)(F.ws + WS_CTL); const bf16* HID = (const bf16*)(F.ws + WS_HID);
      const unsigned a = __hip_atomic_load(ctl + 102, RLX_AGENT), b = __hip_atomic_load(ctl + 103, RLX_AGENT);
      const float s2 = wave_sum(fabsf(bf_lo(HID[(size_t)1000 * 512 + F.lane])));
      int code = 0; if (a != 1u) code |= 1; if (a == 0u) code |= 2; if (b != 1u) code |= 4; if (!(s2 > 1e-6f)) code |= 8;
      dscale = 1.0f + 0.25f * (float)code; }
#endif
    for (int row = gw; row < T; row += NGW) {
        const float* md = MOD + (size_t)(row >> 11) * 12288;
        f32x4 v[8];
#pragma unroll
        for (int j = 0; j < 8; ++j) v[j] = (f32x4){0.f, 0.f, 0.f, 0.f};
#pragma unroll
        for (int s = 0; s < NSLOT; ++s) { const int ss = (s + 8) % 9;
            const bf16* sr = SLOT + ((size_t)row * NSLOT + ss) * DM;
#pragma unroll
            for (int j = 0; j < 8; ++j) { const v2u yv = *(const GAS v2u*)(sr + 4 * F.lane + 256 * j); v[j] += (f32x4){bf_lo(yv.x), bf_hi(yv.x), bf_lo(yv.y), bf_hi(yv.y)}; } }
        float ss = 0.f;
#pragma unroll
        for (int j = 0; j < 8; ++j) ss += (v[j].x * v[j].x + v[j].y * v[j].y) + (v[j].z * v[j].z + v[j].w * v[j].w);
        const float rstd = 1.0f / sqrtf(wave_sum(ss) * (1.0f / DM) + EPS);
#pragma unroll
        for (int j = 0; j < 8; ++j) { const int c = 4 * F.lane + 256 * j;
            const f32x4 gg = *(const GAS f32x4*)(g + c), gt = *(const GAS f32x4*)(md + 10240 + c);
            GAS f32x4* op = (GAS f32x4*)(FOUT + (size_t)row * DM + c);
#ifdef DIAG
            *op = *op * dscale;
#else
            *op = *op + gt * (v[j] * rstd * gg);
#endif
        }
    }
}

constexpr int N_PHASES = 9;
typedef KArgs Args;
__global__ void __launch_bounds__(NTHR, 2) fwd_kernel(Args args) {
    extern __shared__ __attribute__((aligned(16))) unsigned char lds_raw[];
    Frame F;
    F.lds = (LAS unsigned char*)lds_raw;
    F.tid = threadIdx.x; F.lane = F.tid & 63; F.wave = __builtin_amdgcn_readfirstlane(F.tid >> 6);
    F.G = gridDim.x; F.bid = blockIdx.x;
    F.ka = (CKArgs*)__builtin_amdgcn_kernarg_segment_ptr(); F.ws = args.ws;
#define LAUNDER() do { CKArgs* _p = (CKArgs*)__builtin_amdgcn_kernarg_segment_ptr(); asm volatile("" : "+s"(_p) :: "memory"); F.ka = _p; unsigned char* _w = _p->ws; F.ws = _w; } while (0)
    volatile LAS unsigned* barw = (volatile LAS unsigned*)(F.lds + BARW_OFF);
    if (F.tid < 16) barw[F.tid] = 0u;
    __syncthreads();
    XcdBarrier bar; bar.bar = (unsigned*)(F.ws + WS_CTL) + CW_BAR + args.li * XCD_BAR_WORDS; bar.x = 0; bar.st = nullptr;
    const int lo = args.ph_lo, hi = args.ph_hi;
    if (hi - lo > 1) bar = xcd_barrier_post((unsigned*)(F.ws + WS_CTL) + CW_BAR + args.li * XCD_BAR_WORDS, barw);
#ifndef PH_MASK
#define PH_MASK 0x1ff
#endif
#define IN(k) (((PH_MASK >> (k)) & 1) && lo <= (k) && (k) < hi)
#define SEAM(k) do { if (IN(k) && IN((k) + 1)) xcd_barrier(bar); } while (0)
    if (IN(0)) { LAUNDER(); p0_prologue(F); } SEAM(0);
    if (IN(1)) { LAUNDER(); p1_norm(F); } SEAM(1);
    if (IN(2)) { LAUNDER();
        ProbProj P; P.HL = (const bf16*)(F.ws + WS_HL); P.HC = (const bf16*)(F.ws + WS_HC); P.Win = (const bf16*)(F.ws + WS_WIN); P.PROJ = (bf16*)(F.ws + WS_PROJ); P.KVC = (bf16*)(F.ws + WS_KVC);
        P.rope = (const f32x2*)(F.ws + WS_ROPE); P.G = F.G; P.c = F.bid;
        pg8::gemm_phase<ProbProj>(F.lds, P);
    } SEAM(2);
    if (IN(3)) { LAUNDER();
#ifdef ATTN_SIMPLE
        p3_attn_simple(F);
#else
        p3_attn_mfma(F);
#endif
        LAUNDER(); p3_conv(F); } SEAM(3);
    if (IN(4)) { LAUNDER();
        ProbOut P; P.Y = (const bf16*)(F.ws + WS_Y); P.Wout = (const bf16*)(F.ws + WS_WOUT); P.YL = (bf16*)(F.ws + WS_YL); P.SSQ = (float*)(F.ws + WS_SSQ); P.G = F.G; P.c = F.bid;
        pg8::gemm_phase<ProbOut>(F.lds, P);
    } SEAM(4);
    if (IN(5)) { LAUNDER(); p5_route(F); } SEAM(5);
    if (IN(6)) { LAUNDER();
#ifdef DIAG
        if (F.bid == 0 && F.wave == 0) { const bf16* Wgu = (const bf16*)(F.ws + WS_WGU); const bf16* H2 = (const bf16*)(F.ws + WS_HL);
            const float s0 = wave_sum(fabsf(bf_lo(Wgu[((size_t)5 * 1024 + 100) * 2048 + F.lane]))); const float s1 = wave_sum(fabsf(bf_lo(H2[(size_t)1000 * 2048 + F.lane])));
            unsigned st = 0; if (!(s0 > 1e-3f)) st |= 1u; if (!(s1 > 1e-3f)) st |= 2u;
            if (F.lane == 0) __hip_atomic_store((unsigned*)(F.ws + WS_CTL) + 100, st, RLX_AGENT); }
#endif
        ProbGU P; P.tt = build_tiles(F); P.H2 = (const bf16*)(F.ws + WS_HL); P.Wgu = (const bf16*)(F.ws + WS_WGU); P.HID = (bf16*)(F.ws + WS_HID); P.LIST = (const v2u*)(F.ws + WS_LIST); P.G = F.G; P.c = F.bid;
        pg8::gemm_phase<ProbGU>(F.lds, P);
#ifdef DIAG
        VM_WAIT(); __syncthreads();
        if (F.bid == 96 && F.wave == 0) { const bf16* HID = (const bf16*)(F.ws + WS_HID); const float s2 = wave_sum(fabsf(bf_lo(HID[(size_t)1000 * 512 + F.lane])));
            if (F.lane == 0) __hip_atomic_store((unsigned*)(F.ws + WS_CTL) + 102, (s2 > 1e-6f) ? 1u : 2u, RLX_AGENT); }
#endif
    } SEAM(6);
    if (IN(7)) { LAUNDER();
#ifdef DIAG
        if (F.bid == 0 && F.wave == 0) { const bf16* HID = (const bf16*)(F.ws + WS_HID); const float s2 = wave_sum(fabsf(bf_lo(HID[(size_t)1000 * 512 + F.lane])));
            if (F.lane == 0) __hip_atomic_store((unsigned*)(F.ws + WS_CTL) + 103, (s2 > 1e-6f) ? 1u : 2u, RLX_AGENT); }
#endif
        ProbDown P; P.tt = build_tiles(F); P.HID = (const bf16*)(F.ws + WS_HID); P.Wdn = (const bf16*)(F.ws + WS_WDN); P.SLOT = (bf16*)(F.ws + WS_SLOT); P.LIST = (const v2u*)(F.ws + WS_LIST); P.G = F.G; P.c = F.bid;
        pg8::gemm_phase<ProbDown>(F.lds, P);
    } SEAM(7);
    if (IN(8)) { LAUNDER(); p8_final(F); }
#undef IN
#undef SEAM
}

extern "C" void kernel_launch(void* const* d_in, const int* in_sizes, int n_in, void* d_out, int out_size, void* d_ws, size_t ws_size, hipStream_t stream) {
    static int grid = 0;
    if (grid == 0) {
        if (n_in != 25 || in_sizes[0] != T * DM || out_size != T * DM || ws_size < WS_END) { fprintf(stderr, "kernel_launch: shape/workspace mismatch (n_in %d, in0 %d, out %d, ws %zu < %zu)\n", n_in, n_in > 0 ? in_sizes[0] : -1, out_size, ws_size, (size_t)WS_END); grid = -1; return; }
        int dev = 0, cus = 0, per_cu = 0;
        if (hipGetDevice(&dev) != hipSuccess || hipDeviceGetAttribute(&cus, hipDeviceAttributeMultiprocessorCount, dev) != hipSuccess) { grid = -1; return; }
        if (hipFuncSetAttribute((const void*)fwd_kernel, hipFuncAttributeMaxDynamicSharedMemorySize, LDS_BYTES) != hipSuccess) { fprintf(stderr, "kernel_launch: hipFuncSetAttribute failed\n"); grid = -1; return; }
        if (hipOccupancyMaxActiveBlocksPerMultiprocessor(&per_cu, (const void*)fwd_kernel, NTHR, LDS_BYTES) != hipSuccess || per_cu < 1) fprintf(stderr, "kernel_launch: occupancy query says %d\n", per_cu);
        (void)hipGetLastError();
        grid = cus;
        if (grid != 256) fprintf(stderr, "kernel_launch: %d CUs (built for 256)\n", grid);
    }
    if (grid < 0) return;
    if (hipMemsetAsync((char*)d_ws + WS_CTL, 0, CTL_ZERO_BYTES, stream) != hipSuccess) return;
    Args a{};
    for (int i = 0; i < 25; ++i) a.in[i] = (const float*)d_in[i];
    a.out = (float*)d_out; a.ws = (unsigned char*)d_ws; a.pad = 0;
    if (MK_N_LAUNCHES == 1) {
        a.ph_lo = 0; a.ph_hi = N_PHASES; a.li = 0;
        hipLaunchKernelGGL(fwd_kernel, dim3(grid), dim3(NTHR), LDS_BYTES, stream, a);
    } else {
        for (int li = 0; li < N_PHASES; ++li) { a.ph_lo = li; a.ph_hi = li + 1; a.li = 0;
            hipLaunchKernelGGL(fwd_kernel, dim3(grid), dim3(NTHR), LDS_BYTES, stream, a); }
    }
    const hipError_t le = hipPeekAtLastError();
    if (le != hipSuccess) fprintf(stderr, "kernel_launch: launch failed: %s\n", hipGetErrorName(le));
}
```

```cpp
#include <hip/hip_runtime.h>
#include <cstdio>
#include <cstdint>


#ifndef MK_N_LAUNCHES
#define MK_N_LAUNCHES 1
#endif

#define GAS __attribute__((address_space(1)))
#define LAS __attribute__((address_space(3)))
typedef unsigned short bf16;
typedef unsigned v4u __attribute__((ext_vector_type(4)));
typedef unsigned v2u __attribute__((ext_vector_type(2)));
typedef float f32x4 __attribute__((ext_vector_type(4)));
typedef float f32x2 __attribute__((ext_vector_type(2)));
typedef short bf16x8 __attribute__((ext_vector_type(8)));
typedef __bf16 v2bf __attribute__((ext_vector_type(2)));

constexpr int NB = 8, SEQ = 2048, DM = 2048, T = NB * SEQ, LC = 256, TC = NB * LC;
constexpr int GW = 64, DC = 1024, NH = 8, HD = 128;
constexpr int NPROJ = 6144, QOFF = 3072, KOFF = 4096, VOFF = 5120;
constexpr int NE = 64, FE = 512, NSLOT = 9;
constexpr float EPS = 1e-6f;
constexpr int NWAVES = 8, NTHR = 512;
constexpr int LIST_CAP = 16384;
constexpr int MAX_TILES = 640;

constexpr size_t MiB = 1u << 20;
constexpr size_t WS_CTL = 0, CTL_ZERO_BYTES = 1 * MiB;
constexpr size_t WS_MOD = 1 * MiB;
constexpr size_t WS_ROPE = 1 * MiB + 512 * 1024;
constexpr size_t WS_SSQ = 2 * MiB;
constexpr size_t WS_LIST = 4 * MiB;
constexpr size_t WS_WRH = 13 * MiB, WS_WRL = 13 * MiB + 256 * 1024;
constexpr size_t WS_WDN = 14 * MiB;
constexpr size_t WS_YL = 144 * MiB;
constexpr size_t WS_HID = 208 * MiB;
constexpr size_t WS_WGU = 368 * MiB;
constexpr size_t WS_WIN = 628 * MiB;
constexpr size_t WS_WOUT = 652 * MiB;
constexpr size_t WS_HL = 660 * MiB;
constexpr size_t WS_HC = 724 * MiB;
constexpr size_t WS_KVC = 732 * MiB;
constexpr size_t WS_PROJ = 740 * MiB;
constexpr size_t WS_H2LO = 740 * MiB;
constexpr size_t WS_Y = 932 * MiB;
constexpr size_t WS_SLOT = 368 * MiB;
constexpr size_t WS_TOK = 1008 * MiB;
constexpr size_t WS_END = 1009 * MiB;
static_assert(WS_SLOT + (size_t)MAX_TILES * 256 * DM * 2 <= WS_TOK, "slot buffer");
constexpr int CW_BAR = 4096;
constexpr int CW_CNT = 16384;

constexpr int RING_BYTES = 131072;
constexpr int MISC_OFF = RING_BYTES;
constexpr int BARW_OFF = 163840 - 64;
constexpr int LDS_BYTES = 163840;

#define RLX_AGENT __ATOMIC_RELAXED, __HIP_MEMORY_SCOPE_AGENT
#define LDS_WAIT() asm volatile("s_waitcnt lgkmcnt(0)" ::: "memory")
#define VM_WAIT() asm volatile("s_waitcnt vmcnt(0)" ::: "memory")
__device__ __forceinline__ unsigned cvt_pk_bf16(float lo, float hi) { unsigned r; asm volatile("v_cvt_pk_bf16_f32 %0, %1, %2" : "=v"(r) : "v"(lo), "v"(hi)); return r; }
__device__ __forceinline__ float u2f(unsigned u) { return __builtin_bit_cast(float, u); }
__device__ __forceinline__ float bf_lo(unsigned u) { return __builtin_bit_cast(float, u << 16); }
__device__ __forceinline__ float bf_hi(unsigned u) { return __builtin_bit_cast(float, u & 0xffff0000u); }
__device__ __forceinline__ float wave_sum(float v) {
#pragma unroll
    for (int o = 1; o < 64; o <<= 1) v += __shfl_xor(v, o);
    return v;
}
__device__ __forceinline__ float wave_max(float v) {
#pragma unroll
    for (int o = 1; o < 64; o <<= 1) v = fmaxf(v, __shfl_xor(v, o));
    return v;
}
__device__ __forceinline__ float silu_f(float v) { return v / (1.0f + expf(-v)); }

#define XB_TMO      128
#define XB_XCNT(j)  (256  + 64 * (j))
#define XB_XSUB(j)  (1280 + 64 * (j))
#define XB_XGEN(j)  (2304 + 64 * (j))
#define XB_TOP      3328
#define XB_TOPGEN   3392
#define XCD_BAR_WORDS 3456
#define XB_SPIN_CAP (1u << 18)
__device__ __forceinline__ unsigned xb_ld(unsigned* p)              { return __hip_atomic_load(p, __ATOMIC_RELAXED, __HIP_MEMORY_SCOPE_AGENT); }
__device__ __forceinline__ unsigned xb_add(unsigned* p, unsigned v) { return __hip_atomic_fetch_add(p, v, __ATOMIC_RELAXED, __HIP_MEMORY_SCOPE_AGENT); }
__device__ __forceinline__ unsigned xb_xcc_id() { return (unsigned)__builtin_amdgcn_s_getreg((3 << 11) | 20) & 0xFu; }
#define XB_SPIN(cond, bar) do { unsigned _sp = 0; while (cond) { __builtin_amdgcn_s_sleep(1); \
    if ((++_sp & 255u) == 0u) { if (xb_ld(&(bar)[XB_TMO])) break; if (_sp > XB_SPIN_CAP) { atomicAdd(&(bar)[XB_TMO], 1u); break; } } } } while (0)
struct XcdBarrier { unsigned* bar; unsigned x; volatile LAS unsigned* st; };
__device__ __forceinline__ XcdBarrier xcd_barrier_post(unsigned* bar, volatile LAS unsigned* st) {
    XcdBarrier b; b.bar = bar; b.x = xb_xcc_id(); b.st = st;
    if (threadIdx.x == 0) (void)xb_add(&bar[XB_XCNT(b.x)], 1u);
    return b;
}
__device__ __forceinline__ void xcd_barrier_complete(unsigned* bar, unsigned x, unsigned& nloc, unsigned& nx) {
    const unsigned G = gridDim.x * gridDim.y * gridDim.z;
    unsigned sum, cnt, mine, sp = 0u;
    for (;;) {
        sum = 0u; cnt = 0u; mine = 0u;
#pragma unroll
        for (unsigned j = 0; j < 16; ++j) { const unsigned c = xb_ld(&bar[XB_XCNT(j)]); sum += c; cnt += (c > 0u) ? 1u : 0u; mine = (j == x) ? c : mine; }
        if (sum == G) break;
        __builtin_amdgcn_s_sleep(1);
        if ((++sp & 255u) == 0u) { if (xb_ld(&bar[XB_TMO])) break; if (sp > XB_SPIN_CAP) { atomicAdd(&bar[XB_TMO], 1u); break; } }
    }
    nloc = mine > 0u ? mine : 1u; nx = cnt > 0u ? cnt : 1u;
}
__device__ __forceinline__ void xcd_barrier(const XcdBarrier& b) {
    asm volatile("s_waitcnt vmcnt(0)" ::: "memory");
    __syncthreads();
    if (threadIdx.x == 0) {
        unsigned* bar = b.bar;
        __builtin_amdgcn_s_waitcnt(0);
        unsigned nloc = b.st[0], nx = b.st[1];
        if (nloc == 0u) { xcd_barrier_complete(bar, b.x, nloc, nx); b.st[0] = nloc; b.st[1] = nx; }
        const unsigned old = xb_add(&bar[XB_XSUB(b.x)], 1u);
        const unsigned gen = old / nloc;
        if (old + 1u == (gen + 1u) * nloc) {
            __builtin_amdgcn_fence(__ATOMIC_RELEASE, "agent");
            asm volatile("s_waitcnt vmcnt(0)" ::: "memory");
            const unsigned og = xb_add(&bar[XB_TOP], 1u);
            const unsigned tg = og / nx;
            if (og + 1u == (tg + 1u) * nx) xb_add(&bar[XB_TOPGEN], 1u);
            else XB_SPIN(xb_ld(&bar[XB_TOPGEN]) == tg, bar);
            __builtin_amdgcn_fence(__ATOMIC_ACQUIRE, "agent");
            xb_add(&bar[XB_XGEN(b.x)], 1u);
            asm volatile("s_waitcnt vmcnt(0)" ::: "memory");
        } else {
            XB_SPIN(xb_ld(&bar[XB_XGEN(b.x)]) == gen, bar);
            __builtin_amdgcn_fence(__ATOMIC_ACQUIRE, "agent");
            asm volatile("s_waitcnt vmcnt(0)" ::: "memory");
        }
    }
    __syncthreads();
}

namespace pg8 {
constexpr int BM = 256, BK = 64, HALF = 128, HTB = HALF * BK * 2, STAGE_BYTES = 8 * HTB;
__host__ __device__ __forceinline__ int lds_byte(int r, int c) { const int st = (r >> 4) * 2 + (c >> 5), rr = r & 15, cc = c & 31, ob = rr * 64 + cc * 2; return st * 1024 + (ob ^ (((ob >> 9) & 1) << 5)); }
__host__ __device__ __forceinline__ void stage_rc(int b, int& R, int& C) { const int st = b / 1024, sb = b % 1024, swz = sb ^ (((sb >> 9) & 1) << 5); R = (st >> 1) * 16 + swz / 64; C = (st & 1) * 32 + (swz % 64) / 2; }
__host__ __device__ __forceinline__ int perm32(int rho) { const int n = rho >> 4, i = rho & 15; return 8 * (i >> 2) + 4 * n + (i & 3); }
struct Unit { int pm, pn, g; };

__device__ __forceinline__ int round_unit(int i, int G, int c, int total) {
    const int base = i * G; if (base + c >= total && (total - base) >= G) return -1;
    const int R = (total - base) < G ? (total - base) : G;
    if (R <= 0) return -1;
    if (R == G && (G & 7) == 0) return base + (c & 7) * (G >> 3) + (c >> 3);
    return c < R ? base + c : -1;
}

template <class P>
__device__ __forceinline__ void gemm_phase(LAS unsigned char* lds, const P& p) {
    constexpr int K = P::K, nt = K / BK;
    const int tid = threadIdx.x, wid = __builtin_amdgcn_readfirstlane(tid >> 6), lane = tid & 63, wr = wid >> 2, wc = wid & 3, fr = lane & 15, fq = lane >> 4;
    unsigned voffB[2], voffA[2];
#pragma unroll
    for (int i = 0; i < 2; ++i) { int R, C; stage_rc(tid * 16 + i * 8192, R, C); const int Rb = P::PERM ? ((R & ~31) + perm32(R & 31)) : R;
        voffA[i] = (unsigned)(R * K + C) * 2u; voffB[i] = (unsigned)(Rb * K + C) * 2u; }
    LAS unsigned* goffs = (LAS unsigned*)(lds + STAGE_BYTES + 1024);
    constexpr size_t kstep = (size_t)(BK * 2);
    constexpr size_t hstep = (size_t)HALF * K * 2;
    const unsigned ldsw = (unsigned)wid * 1024u;
    const int aoff = lds_byte(wr * 64 + fr, fq * 8), boff = lds_byte(wc * 32 + fr, fq * 8);
#define PG8_SA(b, h) (((b) * 2 + (h)) * HTB)
#define PG8_SB(b, h) ((4 + (b) * 2 + (h)) * HTB)
#define PG8_STAGE(bufoff, gbase, voff) do { _Pragma("unroll") for (int _i = 0; _i < 2; ++_i) \
        __builtin_amdgcn_global_load_lds((const unsigned*)((const char*)(gbase) + (voff)[_i]), (LAS unsigned*)(lds + (bufoff) + ldsw + _i * 8192), 16, 0, 0); } while (0)
#define PG8_STAGE_A(bufoff, h, nextu, kb) do { if constexpr (P::GATHER) { \
            _Pragma("unroll") for (int _i = 0; _i < 2; ++_i) { const unsigned _o = goffs[((((nextu) ? ui + 1 : ui) & 1) * 4 + (h) * 2 + _i) * 512 + tid]; \
                __builtin_amdgcn_global_load_lds((const unsigned*)(gA + (kb) + _o), (LAS unsigned*)(lds + (bufoff) + ldsw + _i * 8192), 16, 0, 0); } } \
        else { const char* _b = ((nextu) ? nA : cA) + (h) * hstep + (kb); PG8_STAGE(bufoff, _b, voffA); } } while (0)
#define PG8_LDA(dst, b, h) do { _Pragma("unroll") for (int m = 0; m < 4; ++m) _Pragma("unroll") for (int k = 0; k < 2; ++k) dst[m][k] = *(const LAS bf16x8*)(lds + PG8_SA(b, h) + aoff + m * 2048 + k * 1024); } while (0)
#define PG8_LDB(dst, b, h) do { _Pragma("unroll") for (int n = 0; n < 2; ++n) _Pragma("unroll") for (int k = 0; k < 2; ++k) dst[n][k] = *(const LAS bf16x8*)(lds + PG8_SB(b, h) + boff + n * 2048 + k * 1024); } while (0)
#define PG8_MMA(ai, bj, At, Bt) do { __builtin_amdgcn_s_setprio(1); _Pragma("unroll") for (int m = 0; m < 4; ++m) _Pragma("unroll") for (int n = 0; n < 2; ++n) _Pragma("unroll") for (int k = 0; k < 2; ++k) \
        acc[ai][bj][m][n] = __builtin_amdgcn_mfma_f32_16x16x32_bf16(Bt[n][k], At[m][k], acc[ai][bj][m][n], 0, 0, 0); __builtin_amdgcn_s_setprio(0); } while (0)
#define PG8_WAIT_V(n) asm volatile("s_waitcnt vmcnt(" #n ")" ::: "memory")
#define PG8_WAIT_L(n) asm volatile("s_waitcnt lgkmcnt(" #n ")" ::: "memory")
#define PG8_BAR __builtin_amdgcn_s_barrier()
#define PG8_SCHED __builtin_amdgcn_sched_barrier(0)
    Unit cur, nxt; int ui = 0;
    if (!p.next(0, cur)) return;
    f32x4 acc[2][2][4][2];
#pragma unroll
    for (int a = 0; a < 2; ++a)
#pragma unroll
        for (int b = 0; b < 2; ++b)
#pragma unroll
            for (int m = 0; m < 4; ++m)
#pragma unroll
                for (int n = 0; n < 2; ++n) acc[a][b][m][n] = (f32x4){0.f, 0.f, 0.f, 0.f};
    bf16x8 At[4][2], B0[2][2], B1[2][2];
    const char* cA = p.a_base(cur); const char* cB = p.b_base(cur);
    const char* nA = cA; const char* gA = cA;
    if constexpr (P::GATHER) { p.rows(cur, tid, goffs); p.rows(cur, tid, goffs + 4 * 512); }
    PG8_STAGE(PG8_SB(0, 0), cB, voffB); PG8_STAGE(PG8_SB(0, 1), cB + hstep, voffB); PG8_STAGE_A(PG8_SA(0, 0), 0, false, 0); PG8_STAGE_A(PG8_SA(0, 1), 1, false, 0);
    if (wr == 1) PG8_BAR;
    PG8_WAIT_V(2); PG8_BAR;
    PG8_STAGE(PG8_SB(1, 0), cB + kstep, voffB); PG8_STAGE_A(PG8_SA(1, 0), 0, false, kstep); PG8_STAGE(PG8_SB(1, 1), cB + hstep + kstep, voffB);
    PG8_WAIT_V(6); PG8_BAR;
    for (;;) {
        const bool has_next = p.next(ui + 1, nxt);
        nA = has_next ? p.a_base(nxt) : cA; const char* nB = has_next ? p.b_base(nxt) : cB;
        if constexpr (P::GATHER) { p.rows(has_next ? nxt : cur, tid, goffs + ((ui + 1) & 1) * 4 * 512); }
        for (int t = 0; t < nt; t += 2) {
            const bool last = (t == nt - 2);
            const size_t k1 = (size_t)(t + 1) * kstep;
            const size_t k2 = last ? 0 : (size_t)(t + 2) * kstep;
            const char* b2 = last ? nB : cB + (size_t)(t + 2) * kstep;
            const size_t k3 = k2 + kstep; const char* b3 = b2 + kstep;
            PG8_LDB(B0, 0, 0); PG8_LDB(B1, 0, 1); PG8_SCHED; PG8_LDA(At, 0, 0); PG8_STAGE_A(PG8_SA(1, 1), 1, false, k1);
            PG8_WAIT_V(8); PG8_WAIT_L(0); PG8_BAR; PG8_MMA(0, 0, At, B0); PG8_MMA(0, 1, At, B1); PG8_BAR; PG8_SCHED;
            PG8_LDA(At, 0, 1); PG8_STAGE(PG8_SB(0, 0), b2, voffB); PG8_STAGE(PG8_SB(0, 1), b2 + hstep, voffB); PG8_STAGE_A(PG8_SA(0, 0), 0, last, k2);
            PG8_WAIT_V(8); PG8_WAIT_L(0); PG8_BAR; PG8_MMA(1, 0, At, B0); PG8_MMA(1, 1, At, B1); PG8_BAR; PG8_SCHED;
            PG8_LDB(B0, 1, 0); PG8_LDB(B1, 1, 1); PG8_SCHED; PG8_LDA(At, 1, 0); PG8_STAGE_A(PG8_SA(0, 1), 1, last, k2);
            PG8_WAIT_V(8); PG8_WAIT_L(0); PG8_BAR; PG8_MMA(0, 0, At, B0); PG8_MMA(0, 1, At, B1); PG8_BAR; PG8_SCHED;
            PG8_LDA(At, 1, 1); PG8_STAGE(PG8_SB(1, 0), b3, voffB); PG8_STAGE(PG8_SB(1, 1), b3 + hstep, voffB); PG8_STAGE_A(PG8_SA(1, 0), 0, last, k3);
            PG8_WAIT_V(8); PG8_WAIT_L(0); PG8_BAR; PG8_MMA(1, 0, At, B0); PG8_MMA(1, 1, At, B1); PG8_BAR; PG8_SCHED;
        }
        if (wr == 0) PG8_BAR;
        p.epi(acc, cur, wr, wc, fr, fq);
        if (!has_next) break;
#pragma unroll
        for (int a = 0; a < 2; ++a)
#pragma unroll
            for (int b = 0; b < 2; ++b)
#pragma unroll
                for (int m = 0; m < 4; ++m)
#pragma unroll
                    for (int n = 0; n < 2; ++n) acc[a][b][m][n] = (f32x4){0.f, 0.f, 0.f, 0.f};
        cur = nxt; cA = nA; cB = nB; ++ui;
        if (wr == 1) PG8_BAR;
    }
    PG8_WAIT_V(0);
    PG8_BAR;
#undef PG8_SA
#undef PG8_SB
#undef PG8_STAGE
#undef PG8_STAGE_A
#undef PG8_LDA
#undef PG8_LDB
#undef PG8_MMA
#undef PG8_WAIT_V
#undef PG8_WAIT_L
#undef PG8_BAR
#undef PG8_SCHED
}
}

struct KArgs { const float* in[25]; float* out; unsigned char* ws; int ph_lo, ph_hi, li, pad; };
typedef const KArgs __attribute__((address_space(4))) CKArgs;
struct Frame {
    LAS unsigned char* lds;
    int tid, lane, wave, G, bid;
    CKArgs* ka;
    unsigned char* ws;
};
#define FIN(i) (F.ka->in[i])
#define FOUT (F.ka->out)
enum { I_X = 0, I_C, I_CTX, I_CCTX, I_WMOD, I_BMOD, I_GPREMIX, I_GPOSTMIX, I_GPREFFN, I_GPOSTFFN, I_WIN, I_CONVW, I_CONVB, I_RPB, I_GCONV, I_GATTN, I_WOUT, I_WROUTER, I_RBIAS,
       I_WEG, I_WEU, I_WED, I_WSG, I_WSU, I_WSD };

template <class RowMap>
__device__ __forceinline__ void transpose_item(const float* W, int ldn, int K, bf16* WT, LAS float* scr, int kb, int nb, int lane, const RowMap& rm) {
    const int k0 = 64 * kb, n0 = 64 * nb;
    f32x4 v[16];
#pragma unroll
    for (int i = 0; i < 16; ++i) v[i] = *(const GAS f32x4*)(W + (size_t)(k0 + 4 * i + (lane >> 4)) * ldn + n0 + 4 * (lane & 15));
#pragma unroll
    for (int i = 0; i < 16; ++i) { LAS float* d = scr + (4 * i + (lane >> 4)) * 65 + 4 * (lane & 15); d[0] = v[i].x; d[1] = v[i].y; d[2] = v[i].z; d[3] = v[i].w; }
    LDS_WAIT(); asm volatile("" ::: "memory");
    const int c = lane & 7;
#pragma unroll
    for (int j = 0; j < 8; ++j) { const int n = (lane >> 3) + 8 * j; const LAS float* s = scr + (8 * c) * 65 + n;
        v4u o; o.x = cvt_pk_bf16(s[0 * 65], s[1 * 65]); o.y = cvt_pk_bf16(s[2 * 65], s[3 * 65]); o.z = cvt_pk_bf16(s[4 * 65], s[5 * 65]); o.w = cvt_pk_bf16(s[6 * 65], s[7 * 65]);
        *(GAS v4u*)(WT + (size_t)rm(n0 + n) * K + k0 + 8 * c) = o; }
    LDS_WAIT(); asm volatile("" ::: "memory");
}
struct RmIdent { int off; __device__ __forceinline__ int operator()(int n) const { return off + n; } };
struct RmWin {
    __device__ __forceinline__ int operator()(int n) const {
        if (n < QOFF || n >= VOFF) return n;
        const int nn = n & 127, axis = nn >> 6, half = (nn >> 5) & 1, f = nn & 31;
        return (n - nn) + 2 * (axis * 32 + f) + half; }
};
struct RmGU { int base; int up; __device__ __forceinline__ int operator()(int f) const { return base + 32 * (f >> 4) + 16 * up + (f & 15); } };

__device__ __forceinline__ void p0_prologue(Frame& F) {
    const int gw = F.bid * NWAVES + F.wave, NGW = F.G * NWAVES;
    if (F.bid == 0) {
        GAS f32x2* rope = (GAS f32x2*)(F.ws + WS_ROPE);
        for (int i = F.tid; i < 64 * 32; i += NTHR) { const int pos = i >> 5, f = i & 31;
            const float inv = powf(10000.0f, -(float)f / 32.0f); const float ang = (float)pos * inv;
            rope[i] = (f32x2){(float)cos((double)ang), (float)sin((double)ang)}; }
    }
    {
        LAS float* act = (LAS float*)F.lds;
        LAS float* red = (LAS float*)(F.lds + 9 * 2048 * 4);
        for (int i = F.tid; i < 9 * 2048; i += NTHR) { const int r = i >> 11, k = i & 2047; const float v = r < 8 ? FIN(I_C)[r * 2048 + k] : FIN(I_CCTX)[k]; act[i] = silu_f(v); }
        __syncthreads();
        const float* wm = FIN(I_WMOD);
        for (int cb = F.bid; cb < 256; cb += F.G) {
            const int kq = F.wave * 5 + F.lane / 12, cq = F.lane % 12; const bool on = F.lane < 60;
            f32x4 a[9];
#pragma unroll
            for (int r = 0; r < 9; ++r) a[r] = (f32x4){0.f, 0.f, 0.f, 0.f};
            if (on) for (int k = kq; k < 2048; k += 40) { const f32x4 w = *(const GAS f32x4*)(wm + (size_t)k * 12288 + cb * 48 + cq * 4);
#pragma unroll
                for (int r = 0; r < 9; ++r) a[r] += w * act[r * 2048 + k]; }
#pragma unroll
            for (int r = 0; r < 9; ++r) {
                f32x4 s = a[r];
#pragma unroll
                for (int j = 1; j < 5; ++j) { const int src = (F.lane % 12) + 12 * j; f32x4 o; o.x = __shfl(a[r].x, src); o.y = __shfl(a[r].y, src); o.z = __shfl(a[r].z, src); o.w = __shfl(a[r].w, src); s += o; }
                if (F.lane < 12) *(LAS f32x4*)(red + (F.wave * 9 + r) * 48 + F.lane * 4) = s;
            }
            __syncthreads();
            if (F.tid < 9 * 48) { const int r = F.tid / 48, cc = F.tid % 48; float s = 0.f;
#pragma unroll
                for (int w = 0; w < 8; ++w) s += red[(w * 9 + r) * 48 + cc];
                ((GAS float*)(F.ws + WS_MOD))[r * 12288 + cb * 48 + cc] = s + FIN(I_BMOD)[cb * 48 + cc]; }
            __syncthreads();
        }
    }
    {
        LAS float* scr = (LAS float*)(F.lds + F.wave * 16896);
        bf16* Win = (bf16*)(F.ws + WS_WIN); bf16* Wout = (bf16*)(F.ws + WS_WOUT); bf16* Wgu = (bf16*)(F.ws + WS_WGU); bf16* Wdn = (bf16*)(F.ws + WS_WDN);
        constexpr int IT_IN = 32 * 96, IT_OUT = 32 * 32, IT_G = 64 * 32 * 8, IT_D = 64 * 8 * 32, IT_SG = 32 * 8, IT_SD = 8 * 32, IT_R = 32 * 2;
        constexpr int NIT = IT_IN + IT_OUT + 2 * IT_G + IT_D + 2 * IT_SG + IT_SD + IT_R;
        for (int it = gw; it < NIT; it += NGW) {
            int r = it;
            if (r < IT_IN) { transpose_item(FIN(I_WIN), NPROJ, DM, Win, scr, r / 96, r % 96, F.lane, RmWin{}); continue; } r -= IT_IN;
            if (r < IT_OUT) { transpose_item(FIN(I_WOUT), DM, DM, Wout, scr, r / 32, r % 32, F.lane, RmIdent{0}); continue; } r -= IT_OUT;
            if (r < IT_G) { const int e = r / 256, q = r % 256; transpose_item(FIN(I_WEG) + (size_t)e * DM * FE, FE, DM, Wgu, scr, q / 8, q % 8, F.lane, RmGU{e * 1024, 0}); continue; } r -= IT_G;
            if (r < IT_G) { const int e = r / 256, q = r % 256; transpose_item(FIN(I_WEU) + (size_t)e * DM * FE, FE, DM, Wgu, scr, q / 8, q % 8, F.lane, RmGU{e * 1024, 1}); continue; } r -= IT_G;
            if (r < IT_D) { const int e = r / 256, q = r % 256; transpose_item(FIN(I_WED) + (size_t)e * FE * DM, DM, FE, Wdn, scr, q / 32, q % 32, F.lane, RmIdent{e * 2048}); continue; } r -= IT_D;
            if (r < IT_SG) { transpose_item(FIN(I_WSG), FE, DM, Wgu, scr, r / 8, r % 8, F.lane, RmGU{64 * 1024, 0}); continue; } r -= IT_SG;
            if (r < IT_SG) { transpose_item(FIN(I_WSU), FE, DM, Wgu, scr, r / 8, r % 8, F.lane, RmGU{64 * 1024, 1}); continue; } r -= IT_SG;
            if (r < IT_SD) { transpose_item(FIN(I_WSD), DM, FE, Wdn, scr, r / 32, r % 32, F.lane, RmIdent{64 * 2048}); continue; } r -= IT_SD;
            {
                const int kb = r / 2, nb = r % 2; const float* W = FIN(I_WROUTER);
                bf16* WH = (bf16*)(F.ws + WS_WRH); bf16* WL = (bf16*)(F.ws + WS_WRL);
                for (int i = 0; i < 32; ++i) { const int kk = 2 * i + (F.lane >> 5), n = nb * 32 + (F.lane & 31), k = kb * 64 + kk;
                    const float v = W[(size_t)k * NE + n]; const unsigned hi = cvt_pk_bf16(v, 0.f) & 0xffffu; const float rem = v - bf_lo(hi);
                    WH[(size_t)n * DM + k] = (bf16)hi; WL[(size_t)n * DM + k] = (bf16)(cvt_pk_bf16(rem, 0.f) & 0xffffu); }
            }
        }
    }
}

__device__ __forceinline__ void p1_norm(Frame& F) {
    const int gw = F.bid * NWAVES + F.wave, NGW = F.G * NWAVES;
    const float* MOD = (const float*)(F.ws + WS_MOD); const float* g = FIN(I_GPREMIX);
    for (int row = gw; row < T + TC; row += NGW) {
        const bool lat = row < T; const int rr = lat ? row : row - T;
        const float* xr = (lat ? FIN(I_X) : FIN(I_CTX)) + (size_t)rr * DM;
        const float* md = MOD + (size_t)(lat ? (rr >> 11) : 8) * 12288;
        bf16* orow = (bf16*)(F.ws + (lat ? WS_HL : WS_HC)) + (size_t)rr * DM;
        f32x4 v[8]; float ss = 0.f;
#pragma unroll
        for (int j = 0; j < 8; ++j) { v[j] = *(const GAS f32x4*)(xr + 4 * F.lane + 256 * j); ss += (v[j].x * v[j].x + v[j].y * v[j].y) + (v[j].z * v[j].z + v[j].w * v[j].w); }
        const float rstd = 1.0f / sqrtf(wave_sum(ss) * (1.0f / DM) + EPS);
#pragma unroll
        for (int j = 0; j < 8; ++j) { const int c = 4 * F.lane + 256 * j;
            const f32x4 gg = *(const GAS f32x4*)(g + c), sh = *(const GAS f32x4*)(md + c), sc = *(const GAS f32x4*)(md + 2048 + c);
            const f32x4 o = (v[j] * rstd) * gg * (sc + 1.0f) + sh;
            *(GAS v2u*)(orow + c) = (v2u){cvt_pk_bf16(o.x, o.y), cvt_pk_bf16(o.z, o.w)}; }
    }
}

struct ProbProj {
    static constexpr int K = DM; static constexpr bool GATHER = false, PERM = true;
    const bf16 *HL, *HC, *Win; bf16 *PROJ, *KVC; const f32x2* rope; int G, c;
    static constexpr int NMAIN = 64 * 24, NTOT = NMAIN + 64;
    __device__ __forceinline__ bool next(int i, pg8::Unit& u) const {
        const int w = pg8::round_unit(i, G, c, NTOT); if (w < 0) return false;
        if (w < NMAIN) { const int gid = w / 192, r = w % 192; u.pm = gid * 8 + (r & 7); u.pn = r >> 3; u.g = 0; }
        else { const int j = w - NMAIN; u.pm = j & 7; u.pn = 16 + (j >> 3); u.g = 1; }
        return true; }
    __device__ __forceinline__ const char* a_base(const pg8::Unit& u) const { return (const char*)HL + (size_t)u.g * (size_t)(WS_HC - WS_HL) + (size_t)u.pm * 256 * K * 2; }
    __device__ __forceinline__ const char* b_base(const pg8::Unit& u) const { return (const char*)Win + (size_t)u.pn * 256 * K * 2; }
    __device__ __forceinline__ void rows(const pg8::Unit&, int, LAS unsigned*) const {}
    __device__ __forceinline__ void epi(const f32x4 (&acc)[2][2][4][2], const pg8::Unit& u, int wr, int wc, int fr, int fq) const {
        const int row0 = u.pm * 256 + wr * 64 + fr;
        const bool rot = (u.g == 0) && (u.pn >= 12) && (u.pn < 20);
        bf16* base = (bf16*)((char*)PROJ + (long)u.g * ((long)WS_KVC - (long)WS_PROJ));
        const int ldc = NPROJ - u.g * (NPROJ - DM), col0 = (u.pn - 16 * u.g) * 256 + wc * 32 + 8 * fq;
        const int p0 = (wc * 32 + 8 * fq) >> 1, axis = p0 >> 5, f0 = p0 & 31;
#pragma unroll
        for (int ai = 0; ai < 2; ++ai)
#pragma unroll
            for (int m = 0; m < 4; ++m) {
                const int row = row0 + ai * 128 + m * 16; bf16* rowp = base + (size_t)row * ldc + col0;
                const int t = row & (SEQ - 1); const int pos = axis ? (t & 63) : (t >> 6);
                const f32x4 csA = *(const GAS f32x4*)(rope + pos * 32 + f0), csB = *(const GAS f32x4*)(rope + pos * 32 + f0 + 2);
                const f32x2 cs0 = (f32x2){csA.x, csA.y}, cs1 = (f32x2){csA.z, csA.w}, cs2 = (f32x2){csB.x, csB.y}, cs3 = (f32x2){csB.z, csB.w};
#pragma unroll
                for (int bj = 0; bj < 2; ++bj) { f32x4 v0 = acc[ai][bj][m][0], v1 = acc[ai][bj][m][1];
                    if (rot) { f32x4 r0, r1;
                        r0.x = v0.x * cs0.x - v0.y * cs0.y; r0.y = v0.y * cs0.x + v0.x * cs0.y;
                        r0.z = v0.z * cs1.x - v0.w * cs1.y; r0.w = v0.w * cs1.x + v0.z * cs1.y;
                        r1.x = v1.x * cs2.x - v1.y * cs2.y; r1.y = v1.y * cs2.x + v1.x * cs2.y;
                        r1.z = v1.z * cs3.x - v1.w * cs3.y; r1.w = v1.w * cs3.x + v1.z * cs3.y; v0 = r0; v1 = r1; }
                    v4u w; w.x = cvt_pk_bf16(v0.x, v0.y); w.y = cvt_pk_bf16(v0.z, v0.w); w.z = cvt_pk_bf16(v1.x, v1.y); w.w = cvt_pk_bf16(v1.z, v1.w);
                    *(GAS v4u*)(rowp + bj * 128) = w; } }
    }
};

__device__ __forceinline__ float dot2bf(unsigned a, unsigned b, float c) { return __builtin_amdgcn_fdot2_f32_bf16(__builtin_bit_cast(v2bf, a), __builtin_bit_cast(v2bf, b), c, false); }
__device__ __forceinline__ void p3_attn_simple(Frame& F) {
    const bf16* PROJ = (const bf16*)(F.ws + WS_PROJ); const bf16* KVC = (const bf16*)(F.ws + WS_KVC); bf16* Y = (bf16*)(F.ws + WS_Y);
    const float* rpb = FIN(I_RPB); const float* gat = FIN(I_GATTN);
    const float scale = 0.08838834764831845f;
    const int per = (T * NH) / F.G;
    for (int i = F.wave; i < per; i += NWAVES) {
        const int task = F.bid * per + i; const int t = task & (SEQ - 1), bh = task >> 11, h = bh & 7, b = bh >> 3;
        const int r = t >> 6, c = t & 63; int r0 = r - 4; r0 = r0 < 0 ? 0 : (r0 > 24 ? 24 : r0); int cs = c - 8; cs = cs < 0 ? 0 : (cs > 48 ? 48 : cs);
        const unsigned qv = *(const GAS unsigned*)(PROJ + (size_t)(b * SEQ + t) * NPROJ + QOFF + h * HD + 2 * F.lane);
        const bf16* kp[6]; float sc[6];
#pragma unroll
        for (int j = 0; j < 6; ++j) { const int n = F.lane + 64 * j;
            if (j < 2) { const int ii = n >> 4, jj = n & 15; const int tk = (r0 + ii) * GW + cs + jj; kp[j] = PROJ + (size_t)(b * SEQ + tk) * NPROJ + KOFF + h * HD; }
            else kp[j] = KVC + (size_t)(b * LC + (n - 128)) * DM + h * HD;
            sc[j] = 0.f; }
#pragma unroll 4
        for (int pc = 0; pc < 16; ++pc) {
            v4u kk[6];
#pragma unroll
            for (int j = 0; j < 6; ++j) kk[j] = *(const GAS v4u*)(kp[j] + 8 * pc);
            const unsigned q0 = __builtin_amdgcn_readlane(qv, 4 * pc), q1 = __builtin_amdgcn_readlane(qv, 4 * pc + 1), q2 = __builtin_amdgcn_readlane(qv, 4 * pc + 2), q3 = __builtin_amdgcn_readlane(qv, 4 * pc + 3);
#pragma unroll
            for (int j = 0; j < 6; ++j) { sc[j] = dot2bf(q0, kk[j].x, sc[j]); sc[j] = dot2bf(q1, kk[j].y, sc[j]); sc[j] = dot2bf(q2, kk[j].z, sc[j]); sc[j] = dot2bf(q3, kk[j].w, sc[j]); }
        }
        float mx = -1e30f;
#pragma unroll
        for (int j = 0; j < 6; ++j) { sc[j] *= scale;
            if (j < 2) { const int n = F.lane + 64 * j, ii = n >> 4, jj = n & 15; sc[j] += rpb[(h * 15 + (r0 + ii - r + 7)) * 31 + (cs + jj - c + 15)]; }
            mx = fmaxf(mx, sc[j]); }
        mx = wave_max(mx);
        float ps = 0.f;
#pragma unroll
        for (int j = 0; j < 6; ++j) { sc[j] = __expf(sc[j] - mx); ps += sc[j]; }
        ps = wave_sum(ps);
        float o0 = 0.f, o1 = 0.f;
        const bf16* vl = PROJ + (size_t)(b * SEQ) * NPROJ + VOFF + h * HD + 2 * F.lane;
        const bf16* vc = KVC + (size_t)(b * LC) * DM + DC + h * HD + 2 * F.lane;
#pragma unroll
        for (int j = 0; j < 6; ++j) {
#pragma unroll 8
            for (int l = 0; l < 64; ++l) { const int n = l + 64 * j; const float p = __builtin_bit_cast(float, __builtin_amdgcn_readlane(__builtin_bit_cast(unsigned, sc[j]), l));
                unsigned vv;
                if (j < 2) { const int tk = (r0 + (n >> 4)) * GW + cs + (n & 15); vv = *(const GAS unsigned*)(vl + (size_t)tk * NPROJ); }
                else vv = *(const GAS unsigned*)(vc + (size_t)(n - 128) * DM);
                o0 += p * bf_lo(vv); o1 += p * bf_hi(vv); }
        }
        const float inv = 1.0f / ps; o0 *= inv; o1 *= inv;
        const float rstd = 1.0f / sqrtf(wave_sum(o0 * o0 + o1 * o1) * (1.0f / HD) + EPS);
        const f32x2 gg = *(const GAS f32x2*)(gat + h * HD + 2 * F.lane);
        *(GAS unsigned*)(Y + (size_t)(b * SEQ + t) * DM + DC + h * HD + 2 * F.lane) = cvt_pk_bf16(o0 * rstd * gg.x, o1 * rstd * gg.y);
    }
}

namespace at {
typedef short s16x4 __attribute__((ext_vector_type(4)));
typedef float f32x16 __attribute__((ext_vector_type(16)));
constexpr float SCALE = 0.088388347648318440f;
constexpr float THR = 8.f;
constexpr int SHM_V = 64 * 128 * 2, SHM_K = 64 * 128 * 2;
constexpr int WS_OFF = 2 * SHM_V + 2 * SHM_K, BT_OFF = WS_OFF + 8 * 64 * 4, BT_FLOATS = 15 * 32 + 192;
#define KSWZ(row, colB) ((row) * 256 + ((colB) ^ (((row) & 7) << 4)))
#define SBAR() __builtin_amdgcn_sched_barrier(0)
__device__ __forceinline__ int crow(int r, int hi) { return (r & 3) + 8 * (r >> 2) + 4 * hi; }
__device__ __forceinline__ void partialSM(f32x16& p0, f32x16& p1, float& m_reg, float& mn, float& alpha) {
  constexpr float C = SCALE * 1.4426950408889634f;
  float pmax = p0[0];
#pragma unroll
  for (int r = 1; r < 16; ++r) pmax = fmaxf(pmax, p0[r]);
#pragma unroll
  for (int r = 0; r < 16; ++r) pmax = fmaxf(pmax, p1[r]);
  { auto rr = __builtin_amdgcn_permlane32_swap(__builtin_bit_cast(unsigned, pmax), __builtin_bit_cast(unsigned, pmax), false, false);
    pmax = fmaxf(u2f(rr[0]), u2f(rr[1])); }
  if (__builtin_expect(__all(pmax - m_reg <= THR / SCALE), 1)) { mn = m_reg; alpha = 1.f; }
  else { mn = fmaxf(m_reg, pmax); alpha = __builtin_amdgcn_exp2f((m_reg - mn) * C); m_reg = mn; }
  const float mnC = -mn * C;
#pragma unroll
  for (int r = 0; r < 16; ++r) p0[r] = fmaf(p0[r], C, mnC);
#pragma unroll
  for (int r = 0; r < 16; ++r) p1[r] = fmaf(p1[r], C, mnC);
#pragma unroll
  for (int r = 0; r < 16; ++r) p0[r] = __builtin_amdgcn_exp2f(p0[r]);
}
__device__ __forceinline__ void finishSM(f32x16& p0, f32x16& p1, float alpha, float& l_reg, bf16x8& pa0, bf16x8& pa1, bf16x8& pa2, bf16x8& pa3) {
#pragma unroll
  for (int r = 0; r < 16; ++r) p1[r] = __builtin_amdgcn_exp2f(p1[r]);
  float ps = 0;
#pragma unroll
  for (int r = 0; r < 16; ++r) ps += p0[r];
#pragma unroll
  for (int r = 0; r < 16; ++r) ps += p1[r];
  { auto rr = __builtin_amdgcn_permlane32_swap(__builtin_bit_cast(unsigned, ps), __builtin_bit_cast(unsigned, ps), false, false);
    ps = u2f(rr[0]) + u2f(rr[1]); }
  l_reg = l_reg * alpha + ps;
#define PK4(P, BASE, OUT) do { unsigned a0 = cvt_pk_bf16(P[BASE + 0], P[BASE + 1]), a1 = cvt_pk_bf16(P[BASE + 2], P[BASE + 3]);   \
    unsigned b0 = cvt_pk_bf16(P[BASE + 4], P[BASE + 5]), b1 = cvt_pk_bf16(P[BASE + 6], P[BASE + 7]);                              \
    auto r0 = __builtin_amdgcn_permlane32_swap(a0, b0, false, false); auto r1 = __builtin_amdgcn_permlane32_swap(a1, b1, false, false); \
    v4u w = {r0[0], r1[0], r0[1], r1[1]}; OUT = __builtin_bit_cast(bf16x8, w); } while (0)
  PK4(p0, 0, pa0); PK4(p0, 8, pa1); PK4(p1, 0, pa2); PK4(p1, 8, pa3);
#undef PK4
}
__device__ __forceinline__ void qkt(f32x16& p0, f32x16& p1, const LAS char* Ks, const bf16x8* qr, int r32, int hi) {
  p0 = f32x16{}; p1 = f32x16{};
#pragma unroll
  for (int d0 = 0; d0 < 8; ++d0) { const int cb = (d0 * 16 + hi * 8) * 2;
    const bf16x8 b0 = *(const LAS bf16x8*)(Ks + KSWZ(r32, cb));
    const bf16x8 b1 = *(const LAS bf16x8*)(Ks + KSWZ(32 + r32, cb));
    p0 = __builtin_amdgcn_mfma_f32_32x32x16_bf16(b0, qr[d0], p0, 0, 0, 0);
    p1 = __builtin_amdgcn_mfma_f32_32x32x16_bf16(b1, qr[d0], p1, 0, 0, 0); }
}
__device__ __forceinline__ int v_st(int k, int c) { const int kk = (k & ~0xC) | ((k & 4) << 1) | ((k & 8) >> 1); return ((kk >> 3) * 4 + (c >> 5)) * 512 + ((kk & 7) * 32 + (c & 31)) * 2; }
__device__ __forceinline__ int v_rd_base(int lane) { return ((lane & 3) << 3) | (((lane >> 2) & 3) << 6) | (((lane >> 4) & 1) << 5) | (((lane >> 5) & 1) << 8); }
constexpr int v_rd_off(int d0, int ks, int half) { return d0 * 512 + ks * 4096 + half * 2048; }
template <int OFF> __device__ __forceinline__ s16x4 tr_read(int vb) {
  s16x4 r; asm volatile("ds_read_b64_tr_b16 %0, %1 offset:%2" : "=&v"(r) : "v"(vb), "i"(OFF) : "memory"); return r;
}
template <int D0> __device__ __forceinline__ void pv_one(f32x16& od, int vb, bf16x8 pa0, bf16x8 pa1, bf16x8 pa2, bf16x8 pa3) {
  const s16x4 l0 = tr_read<v_rd_off(D0, 0, 0)>(vb), h0 = tr_read<v_rd_off(D0, 0, 1)>(vb), l1 = tr_read<v_rd_off(D0, 1, 0)>(vb), h1 = tr_read<v_rd_off(D0, 1, 1)>(vb);
  const s16x4 l2 = tr_read<v_rd_off(D0, 2, 0)>(vb), h2 = tr_read<v_rd_off(D0, 2, 1)>(vb), l3 = tr_read<v_rd_off(D0, 3, 0)>(vb), h3 = tr_read<v_rd_off(D0, 3, 1)>(vb);
  asm volatile("s_waitcnt lgkmcnt(0)" ::: "memory"); SBAR();
#define PK(L, H) (bf16x8){L[0], L[1], L[2], L[3], H[0], H[1], H[2], H[3]}
  od = __builtin_amdgcn_mfma_f32_32x32x16_bf16(pa0, PK(l0, h0), od, 0, 0, 0);
  od = __builtin_amdgcn_mfma_f32_32x32x16_bf16(pa1, PK(l1, h1), od, 0, 0, 0);
  od = __builtin_amdgcn_mfma_f32_32x32x16_bf16(pa2, PK(l2, h2), od, 0, 0, 0);
  od = __builtin_amdgcn_mfma_f32_32x32x16_bf16(pa3, PK(l3, h3), od, 0, 0, 0);
#undef PK
}
__device__ __forceinline__ void pv_d0(f32x16* o, int vb, bf16x8 pa0, bf16x8 pa1, bf16x8 pa2, bf16x8 pa3) {
  pv_one<0>(o[0], vb, pa0, pa1, pa2, pa3); pv_one<1>(o[1], vb, pa0, pa1, pa2, pa3); pv_one<2>(o[2], vb, pa0, pa1, pa2, pa3); pv_one<3>(o[3], vb, pa0, pa1, pa2, pa3);
}
__device__ __forceinline__ void bias_mask(f32x16& p0, f32x16& p1, const LAS float* bt, int j, int kr_lo, int rq, int r0w, int c, int cs, int hi) {
  if (j < 4) return;
  const int kr = kr_lo + (j - 4);
  if (kr < r0w || kr > r0w + 7) {
#pragma unroll
    for (int r = 0; r < 16; ++r) { p0[r] = -1e30f; p1[r] = -1e30f; }
    return; }
  const LAS float* bp = bt + 64 + (kr - rq + 7) * 32 + 15 - c + 4 * hi;
  const int kc0 = 4 * hi - cs;
#pragma unroll
  for (int r = 0; r < 16; ++r) { const int KC = (r & 3) + 8 * (r >> 2);
    const float b0 = bp[KC], b1 = bp[KC + 32];
    p0[r] = ((unsigned)(kc0 + KC) < 16u) ? p0[r] + b0 : -1e30f;
    p1[r] = ((unsigned)(kc0 + KC + 32) < 16u) ? p1[r] + b1 : -1e30f;
    if ((r & 3) == 3) asm volatile("" ::: "memory"); }
}
}

__device__ __forceinline__ void attn_unit(Frame& F, int b, int h, int g) {
  using namespace at;
  const bf16* PROJ = (const bf16*)(F.ws + WS_PROJ); const bf16* KVC = (const bf16*)(F.ws + WS_KVC); bf16* Y = (bf16*)(F.ws + WS_Y);
  const int tid = F.tid, wid = F.wave, lane = F.lane, r32 = lane & 31, hi = lane >> 5;
  const LAS char* ldsc = (const LAS char*)F.lds;
  LAS char* V_lds = (LAS char*)F.lds; LAS char* K_lds = (LAS char*)F.lds + 2 * SHM_V;
  LAS float* wsl = (LAS float*)(F.lds + WS_OFF) + wid * 64; LAS float* li_l = wsl; LAS float* al_l = wsl + 32;
  LAS float* bt = (LAS float*)(F.lds + BT_OFF);
  const int nloc = (g == 0 || g == 7) ? 8 : 12; const int kr_lo = (g == 0) ? 0 : (g == 7 ? 24 : 4 * g - 4); const int NT = 4 + nloc;
  const int rq = 4 * g + (wid >> 1); int r0w = rq - 4; r0w = r0w < 0 ? 0 : (r0w > 24 ? 24 : r0w);
  const int c = (wid & 1) * 32 + r32; int cs = c - 8; cs = cs < 0 ? 0 : (cs > 48 ? 48 : cs);
  __syncthreads();
  for (int i = tid; i < BT_FLOATS; i += NTHR) { const int k = i - 64; float v = 0.f;
    if (k >= 0 && k < 15 * 32 && (k & 31) < 31) v = FIN(I_RPB)[(h * 15 + (k >> 5)) * 31 + (k & 31)] * (1.0f / SCALE);
    bt[i] = v; }
  float m_reg = -1e30f, l_reg = 0; f32x16 o[4] = {}; bf16x8 qr[8];
  const bf16* Qw = PROJ + (size_t)(b * SEQ + rq * GW + c) * NPROJ + QOFF + h * HD + hi * 8;
#pragma unroll
  for (int d0 = 0; d0 < 8; ++d0) qr[d0] = *(const GAS bf16x8*)(Qw + d0 * 16);
  const int sr = tid >> 4, sc = (tid & 15) * 8, vst0 = v_st(sr, sc), vst1 = v_st(32 + sr, sc);
  const int vb0 = (int)(uintptr_t)V_lds + v_rd_base(lane);
  const GAS char* Kc = (const GAS char*)(KVC + (size_t)(b * LC) * DM + h * HD);
  const GAS char* Kl = (const GAS char*)(PROJ + (size_t)(b * SEQ) * NPROJ + KOFF + h * HD);
  const unsigned vo_c = (unsigned)(sr * DM + sc) * 2u, vo_l = (unsigned)(sr * NPROJ + sc) * 2u;
  struct { bf16x8 vs0, vs1, ks0, ks1; } st_;
#define SLOAD(j) do { const int _j = (j); const GAS char* _k; unsigned _vo; size_t _h; \
    if (_j < 4) { _k = Kc + (size_t)(_j * 64) * DM * 2; _vo = vo_c; _h = (size_t)32 * DM * 2; } else { _k = Kl + (size_t)((kr_lo + _j - 4) * GW) * NPROJ * 2; _vo = vo_l; _h = (size_t)32 * NPROJ * 2; } \
    st_.ks0 = *(const GAS bf16x8*)(_k + _vo); st_.ks1 = *(const GAS bf16x8*)(_k + _h + _vo); \
    st_.vs0 = *(const GAS bf16x8*)(_k + 2048 + _vo); st_.vs1 = *(const GAS bf16x8*)(_k + _h + 2048 + _vo); } while (0)
#define SWRITE(bb) do { *(LAS bf16x8*)(V_lds + (bb) * SHM_V + vst0) = st_.vs0; *(LAS bf16x8*)(V_lds + (bb) * SHM_V + vst1) = st_.vs1; const int kc = sc * 2; \
    *(LAS bf16x8*)(K_lds + (bb) * SHM_K + KSWZ(sr, kc)) = st_.ks0; *(LAS bf16x8*)(K_lds + (bb) * SHM_K + KSWZ(32 + sr, kc)) = st_.ks1; } while (0)
#define RESC(a) do { if (__any((a) < 1.f)) { if (hi == 0) al_l[r32] = (a); asm volatile("s_waitcnt lgkmcnt(0)" ::: "memory"); \
    _Pragma("unroll") for (int d = 0; d < 4; ++d) _Pragma("unroll") for (int r = 0; r < 16; ++r) o[d][r] *= al_l[crow(r, hi)]; } } while (0)
#define BIAS(P0, P1, j) bias_mask(P0, P1, bt, (j), kr_lo, rq, r0w, c, cs, hi)
  f32x16 p0, p1; float mn, al; bf16x8 pa0, pa1, pa2, pa3;
#define STEP(j, B) do { SWRITE(B); if ((j) + 1 < NT) SLOAD((j) + 1); __syncthreads(); \
    qkt(p0, p1, K_lds + (B) * SHM_K, qr, r32, hi); BIAS(p0, p1, (j)); partialSM(p0, p1, m_reg, mn, al); RESC(al); \
    finishSM(p0, p1, al, l_reg, pa0, pa1, pa2, pa3); SBAR(); pv_d0(o, vb0 + (B) * SHM_V, pa0, pa1, pa2, pa3); } while (0)
  SLOAD(0);
  for (int j = 0; j < NT; j += 2) { STEP(j, 0); STEP(j + 1, 1); }
#undef STEP
  asm volatile("s_waitcnt vmcnt(0)" ::: "memory");
  if (hi == 0) li_l[r32] = l_reg; asm volatile("s_waitcnt lgkmcnt(0)" ::: "memory");
  const float* ga = FIN(I_GATTN) + h * HD;
  float gg[4];
#pragma unroll
  for (int d0 = 0; d0 < 4; ++d0) gg[d0] = ga[d0 * 32 + r32];
  bf16* Yw = Y + (size_t)(b * SEQ + rq * GW + (wid & 1) * 32) * DM + DC + h * HD + r32;
#pragma unroll
  for (int r = 0; r < 16; ++r) { const int orow = crow(r, hi); const float rl = 1.0f / li_l[orow];
    float v0 = o[0][r] * rl, v1 = o[1][r] * rl, v2 = o[2][r] * rl, v3 = o[3][r] * rl;
    float ss = (v0 * v0 + v1 * v1) + (v2 * v2 + v3 * v3);
    ss += __shfl_xor(ss, 1); ss += __shfl_xor(ss, 2); ss += __shfl_xor(ss, 4); ss += __shfl_xor(ss, 8); ss += __shfl_xor(ss, 16);
    const float rstd = 1.0f / sqrtf(ss * (1.0f / HD) + EPS);
    bf16* yr = Yw + (size_t)orow * DM;
    yr[0] = (bf16)(cvt_pk_bf16(v0 * rstd * gg[0], 0.f) & 0xffffu); yr[32] = (bf16)(cvt_pk_bf16(v1 * rstd * gg[1], 0.f) & 0xffffu);
    yr[64] = (bf16)(cvt_pk_bf16(v2 * rstd * gg[2], 0.f) & 0xffffu); yr[96] = (bf16)(cvt_pk_bf16(v3 * rstd * gg[3], 0.f) & 0xffffu); }
#undef SLOAD
#undef SWRITE
#undef RESC
#undef BIAS
}
__device__ __forceinline__ void p3_attn_mfma(Frame& F) {
  const int cx = (F.bid & 7) * 32 + (F.bid >> 3);
  for (int u = cx; u < 512; u += 256) {
    int bh, g;
    if (u < 384) { bh = u / 6; g = 1 + u % 6; } else { const int s = u - 384; bh = s >> 1; g = (s & 1) ? 7 : 0; }
    attn_unit(F, bh >> 3, bh & 7, g);
  }
}

__device__ __forceinline__ void p3_conv(Frame& F) {
    const bf16* PROJ = (const bf16*)(F.ws + WS_PROJ); bf16* Y = (bf16*)(F.ws + WS_Y);
    const float* cw = FIN(I_CONVW); const float* cb = FIN(I_CONVB); const float* gc = FIN(I_GCONV);
    const int gw = F.bid * NWAVES + F.wave, NGW = F.G * NWAVES;
    const int ch0 = 16 * F.lane;
    for (int row = gw; row < T; row += NGW) {
        const int t = row & (SEQ - 1);
        const bf16* pr = PROJ + (size_t)row * NPROJ + ch0;
        float pm[16], p0[16], pp[16], ub[16];
#pragma unroll
        for (int hh = 0; hh < 2; ++hh) {
            const v4u vb = *(const GAS v4u*)(pr + 8 * hh), vc0 = *(const GAS v4u*)(pr + 1024 + 8 * hh), vx0 = *(const GAS v4u*)(pr + 2048 + 8 * hh);
            v4u vcm = (v4u){0, 0, 0, 0}, vxm = vcm, vcp = vcm, vxp = vcm;
            if (t > 0) { vcm = *(const GAS v4u*)(pr - NPROJ + 1024 + 8 * hh); vxm = *(const GAS v4u*)(pr - NPROJ + 2048 + 8 * hh); }
            if (t < SEQ - 1) { vcp = *(const GAS v4u*)(pr + NPROJ + 1024 + 8 * hh); vxp = *(const GAS v4u*)(pr + NPROJ + 2048 + 8 * hh); }
#pragma unroll
            for (int q = 0; q < 4; ++q) { const int e = 8 * hh + 2 * q;
                ub[e] = bf_lo(vb[q]); ub[e + 1] = bf_hi(vb[q]);
                p0[e] = bf_lo(vc0[q]) * bf_lo(vx0[q]); p0[e + 1] = bf_hi(vc0[q]) * bf_hi(vx0[q]);
                pm[e] = bf_lo(vcm[q]) * bf_lo(vxm[q]); pm[e + 1] = bf_hi(vcm[q]) * bf_hi(vxm[q]);
                pp[e] = bf_lo(vcp[q]) * bf_lo(vxp[q]); pp[e + 1] = bf_hi(vcp[q]) * bf_hi(vxp[q]); }
        }
        float o[16]; float ss = 0.f;
#pragma unroll
        for (int q = 0; q < 4; ++q) { const f32x4 w0 = *(const GAS f32x4*)(cw + ch0 + 4 * q), w1 = *(const GAS f32x4*)(cw + 1024 + ch0 + 4 * q), w2 = *(const GAS f32x4*)(cw + 2048 + ch0 + 4 * q), bb = *(const GAS f32x4*)(cb + ch0 + 4 * q);
#pragma unroll
            for (int e = 0; e < 4; ++e) { const int k = 4 * q + e; const float cv = pm[k] * w0[e] + p0[k] * w1[e] + pp[k] * w2[e] + bb[e]; o[k] = ub[k] * cv; ss += o[k] * o[k]; } }
        ss += __shfl_xor(ss, 1); ss += __shfl_xor(ss, 2); ss += __shfl_xor(ss, 4);
        const float rstd = 1.0f / sqrtf(ss * (1.0f / 128.0f) + EPS);
        unsigned w[8];
#pragma unroll
        for (int q = 0; q < 4; ++q) { const f32x4 gg = *(const GAS f32x4*)(gc + ch0 + 4 * q);
            w[2 * q] = cvt_pk_bf16(o[4 * q] * rstd * gg[0], o[4 * q + 1] * rstd * gg[1]); w[2 * q + 1] = cvt_pk_bf16(o[4 * q + 2] * rstd * gg[2], o[4 * q + 3] * rstd * gg[3]); }
        *(GAS v4u*)(Y + (size_t)row * DM + ch0) = (v4u){w[0], w[1], w[2], w[3]};
        *(GAS v4u*)(Y + (size_t)row * DM + ch0 + 8) = (v4u){w[4], w[5], w[6], w[7]};
    }
}

struct ProbOut {
    static constexpr int K = DM; static constexpr bool GATHER = false, PERM = true;
    const bf16 *Y, *Wout; bf16* YL; float* SSQ; int G, c;
    __device__ __forceinline__ bool next(int i, pg8::Unit& u) const {
        const int w = pg8::round_unit(i, G, c, 512); if (w < 0) return false;
        u.pm = (w >> 6) * 8 + (w & 7); u.pn = (w & 63) >> 3; u.g = 0; return true; }
    __device__ __forceinline__ const char* a_base(const pg8::Unit& u) const { return (const char*)Y + (size_t)u.pm * 256 * K * 2; }
    __device__ __forceinline__ const char* b_base(const pg8::Unit& u) const { return (const char*)Wout + (size_t)u.pn * 256 * K * 2; }
    __device__ __forceinline__ void rows(const pg8::Unit&, int, LAS unsigned*) const {}
    __device__ __forceinline__ void epi(const f32x4 (&acc)[2][2][4][2], const pg8::Unit& u, int wr, int wc, int fr, int fq) const {
        const int row0 = u.pm * 256 + wr * 64 + fr, col0 = u.pn * 256 + wc * 32 + 8 * fq;
#pragma unroll
        for (int ai = 0; ai < 2; ++ai)
#pragma unroll
            for (int m = 0; m < 4; ++m) { const int row = row0 + ai * 128 + m * 16; bf16* rowp = YL + (size_t)row * DM + col0; float ss = 0.f;
#pragma unroll
                for (int bj = 0; bj < 2; ++bj) { const f32x4 v0 = acc[ai][bj][m][0], v1 = acc[ai][bj][m][1];
                    ss += (v0.x * v0.x + v0.y * v0.y) + (v0.z * v0.z + v0.w * v0.w) + (v1.x * v1.x + v1.y * v1.y) + (v1.z * v1.z + v1.w * v1.w);
                    v4u w; w.x = cvt_pk_bf16(v0.x, v0.y); w.y = cvt_pk_bf16(v0.z, v0.w); w.z = cvt_pk_bf16(v1.x, v1.y); w.w = cvt_pk_bf16(v1.z, v1.w);
                    *(GAS v4u*)(rowp + bj * 128) = w; }
                ss += __shfl_xor(ss, 16); ss += __shfl_xor(ss, 32);
                if (fq == 0) SSQ[(size_t)row * 32 + u.pn * 4 + wc] = ss; }
    }
};

__device__ __forceinline__ void p5_route(Frame& F) {
    const float* MOD = (const float*)(F.ws + WS_MOD);
    const bf16* YL = (const bf16*)(F.ws + WS_YL); const float* SSQ = (const float*)(F.ws + WS_SSQ);
    bf16* H2 = (bf16*)(F.ws + WS_HL); bf16* H2L = (bf16*)(F.ws + WS_H2LO);
    const bf16* WRH = (const bf16*)(F.ws + WS_WRH); const bf16* WRL = (const bf16*)(F.ws + WS_WRL);
    unsigned* gcnt = (unsigned*)(F.ws + WS_CTL) + CW_CNT;
    v2u* LIST = (v2u*)(F.ws + WS_LIST);
    LAS float* logit = (LAS float*)F.lds;
    LAS unsigned* lcnt = (LAS unsigned*)(F.lds + 16384);
    LAS unsigned* lbase = (LAS unsigned*)(F.lds + 16384 + 256);
    LAS unsigned* ent = (LAS unsigned*)(F.lds + 16384 + 512);
    for (int blk = F.bid; blk < T / 64; blk += F.G) {
        const int row0 = blk * 64;
        if (F.tid < 64) lcnt[F.tid] = 0u;
        for (int rr = F.wave; rr < 64; rr += NWAVES) {
            const int row = row0 + rr, b = row >> 11; const float* md = MOD + (size_t)b * 12288;
            const float* xr = FIN(I_X) + (size_t)row * DM; const bf16* yr = YL + (size_t)row * DM;
            float sq = F.lane < 32 ? SSQ[(size_t)row * 32 + F.lane] : 0.f; sq = wave_sum(sq);
            const float rstd1 = 1.0f / sqrtf(sq * (1.0f / DM) + EPS);
            f32x4 v[8]; float ss = 0.f;
#pragma unroll
            for (int j = 0; j < 8; ++j) { const int c = 4 * F.lane + 256 * j;
                const f32x4 xv = *(const GAS f32x4*)(xr + c); const v2u yv = *(const GAS v2u*)(yr + c);
                const f32x4 gp = *(const GAS f32x4*)(FIN(I_GPOSTMIX) + c), gt = *(const GAS f32x4*)(md + 4096 + c);
                const f32x4 yl = (f32x4){bf_lo(yv.x), bf_hi(yv.x), bf_lo(yv.y), bf_hi(yv.y)};
                v[j] = xv + gt * (yl * rstd1 * gp);
                *(GAS f32x4*)(FOUT + (size_t)row * DM + c) = v[j];
                ss += (v[j].x * v[j].x + v[j].y * v[j].y) + (v[j].z * v[j].z + v[j].w * v[j].w); }
            const float rstd2 = 1.0f / sqrtf(wave_sum(ss) * (1.0f / DM) + EPS);
#pragma unroll
            for (int j = 0; j < 8; ++j) { const int c = 4 * F.lane + 256 * j;
                const f32x4 gg = *(const GAS f32x4*)(FIN(I_GPREFFN) + c), sh = *(const GAS f32x4*)(md + 6144 + c), sc = *(const GAS f32x4*)(md + 8192 + c);
                const f32x4 h = (v[j] * rstd2) * gg * (sc + 1.0f) + sh;
                const unsigned h0 = cvt_pk_bf16(h.x, h.y), h1 = cvt_pk_bf16(h.z, h.w);
                const unsigned l0 = cvt_pk_bf16(h.x - bf_lo(h0), h.y - bf_hi(h0)), l1 = cvt_pk_bf16(h.z - bf_lo(h1), h.w - bf_hi(h1));
                *(GAS v2u*)(H2 + (size_t)row * DM + c) = (v2u){h0, h1}; *(GAS v2u*)(H2L + (size_t)row * DM + c) = (v2u){l0, l1}; }
        }
        VM_WAIT(); __syncthreads();
        {
            const int rt = F.wave & 3, nh = F.wave >> 2, fr = F.lane & 15, fq = F.lane >> 4;
            const bf16* ah = H2 + (size_t)(row0 + rt * 16 + fr) * DM + 8 * fq; const bf16* al = H2L + (size_t)(row0 + rt * 16 + fr) * DM + 8 * fq;
            f32x4 acc[2] = {(f32x4){0.f, 0.f, 0.f, 0.f}, (f32x4){0.f, 0.f, 0.f, 0.f}};
#pragma unroll 2
            for (int s = 0; s < 64; ++s) {
                const bf16x8 a_h = *(const GAS bf16x8*)(ah + 32 * s), a_l = *(const GAS bf16x8*)(al + 32 * s);
#pragma unroll
                for (int n2 = 0; n2 < 2; ++n2) { const size_t eo = (size_t)(nh * 32 + n2 * 16 + fr) * DM + 32 * s + 8 * fq;
                    const bf16x8 b_h = *(const GAS bf16x8*)(WRH + eo), b_l = *(const GAS bf16x8*)(WRL + eo);
                    acc[n2] = __builtin_amdgcn_mfma_f32_16x16x32_bf16(a_l, b_h, acc[n2], 0, 0, 0);
                    acc[n2] = __builtin_amdgcn_mfma_f32_16x16x32_bf16(a_h, b_l, acc[n2], 0, 0, 0);
                    acc[n2] = __builtin_amdgcn_mfma_f32_16x16x32_bf16(a_h, b_h, acc[n2], 0, 0, 0); }
            }
#pragma unroll
            for (int n2 = 0; n2 < 2; ++n2)
#pragma unroll
                for (int r = 0; r < 4; ++r) logit[(rt * 16 + 4 * fq + r) * 64 + nh * 32 + n2 * 16 + fr] = acc[n2][r];
        }
        __syncthreads();
        for (int rr = F.wave; rr < 64; rr += NWAVES) {
            const int row = row0 + rr; const int e = F.lane;
            const float lg = logit[rr * 64 + e]; const float score = 1.0f / (1.0f + expf(-lg)); const float sel = score + FIN(I_RBIAS)[e];
            float m1 = sel; m1 = fmaxf(m1, __shfl_xor(m1, 1)); m1 = fmaxf(m1, __shfl_xor(m1, 2)); m1 = fmaxf(m1, __shfl_xor(m1, 4));
            int i1 = (sel == m1) ? e : 1000; i1 = min(i1, __shfl_xor(i1, 1)); i1 = min(i1, __shfl_xor(i1, 2)); i1 = min(i1, __shfl_xor(i1, 4));
            float s2 = (e == i1) ? -INFINITY : sel; s2 = fmaxf(s2, __shfl_xor(s2, 1)); s2 = fmaxf(s2, __shfl_xor(s2, 2)); s2 = fmaxf(s2, __shfl_xor(s2, 4));
            const float gs = m1 + s2; const int g = e >> 3; int grank = 0;
#pragma unroll
            for (int g2 = 0; g2 < 8; ++g2) { const float o = __builtin_bit_cast(float, __builtin_amdgcn_readlane(__builtin_bit_cast(unsigned, gs), 8 * g2)); grank += (o > gs || (o == gs && g2 < g)) ? 1 : 0; }
            const float ms = grank < 4 ? sel : -INFINITY; int rank = 0;
#pragma unroll 4
            for (int e2 = 0; e2 < 64; ++e2) { const float o = __builtin_bit_cast(float, __builtin_amdgcn_readlane(__builtin_bit_cast(unsigned, ms), e2)); rank += (o > ms || (o == ms && e2 < e)) ? 1 : 0; }
            const bool chosen = rank < 8;
            const float ssum = wave_sum(chosen ? score : 0.f);
            const float w = score / ssum * 2.5f;
            if (chosen) { const unsigned lp = __hip_atomic_fetch_add(lcnt + e, 1u, __ATOMIC_RELAXED, __HIP_MEMORY_SCOPE_WORKGROUP);
                LAS unsigned* en = ent + (rr * 8 + rank) * 4; en[0] = (unsigned)e; en[1] = lp; en[2] = (unsigned)row * 16u + (unsigned)rank; en[3] = __builtin_bit_cast(unsigned, w); }
            if (F.lane == 0) LIST[(size_t)64 * LIST_CAP + row] = (v2u){(unsigned)row * 16u + 8u, __builtin_bit_cast(unsigned, 1.0f)};
        }
        __syncthreads();
        if (F.tid < 64) lbase[F.tid] = __hip_atomic_fetch_add(gcnt + 64 * F.tid, lcnt[F.tid], RLX_AGENT);
        __syncthreads();
        { const LAS unsigned* en = ent + F.tid * 4; const unsigned e = en[0], idx = lbase[e] + en[1]; LIST[(size_t)e * LIST_CAP + idx] = (v2u){en[2], en[3]};
          ((v2u*)(F.ws + WS_TOK))[(size_t)(en[2] >> 4) * 8 + (en[2] & 15u)] = (v2u){(e << 16) | idx, en[3]}; }
        __syncthreads();
    }
}

struct TileTab { LAS int* cnt; LAS int* tstart; };
__device__ __forceinline__ TileTab build_tiles(Frame& F) {
    TileTab tt; tt.cnt = (LAS int*)(F.lds + MISC_OFF); tt.tstart = tt.cnt + 128;
    const unsigned* gcnt = (const unsigned*)(F.ws + WS_CTL) + CW_CNT;
    if (F.tid < 64) tt.cnt[F.tid] = (int)__hip_atomic_load(gcnt + 64 * F.tid, RLX_AGENT);
    if (F.tid == 64) tt.cnt[64] = T;
    __syncthreads();
    if (F.tid == 0) { int s = 0; for (int e = 0; e < 65; ++e) { tt.tstart[e] = s; s += (tt.cnt[e] + 255) >> 8; } tt.tstart[65] = s; }
    __syncthreads();
    return tt;
}
__device__ __forceinline__ int tile_expert(const TileTab& tt, int tile) { int e = 0; while (tt.tstart[e + 1] <= tile) ++e; return e; }

struct ProbGU {
    static constexpr int K = DM; static constexpr bool GATHER = true, PERM = false;
    const bf16 *H2, *Wgu; bf16* HID; const v2u* LIST; TileTab tt; int G, c;
    __device__ __forceinline__ bool next(int i, pg8::Unit& u) const {
        const int total = tt.tstart[65] * 4; const int w = pg8::round_unit(i, G, c, total); if (w < 0) return false;
        u.pm = w >> 2; u.pn = w & 3; u.g = tile_expert(tt, u.pm); return true; }
    __device__ __forceinline__ const char* a_base(const pg8::Unit&) const { return (const char*)H2; }
    __device__ __forceinline__ const char* b_base(const pg8::Unit& u) const { return (const char*)Wgu + ((size_t)u.g * 1024 + (size_t)u.pn * 256) * K * 2; }
    __device__ __forceinline__ void rows(const pg8::Unit& u, int tid, LAS unsigned* dst) const {
        const int lt = u.pm - tt.tstart[u.g]; const int nrow = tt.cnt[u.g] - lt * 256; const v2u* lp = LIST + (size_t)u.g * LIST_CAP + lt * 256;
#pragma unroll
        for (int i = 0; i < 2; ++i) { int R0, C; pg8::stage_rc(tid * 16 + i * 8192, R0, C);
#pragma unroll
            for (int h = 0; h < 2; ++h) { const int R = R0 + 128 * h; unsigned tok = 0u; if (R < nrow) tok = lp[R].x >> 4; dst[(h * 2 + i) * 512 + tid] = tok * (unsigned)(K * 2) + (unsigned)(C * 2); } }
    }
    __device__ __forceinline__ void epi(const f32x4 (&acc)[2][2][4][2], const pg8::Unit& u, int wr, int wc, int fr, int fq) const {
#pragma unroll
        for (int ai = 0; ai < 2; ++ai)
#pragma unroll
            for (int m = 0; m < 4; ++m) { const int R = ai * 128 + wr * 64 + m * 16 + fr;
                bf16* rowp = HID + ((size_t)u.pm * 256 + R) * FE + u.pn * 128 + wc * 16 + 4 * fq;
#pragma unroll
                for (int bj = 0; bj < 2; ++bj) { const f32x4 g = acc[ai][bj][m][0], up = acc[ai][bj][m][1]; f32x4 hv;
#pragma unroll
                    for (int q = 0; q < 4; ++q) hv[q] = g[q] / (1.0f + __expf(-g[q])) * up[q];
                    *(GAS v2u*)(rowp + bj * 64) = (v2u){cvt_pk_bf16(hv.x, hv.y), cvt_pk_bf16(hv.z, hv.w)}; } }
    }
};
struct ProbDown {
    static constexpr int K = FE; static constexpr bool GATHER = false, PERM = true;
    const bf16 *HID, *Wdn; bf16* SLOT; const v2u* LIST; TileTab tt; int G, c;
    __device__ __forceinline__ bool next(int i, pg8::Unit& u) const {
        const int total = tt.tstart[65] * 8; const int w = pg8::round_unit(i, G, c, total); if (w < 0) return false;
        u.pm = w >> 3; u.pn = w & 7; u.g = tile_expert(tt, u.pm); return true; }
    __device__ __forceinline__ const char* a_base(const pg8::Unit& u) const { return (const char*)HID + (size_t)u.pm * 256 * K * 2; }
    __device__ __forceinline__ const char* b_base(const pg8::Unit& u) const { return (const char*)Wdn + ((size_t)u.g * 2048 + (size_t)u.pn * 256) * K * 2; }
    __device__ __forceinline__ void rows(const pg8::Unit&, int, LAS unsigned*) const {}
    __device__ __forceinline__ void epi(const f32x4 (&acc)[2][2][4][2], const pg8::Unit& u, int wr, int wc, int fr, int fq) const {
        const int col0 = u.pn * 256 + wc * 32 + 8 * fq;
#pragma unroll
        for (int ai = 0; ai < 2; ++ai)
#pragma unroll
            for (int m = 0; m < 4; ++m) { const int R = ai * 128 + wr * 64 + m * 16 + fr; bf16* rowp = SLOT + ((size_t)u.pm * 256 + R) * DM + col0;
#pragma unroll
                for (int bj = 0; bj < 2; ++bj) { const f32x4 v0 = acc[ai][bj][m][0], v1 = acc[ai][bj][m][1];
                    v4u w; w.x = cvt_pk_bf16(v0.x, v0.y); w.y = cvt_pk_bf16(v0.z, v0.w); w.z = cvt_pk_bf16(v1.x, v1.y); w.w = cvt_pk_bf16(v1.z, v1.w);
                    *(GAS v4u*)(rowp + bj * 128) = w; } }
    }
};

__device__ __forceinline__ void p8_final(Frame& F) {
    const int gw = F.bid * NWAVES + F.wave, NGW = F.G * NWAVES;
    const TileTab tt = build_tiles(F);
    const float* MOD = (const float*)(F.ws + WS_MOD); const bf16* SLOT = (const bf16*)(F.ws + WS_SLOT); const float* g = FIN(I_GPOSTFFN);
    const v2u* TOK = (const v2u*)(F.ws + WS_TOK);
    const int sh0 = tt.tstart[64] * 256;
    for (int row = gw; row < T; row += NGW) {
        const float* md = MOD + (size_t)(row >> 11) * 12288;
        unsigned mypos = 0u; float myw = 0.f;
        if (F.lane < 8) { const v2u tk = TOK[(size_t)row * 8 + F.lane]; const unsigned e = tk.x >> 16; mypos = (unsigned)tt.tstart[e] * 256u + (tk.x & 0xffffu); myw = u2f(tk.y); }
        f32x4 v[8];
        { const bf16* sr = SLOT + (size_t)(sh0 + row) * DM;
#pragma unroll
          for (int j = 0; j < 8; ++j) { const v2u yv = *(const GAS v2u*)(sr + 4 * F.lane + 256 * j); v[j] = (f32x4){bf_lo(yv.x), bf_hi(yv.x), bf_lo(yv.y), bf_hi(yv.y)}; } }
#pragma unroll
        for (int s = 0; s < 8; ++s) { const unsigned pos = __builtin_amdgcn_readlane(mypos, s); const float w = u2f(__builtin_amdgcn_readlane(__builtin_bit_cast(unsigned, myw), s));
            const bf16* sr = SLOT + (size_t)pos * DM;
#pragma unroll
            for (int j = 0; j < 8; ++j) { const v2u yv = *(const GAS v2u*)(sr + 4 * F.lane + 256 * j); v[j] += (f32x4){bf_lo(yv.x), bf_hi(yv.x), bf_lo(yv.y), bf_hi(yv.y)} * w; } }
        float ss = 0.f;
#pragma unroll
        for (int j = 0; j < 8; ++j) ss += (v[j].x * v[j].x + v[j].y * v[j].y) + (v[j].z * v[j].z + v[j].w * v[j].w);
        const float rstd = 1.0f / sqrtf(wave_sum(ss) * (1.0f / DM) + EPS);
#pragma unroll
        for (int j = 0; j < 8; ++j) { const int c = 4 * F.lane + 256 * j;
            const f32x4 gg = *(const GAS f32x4*)(g + c), gt = *(const GAS f32x4*)(md + 10240 + c);
            GAS f32x4* op = (GAS f32x4*)(FOUT + (size_t)row * DM + c);
            *op = *op + gt * (v[j] * rstd * gg); }
    }
}

constexpr int N_PHASES = 9;
typedef KArgs Args;
__global__ void __launch_bounds__(NTHR, 2) fwd_kernel(Args args) {
    extern __shared__ __attribute__((aligned(16))) unsigned char lds_raw[];
    Frame F;
    F.lds = (LAS unsigned char*)lds_raw;
    F.tid = threadIdx.x; F.lane = F.tid & 63; F.wave = __builtin_amdgcn_readfirstlane(F.tid >> 6);
    F.G = gridDim.x; F.bid = blockIdx.x;
    F.ka = (CKArgs*)__builtin_amdgcn_kernarg_segment_ptr(); F.ws = args.ws;
#define LAUNDER() do { CKArgs* _p = (CKArgs*)__builtin_amdgcn_kernarg_segment_ptr(); asm volatile("" : "+s"(_p) :: "memory"); F.ka = _p; unsigned char* _w = _p->ws; F.ws = _w; } while (0)
    volatile LAS unsigned* barw = (volatile LAS unsigned*)(F.lds + BARW_OFF);
    if (F.tid < 16) barw[F.tid] = 0u;
    __syncthreads();
    XcdBarrier bar; bar.bar = (unsigned*)(F.ws + WS_CTL) + CW_BAR + args.li * XCD_BAR_WORDS; bar.x = 0; bar.st = nullptr;
    const int lo = args.ph_lo, hi = args.ph_hi;
    if (hi - lo > 1) bar = xcd_barrier_post((unsigned*)(F.ws + WS_CTL) + CW_BAR + args.li * XCD_BAR_WORDS, barw);
#ifndef PH_MASK
#define PH_MASK 0x1ff
#endif
#define IN(k) (((PH_MASK >> (k)) & 1) && lo <= (k) && (k) < hi)
#define SEAM(k) do { if (IN(k) && IN((k) + 1)) xcd_barrier(bar); } while (0)
#ifndef REPEAT_MASK
#define REPEAT_MASK 0
#endif
#define NREP(k) (((REPEAT_MASK >> (k)) & 1) ? 2 : 1)
    if (IN(0)) { for (int rep = 0; rep < NREP(0); ++rep) { if (rep) xcd_barrier(bar); LAUNDER(); p0_prologue(F); } } SEAM(0);
    if (IN(1)) { LAUNDER(); p1_norm(F); } SEAM(1);
    if (IN(2)) { LAUNDER();
        ProbProj P; P.HL = (const bf16*)(F.ws + WS_HL); P.HC = (const bf16*)(F.ws + WS_HC); P.Win = (const bf16*)(F.ws + WS_WIN); P.PROJ = (bf16*)(F.ws + WS_PROJ); P.KVC = (bf16*)(F.ws + WS_KVC);
        P.rope = (const f32x2*)(F.ws + WS_ROPE); P.G = F.G; P.c = F.bid;
        for (int rep = 0; rep < NREP(2); ++rep) { if (rep) xcd_barrier(bar); pg8::gemm_phase<ProbProj>(F.lds, P); }
    } SEAM(2);
    if (IN(3)) { LAUNDER();
#ifdef ATTN_SIMPLE
        p3_attn_simple(F);
#else
        p3_attn_mfma(F);
#endif
        LAUNDER(); p3_conv(F); } SEAM(3);
    if (IN(4)) { LAUNDER();
        ProbOut P; P.Y = (const bf16*)(F.ws + WS_Y); P.Wout = (const bf16*)(F.ws + WS_WOUT); P.YL = (bf16*)(F.ws + WS_YL); P.SSQ = (float*)(F.ws + WS_SSQ); P.G = F.G; P.c = F.bid;
        pg8::gemm_phase<ProbOut>(F.lds, P);
    } SEAM(4);
    if (IN(5)) { LAUNDER(); p5_route(F); } SEAM(5);
    if (IN(6)) { LAUNDER();
#ifdef DIAG
        if (F.bid == 0 && F.wave == 0) { const bf16* Wgu = (const bf16*)(F.ws + WS_WGU); const bf16* H2 = (const bf16*)(F.ws + WS_HL);
            const float s0 = wave_sum(fabsf(bf_lo(Wgu[((size_t)5 * 1024 + 100) * 2048 + F.lane]))); const float s1 = wave_sum(fabsf(bf_lo(H2[(size_t)1000 * 2048 + F.lane])));
            unsigned st = 0; if (!(s0 > 1e-3f)) st |= 1u; if (!(s1 > 1e-3f)) st |= 2u;
            if (F.lane == 0) __hip_atomic_store((unsigned*)(F.ws + WS_CTL) + 100, st, RLX_AGENT); }
#endif
        ProbGU P; P.tt = build_tiles(F); P.H2 = (const bf16*)(F.ws + WS_HL); P.Wgu = (const bf16*)(F.ws + WS_WGU); P.HID = (bf16*)(F.ws + WS_HID); P.LIST = (const v2u*)(F.ws + WS_LIST); P.G = F.G; P.c = F.bid;
        for (int rep = 0; rep < NREP(6); ++rep) { if (rep) xcd_barrier(bar); pg8::gemm_phase<ProbGU>(F.lds, P); }
#ifdef DIAG
        VM_WAIT(); __syncthreads();
        if (F.bid == 96 && F.wave == 0) { const bf16* HID = (const bf16*)(F.ws + WS_HID); const float s2 = wave_sum(fabsf(bf_lo(HID[(size_t)1000 * 512 + F.lane])));
            if (F.lane == 0) __hip_atomic_store((unsigned*)(F.ws + WS_CTL) + 102, (s2 > 1e-6f) ? 1u : 2u, RLX_AGENT); }
#endif
    } SEAM(6);
    if (IN(7)) { LAUNDER();
#ifdef DIAG
        if (F.bid == 0 && F.wave == 0) { const bf16* HID = (const bf16*)(F.ws + WS_HID); const float s2 = wave_sum(fabsf(bf_lo(HID[(size_t)1000 * 512 + F.lane])));
            if (F.lane == 0) __hip_atomic_store((unsigned*)(F.ws + WS_CTL) + 103, (s2 > 1e-6f) ? 1u : 2u, RLX_AGENT); }
#endif
        ProbDown P; P.tt = build_tiles(F); P.HID = (const bf16*)(F.ws + WS_HID); P.Wdn = (const bf16*)(F.ws + WS_WDN); P.SLOT = (bf16*)(F.ws + WS_SLOT); P.LIST = (const v2u*)(F.ws + WS_LIST); P.G = F.G; P.c = F.bid;
        for (int rep = 0; rep < NREP(7); ++rep) { if (rep) xcd_barrier(bar); pg8::gemm_phase<ProbDown>(F.lds, P); }
    } SEAM(7);
    if (IN(8)) { LAUNDER(); p8_final(F); }
#undef IN
#undef SEAM
}

extern "C" void kernel_launch(void* const* d_in, const int* in_sizes, int n_in, void* d_out, int out_size, void* d_ws, size_t ws_size, hipStream_t stream) {
    static int grid = 0;
    if (grid == 0) {
        if (n_in != 25 || in_sizes[0] != T * DM || out_size != T * DM || ws_size < WS_END) { fprintf(stderr, "kernel_launch: shape/workspace mismatch (n_in %d, in0 %d, out %d, ws %zu < %zu)\n", n_in, n_in > 0 ? in_sizes[0] : -1, out_size, ws_size, (size_t)WS_END); grid = -1; return; }
        int dev = 0, cus = 0, per_cu = 0;
        if (hipGetDevice(&dev) != hipSuccess || hipDeviceGetAttribute(&cus, hipDeviceAttributeMultiprocessorCount, dev) != hipSuccess) { grid = -1; return; }
        if (hipFuncSetAttribute((const void*)fwd_kernel, hipFuncAttributeMaxDynamicSharedMemorySize, LDS_BYTES) != hipSuccess) { fprintf(stderr, "kernel_launch: hipFuncSetAttribute failed\n"); grid = -1; return; }
        if (hipOccupancyMaxActiveBlocksPerMultiprocessor(&per_cu, (const void*)fwd_kernel, NTHR, LDS_BYTES) != hipSuccess || per_cu < 1) fprintf(stderr, "kernel_launch: occupancy query says %d\n", per_cu);
        (void)hipGetLastError();
        grid = cus;
        if (grid != 256) fprintf(stderr, "kernel_launch: %d CUs (built for 256)\n", grid);
    }
    if (grid < 0) return;
    if (hipMemsetAsync((char*)d_ws + WS_CTL, 0, CTL_ZERO_BYTES, stream) != hipSuccess) return;
    Args a{};
    for (int i = 0; i < 25; ++i) a.in[i] = (const float*)d_in[i];
    a.out = (float*)d_out; a.ws = (unsigned char*)d_ws; a.pad = 0;
    if (MK_N_LAUNCHES == 1) {
        a.ph_lo = 0; a.ph_hi = N_PHASES; a.li = 0;
        hipLaunchKernelGGL(fwd_kernel, dim3(grid), dim3(NTHR), LDS_BYTES, stream, a);
    } else {
        for (int li = 0; li < N_PHASES; ++li) { a.ph_lo = li; a.ph_hi = li + 1; a.li = 0;
            hipLaunchKernelGGL(fwd_kernel, dim3(grid), dim3(NTHR), LDS_BYTES, stream, a); }
    }
    const hipError_t le = hipPeekAtLastError();
    if (le != hipSuccess) fprintf(stderr, "kernel_launch: launch failed: %s\n", hipGetErrorName(le));
}
```

```cpp
#include <hip/hip_runtime.h>
#include <cstdio>
#include <cstdint>


#ifndef MK_N_LAUNCHES
#define MK_N_LAUNCHES 1
#endif

#define GAS __attribute__((address_space(1)))
#define LAS __attribute__((address_space(3)))
typedef unsigned short bf16;
typedef unsigned v4u __attribute__((ext_vector_type(4)));
typedef unsigned v2u __attribute__((ext_vector_type(2)));
typedef float f32x4 __attribute__((ext_vector_type(4)));
typedef float f32x2 __attribute__((ext_vector_type(2)));
typedef short bf16x8 __attribute__((ext_vector_type(8)));
typedef __bf16 v2bf __attribute__((ext_vector_type(2)));
typedef int v4i __attribute__((ext_vector_type(4)));
typedef int v8i __attribute__((ext_vector_type(8)));

constexpr int NB = 8, SEQ = 2048, DM = 2048, T = NB * SEQ, LC = 256, TC = NB * LC;
constexpr int GW = 64, DC = 1024, NH = 8, HD = 128;
constexpr int NPROJ = 6144, QOFF = 3072, KOFF = 4096, VOFF = 5120;
constexpr int NE = 64, FE = 512, NSLOT = 9;
constexpr float EPS = 1e-6f;
constexpr int NWAVES = 8, NTHR = 512;
constexpr int LIST_CAP = 16384;
constexpr int MAX_TILES = 640;

constexpr size_t MiB = 1u << 20;
constexpr size_t WS_CTL = 0, CTL_ZERO_BYTES = 1 * MiB;
constexpr size_t WS_MOD = 1 * MiB;
constexpr size_t WS_ROPE = 1 * MiB + 512 * 1024;
constexpr size_t WS_SSQ = 2 * MiB;
constexpr size_t WS_LIST = 4 * MiB;
constexpr size_t WS_WRH = 13 * MiB, WS_WRL = 13 * MiB + 256 * 1024;
constexpr size_t WS_WDN = 14 * MiB;
constexpr size_t WS_YL = 144 * MiB;
constexpr size_t WS_HID = 208 * MiB;
constexpr size_t WS_WGU = 368 * MiB;
constexpr size_t WS_WIN = 628 * MiB;
constexpr size_t WS_WOUT = 652 * MiB;
constexpr size_t WS_HL = 660 * MiB;
constexpr size_t WS_HC = 724 * MiB;
constexpr size_t WS_KVC = 732 * MiB;
constexpr size_t WS_PROJ = 740 * MiB;
constexpr size_t WS_H2LO = 740 * MiB;
constexpr size_t WS_Y = 932 * MiB;
constexpr size_t WS_H2Q = 932 * MiB;
constexpr size_t WS_SLOT = 368 * MiB;
constexpr size_t WS_TOK = 1008 * MiB;
constexpr size_t WS_END = 1009 * MiB;
static_assert(WS_SLOT + (size_t)MAX_TILES * 256 * DM * 2 <= WS_TOK, "slot buffer");
constexpr int CW_BAR = 4096;
constexpr int CW_CNT = 16384;

constexpr int RING_BYTES = 131072;
constexpr int MISC_OFF = RING_BYTES;
constexpr int BARW_OFF = 163840 - 64;
constexpr int LDS_BYTES = 163840;

#define RLX_AGENT __ATOMIC_RELAXED, __HIP_MEMORY_SCOPE_AGENT
#define LDS_WAIT() asm volatile("s_waitcnt lgkmcnt(0)" ::: "memory")
#define VM_WAIT() asm volatile("s_waitcnt vmcnt(0)" ::: "memory")
__device__ __forceinline__ unsigned cvt_pk_bf16(float lo, float hi) { unsigned r; asm volatile("v_cvt_pk_bf16_f32 %0, %1, %2" : "=v"(r) : "v"(lo), "v"(hi)); return r; }
__device__ __forceinline__ float u2f(unsigned u) { return __builtin_bit_cast(float, u); }
__device__ __forceinline__ float bf_lo(unsigned u) { return __builtin_bit_cast(float, u << 16); }
__device__ __forceinline__ float bf_hi(unsigned u) { return __builtin_bit_cast(float, u & 0xffff0000u); }
__device__ __forceinline__ float clamp448(float v) { return fminf(fmaxf(v, -448.0f), 448.0f); }
__device__ __forceinline__ unsigned pack4_fp8(float a, float b, float c, float d) {
    int p = __builtin_amdgcn_cvt_pk_fp8_f32(a, b, 0, false); p = __builtin_amdgcn_cvt_pk_fp8_f32(c, d, p, true); return (unsigned)p; }
__device__ __forceinline__ float wave_sum(float v) {
#pragma unroll
    for (int o = 1; o < 64; o <<= 1) v += __shfl_xor(v, o);
    return v;
}
__device__ __forceinline__ float wave_max(float v) {
#pragma unroll
    for (int o = 1; o < 64; o <<= 1) v = fmaxf(v, __shfl_xor(v, o));
    return v;
}
__device__ __forceinline__ float silu_f(float v) { return v / (1.0f + expf(-v)); }

#define XB_TMO      128
#define XB_XCNT(j)  (256  + 64 * (j))
#define XB_XSUB(j)  (1280 + 64 * (j))
#define XB_XGEN(j)  (2304 + 64 * (j))
#define XB_TOP      3328
#define XB_TOPGEN   3392
#define XCD_BAR_WORDS 3456
#define XB_SPIN_CAP (1u << 18)
__device__ __forceinline__ unsigned xb_ld(unsigned* p)              { return __hip_atomic_load(p, __ATOMIC_RELAXED, __HIP_MEMORY_SCOPE_AGENT); }
__device__ __forceinline__ unsigned xb_add(unsigned* p, unsigned v) { return __hip_atomic_fetch_add(p, v, __ATOMIC_RELAXED, __HIP_MEMORY_SCOPE_AGENT); }
__device__ __forceinline__ unsigned xb_xcc_id() { return (unsigned)__builtin_amdgcn_s_getreg((3 << 11) | 20) & 0xFu; }
#define XB_SPIN(cond, bar) do { unsigned _sp = 0; while (cond) { __builtin_amdgcn_s_sleep(1); \
    if ((++_sp & 255u) == 0u) { if (xb_ld(&(bar)[XB_TMO])) break; if (_sp > XB_SPIN_CAP) { atomicAdd(&(bar)[XB_TMO], 1u); break; } } } } while (0)
struct XcdBarrier { unsigned* bar; unsigned x; volatile LAS unsigned* st; };
__device__ __forceinline__ XcdBarrier xcd_barrier_post(unsigned* bar, volatile LAS unsigned* st) {
    XcdBarrier b; b.bar = bar; b.x = xb_xcc_id(); b.st = st;
    if (threadIdx.x == 0) (void)xb_add(&bar[XB_XCNT(b.x)], 1u);
    return b;
}
__device__ __forceinline__ void xcd_barrier_complete(unsigned* bar, unsigned x, unsigned& nloc, unsigned& nx) {
    const unsigned G = gridDim.x * gridDim.y * gridDim.z;
    unsigned sum, cnt, mine, sp = 0u;
    for (;;) {
        sum = 0u; cnt = 0u; mine = 0u;
#pragma unroll
        for (unsigned j = 0; j < 16; ++j) { const unsigned c = xb_ld(&bar[XB_XCNT(j)]); sum += c; cnt += (c > 0u) ? 1u : 0u; mine = (j == x) ? c : mine; }
        if (sum == G) break;
        __builtin_amdgcn_s_sleep(1);
        if ((++sp & 255u) == 0u) { if (xb_ld(&bar[XB_TMO])) break; if (sp > XB_SPIN_CAP) { atomicAdd(&bar[XB_TMO], 1u); break; } }
    }
    nloc = mine > 0u ? mine : 1u; nx = cnt > 0u ? cnt : 1u;
}
__device__ __forceinline__ void xcd_barrier(const XcdBarrier& b) {
    asm volatile("s_waitcnt vmcnt(0)" ::: "memory");
    __syncthreads();
    if (threadIdx.x == 0) {
        unsigned* bar = b.bar;
        __builtin_amdgcn_s_waitcnt(0);
        unsigned nloc = b.st[0], nx = b.st[1];
        if (nloc == 0u) { xcd_barrier_complete(bar, b.x, nloc, nx); b.st[0] = nloc; b.st[1] = nx; }
        const unsigned old = xb_add(&bar[XB_XSUB(b.x)], 1u);
        const unsigned gen = old / nloc;
        if (old + 1u == (gen + 1u) * nloc) {
            __builtin_amdgcn_fence(__ATOMIC_RELEASE, "agent");
            asm volatile("s_waitcnt vmcnt(0)" ::: "memory");
            const unsigned og = xb_add(&bar[XB_TOP], 1u);
            const unsigned tg = og / nx;
            if (og + 1u == (tg + 1u) * nx) xb_add(&bar[XB_TOPGEN], 1u);
            else XB_SPIN(xb_ld(&bar[XB_TOPGEN]) == tg, bar);
            __builtin_amdgcn_fence(__ATOMIC_ACQUIRE, "agent");
            xb_add(&bar[XB_XGEN(b.x)], 1u);
            asm volatile("s_waitcnt vmcnt(0)" ::: "memory");
        } else {
            XB_SPIN(xb_ld(&bar[XB_XGEN(b.x)]) == gen, bar);
            __builtin_amdgcn_fence(__ATOMIC_ACQUIRE, "agent");
            asm volatile("s_waitcnt vmcnt(0)" ::: "memory");
        }
    }
    __syncthreads();
}

namespace pg8 {
constexpr int BM = 256, BK = 64, HALF = 128, HTB = HALF * BK * 2, STAGE_BYTES = 8 * HTB;
__host__ __device__ __forceinline__ int lds_byte(int r, int c) { const int st = (r >> 4) * 2 + (c >> 5), rr = r & 15, cc = c & 31, ob = rr * 64 + cc * 2; return st * 1024 + (ob ^ (((ob >> 9) & 1) << 5)); }
__host__ __device__ __forceinline__ void stage_rc(int b, int& R, int& C) { const int st = b / 1024, sb = b % 1024, swz = sb ^ (((sb >> 9) & 1) << 5); R = (st >> 1) * 16 + swz / 64; C = (st & 1) * 32 + (swz % 64) / 2; }
__host__ __device__ __forceinline__ int perm32(int rho) { const int n = rho >> 4, i = rho & 15; return 8 * (i >> 2) + 4 * n + (i & 3); }
struct Unit { int pm, pn, g; };

__device__ __forceinline__ int round_unit(int i, int G, int c, int total) {
    const int base = i * G; if (base + c >= total && (total - base) >= G) return -1;
    const int R = (total - base) < G ? (total - base) : G;
    if (R <= 0) return -1;
    if (R == G && (G & 7) == 0) return base + (c & 7) * (G >> 3) + (c >> 3);
    return c < R ? base + c : -1;
}

template <class P>
__device__ __forceinline__ void gemm_phase(LAS unsigned char* lds, const P& p) {
    constexpr int KB = P::KB, nt = KB / (BK * 2);
    const int tid = threadIdx.x, wid = __builtin_amdgcn_readfirstlane(tid >> 6), lane = tid & 63, wr = wid >> 2, wc = wid & 3, fr = lane & 15, fq = lane >> 4;
    unsigned voffB[2], voffA[2];
#pragma unroll
    for (int i = 0; i < 2; ++i) { int R, C; stage_rc(tid * 16 + i * 8192, R, C); const int Rb = P::PERM ? ((R & ~31) + perm32(R & 31)) : R;
        voffA[i] = (unsigned)(R * KB + C * 2); voffB[i] = (unsigned)(Rb * KB + C * 2); }
    LAS unsigned* goffs = (LAS unsigned*)(lds + STAGE_BYTES + 1024);
    constexpr size_t kstep = (size_t)(BK * 2);
    constexpr size_t hstep = (size_t)HALF * KB;
    const unsigned ldsw = (unsigned)wid * 1024u;
    const int aoff = lds_byte(wr * 64 + fr, fq * 8), boff = lds_byte(wc * 32 + fr, fq * 8);
#define PG8_SA(b, h) (((b) * 2 + (h)) * HTB)
#define PG8_SB(b, h) ((4 + (b) * 2 + (h)) * HTB)
#define PG8_STAGE(bufoff, gbase, voff) do { _Pragma("unroll") for (int _i = 0; _i < 2; ++_i) \
        __builtin_amdgcn_global_load_lds((const unsigned*)((const char*)(gbase) + (voff)[_i]), (LAS unsigned*)(lds + (bufoff) + ldsw + _i * 8192), 16, 0, 0); } while (0)
#define PG8_STAGE_A(bufoff, h, nextu, kb) do { if constexpr (P::GATHER) { \
            _Pragma("unroll") for (int _i = 0; _i < 2; ++_i) { const unsigned _o = goffs[((((nextu) ? ui + 1 : ui) & 1) * 4 + (h) * 2 + _i) * 512 + tid]; \
                __builtin_amdgcn_global_load_lds((const unsigned*)(gA + (kb) + _o), (LAS unsigned*)(lds + (bufoff) + ldsw + _i * 8192), 16, 0, 0); } } \
        else { const char* _b = ((nextu) ? nA : cA) + (h) * hstep + (kb); PG8_STAGE(bufoff, _b, voffA); } } while (0)
#define PG8_RD2(p) __builtin_shufflevector(*(const LAS v4i*)(p), *(const LAS v4i*)((p) + 1024), 0, 1, 2, 3, 4, 5, 6, 7)
#define PG8_LDA(dst, b, h) do { _Pragma("unroll") for (int m = 0; m < 4; ++m) dst[m] = PG8_RD2(lds + PG8_SA(b, h) + aoff + m * 2048); } while (0)
#define PG8_LDB(dst, b, h) do { _Pragma("unroll") for (int n = 0; n < 2; ++n) dst[n] = PG8_RD2(lds + PG8_SB(b, h) + boff + n * 2048); } while (0)
#define PG8_LO(x) __builtin_bit_cast(bf16x8, __builtin_shufflevector((x), (x), 0, 1, 2, 3))
#define PG8_HI(x) __builtin_bit_cast(bf16x8, __builtin_shufflevector((x), (x), 4, 5, 6, 7))
#define PG8_MMA(ai, bj, At, Bt) do { __builtin_amdgcn_s_setprio(1); if constexpr (P::FP8) { _Pragma("unroll") for (int m = 0; m < 4; ++m) _Pragma("unroll") for (int n = 0; n < 2; ++n) \
            asm volatile("v_mfma_scale_f32_16x16x128_f8f6f4 %0, %1, %2, %0, %3, %4 op_sel_hi:[0,0,0]" : "+v"(acc[ai][bj][m][n]) : "v"(Bt[n]), "v"(At[m]), "v"(sclB), "v"(sclA)); } \
        else { _Pragma("unroll") for (int m = 0; m < 4; ++m) _Pragma("unroll") for (int n = 0; n < 2; ++n) { \
            acc[ai][bj][m][n] = __builtin_amdgcn_mfma_f32_16x16x32_bf16(PG8_LO(Bt[n]), PG8_LO(At[m]), acc[ai][bj][m][n], 0, 0, 0); \
            acc[ai][bj][m][n] = __builtin_amdgcn_mfma_f32_16x16x32_bf16(PG8_HI(Bt[n]), PG8_HI(At[m]), acc[ai][bj][m][n], 0, 0, 0); } } __builtin_amdgcn_s_setprio(0); } while (0)
#define PG8_WAIT_V(n) asm volatile("s_waitcnt vmcnt(" #n ")" ::: "memory")
#define PG8_WAIT_L(n) asm volatile("s_waitcnt lgkmcnt(" #n ")" ::: "memory")
#define PG8_BAR __builtin_amdgcn_s_barrier()
#define PG8_SCHED __builtin_amdgcn_sched_barrier(0)
    Unit cur, nxt; int ui = 0;
    if (!p.next(0, cur)) return;
    f32x4 acc[2][2][4][2];
#pragma unroll
    for (int a = 0; a < 2; ++a)
#pragma unroll
        for (int b = 0; b < 2; ++b)
#pragma unroll
            for (int m = 0; m < 4; ++m)
#pragma unroll
                for (int n = 0; n < 2; ++n) acc[a][b][m][n] = (f32x4){0.f, 0.f, 0.f, 0.f};
    v8i At[4], B0[2], B1[2];
    int sclA = P::SCALE_A, sclB = P::SCALE_B; if constexpr (P::FP8) { asm volatile("" : "+v"(sclA), "+v"(sclB)); }
    const char* cA = p.a_base(cur); const char* cB = p.b_base(cur);
    const char* nA = cA; const char* gA = cA;
    if constexpr (P::GATHER) { p.rows(cur, tid, goffs); p.rows(cur, tid, goffs + 4 * 512); }
    PG8_STAGE(PG8_SB(0, 0), cB, voffB); PG8_STAGE(PG8_SB(0, 1), cB + hstep, voffB); PG8_STAGE_A(PG8_SA(0, 0), 0, false, 0); PG8_STAGE_A(PG8_SA(0, 1), 1, false, 0);
    if (wr == 1) PG8_BAR;
    PG8_WAIT_V(2); PG8_BAR;
    PG8_STAGE(PG8_SB(1, 0), cB + kstep, voffB); PG8_STAGE_A(PG8_SA(1, 0), 0, false, kstep); PG8_STAGE(PG8_SB(1, 1), cB + hstep + kstep, voffB);
    PG8_WAIT_V(6); PG8_BAR;
    for (;;) {
        const bool has_next = p.next(ui + 1, nxt);
        nA = has_next ? p.a_base(nxt) : cA; const char* nB = has_next ? p.b_base(nxt) : cB;
        if constexpr (P::GATHER) { p.rows(has_next ? nxt : cur, tid, goffs + ((ui + 1) & 1) * 4 * 512); }
#pragma unroll 1
        for (int t = 0; t < nt; t += 2) {
            const bool last = (t == nt - 2);
            const size_t k1 = (size_t)(t + 1) * kstep;
            const size_t k2 = last ? 0 : (size_t)(t + 2) * kstep;
            const char* b2 = last ? nB : cB + (size_t)(t + 2) * kstep;
            const size_t k3 = k2 + kstep; const char* b3 = b2 + kstep;
            PG8_LDB(B0, 0, 0); PG8_LDB(B1, 0, 1); PG8_SCHED; PG8_LDA(At, 0, 0); PG8_STAGE_A(PG8_SA(1, 1), 1, false, k1);
            PG8_WAIT_V(8); PG8_WAIT_L(0); PG8_BAR; PG8_MMA(0, 0, At, B0); PG8_MMA(0, 1, At, B1); PG8_BAR; PG8_SCHED;
            PG8_LDA(At, 0, 1); PG8_STAGE(PG8_SB(0, 0), b2, voffB); PG8_STAGE(PG8_SB(0, 1), b2 + hstep, voffB); PG8_STAGE_A(PG8_SA(0, 0), 0, last, k2);
            PG8_WAIT_V(8); PG8_WAIT_L(0); PG8_BAR; PG8_MMA(1, 0, At, B0); PG8_MMA(1, 1, At, B1); PG8_BAR; PG8_SCHED;
            PG8_LDB(B0, 1, 0); PG8_LDB(B1, 1, 1); PG8_SCHED; PG8_LDA(At, 1, 0); PG8_STAGE_A(PG8_SA(0, 1), 1, last, k2);
            PG8_WAIT_V(8); PG8_WAIT_L(0); PG8_BAR; PG8_MMA(0, 0, At, B0); PG8_MMA(0, 1, At, B1); PG8_BAR; PG8_SCHED;
            PG8_LDA(At, 1, 1); PG8_STAGE(PG8_SB(1, 0), b3, voffB); PG8_STAGE(PG8_SB(1, 1), b3 + hstep, voffB); PG8_STAGE_A(PG8_SA(1, 0), 0, last, k3);
            PG8_WAIT_V(8); PG8_WAIT_L(0); PG8_BAR; PG8_MMA(1, 0, At, B0); PG8_MMA(1, 1, At, B1); PG8_BAR; PG8_SCHED;
        }
        if (wr == 0) PG8_BAR;
        if constexpr (P::FP8) { asm volatile("s_nop 15\n\ts_nop 15" ::: "memory"); }
        { int tz = threadIdx.x; asm volatile("" : "+v"(tz));
          const int ewid = tz >> 6, elane = tz & 63; p.epi(acc, cur, ewid >> 2, ewid & 3, elane & 15, elane >> 4); }
        if (!has_next) break;
#pragma unroll
        for (int a = 0; a < 2; ++a)
#pragma unroll
            for (int b = 0; b < 2; ++b)
#pragma unroll
                for (int m = 0; m < 4; ++m)
#pragma unroll
                    for (int n = 0; n < 2; ++n) acc[a][b][m][n] = (f32x4){0.f, 0.f, 0.f, 0.f};
        cur = nxt; cA = nA; cB = nB; ++ui;
        if (wr == 1) PG8_BAR;
    }
    PG8_WAIT_V(0);
    PG8_BAR;
#undef PG8_SA
#undef PG8_SB
#undef PG8_STAGE
#undef PG8_STAGE_A
#undef PG8_LDA
#undef PG8_LDB
#undef PG8_MMA
#undef PG8_LO
#undef PG8_HI
#undef PG8_RD2
#undef PG8_WAIT_V
#undef PG8_WAIT_L
#undef PG8_BAR
#undef PG8_SCHED
}
}

struct KArgs { const float* in[25]; float* out; unsigned char* ws; int ph_lo, ph_hi, li, pad; };
typedef const KArgs __attribute__((address_space(4))) CKArgs;
struct Frame {
    LAS unsigned char* lds;
    int tid, lane, wave, G, bid;
    CKArgs* ka;
    unsigned char* ws;
};
#define FIN(i) (F.ka->in[i])
#define FOUT (F.ka->out)
enum { I_X = 0, I_C, I_CTX, I_CCTX, I_WMOD, I_BMOD, I_GPREMIX, I_GPOSTMIX, I_GPREFFN, I_GPOSTFFN, I_WIN, I_CONVW, I_CONVB, I_RPB, I_GCONV, I_GATTN, I_WOUT, I_WROUTER, I_RBIAS,
       I_WEG, I_WEU, I_WED, I_WSG, I_WSU, I_WSD };

template <class RowMap>
__device__ __forceinline__ void transpose_item(const float* W, int ldn, int K, bf16* WT, LAS float* scr, int kb, int nb, int lane, const RowMap& rm) {
    const int k0 = 64 * kb, n0 = 64 * nb;
    f32x4 v[16];
#pragma unroll
    for (int i = 0; i < 16; ++i) v[i] = *(const GAS f32x4*)(W + (size_t)(k0 + 4 * i + (lane >> 4)) * ldn + n0 + 4 * (lane & 15));
#pragma unroll
    for (int i = 0; i < 16; ++i) { LAS float* d = scr + (4 * i + (lane >> 4)) * 65 + 4 * (lane & 15); d[0] = v[i].x; d[1] = v[i].y; d[2] = v[i].z; d[3] = v[i].w; }
    LDS_WAIT(); asm volatile("" ::: "memory");
    const int c = lane & 7;
#pragma unroll
    for (int j = 0; j < 8; ++j) { const int n = (lane >> 3) + 8 * j; const LAS float* s = scr + (8 * c) * 65 + n;
        v4u o; o.x = cvt_pk_bf16(s[0 * 65], s[1 * 65]); o.y = cvt_pk_bf16(s[2 * 65], s[3 * 65]); o.z = cvt_pk_bf16(s[4 * 65], s[5 * 65]); o.w = cvt_pk_bf16(s[6 * 65], s[7 * 65]);
        *(GAS v4u*)(WT + (size_t)rm(n0 + n) * K + k0 + 8 * c) = o; }
    LDS_WAIT(); asm volatile("" ::: "memory");
}
template <class RowMap>
__device__ __forceinline__ void transpose_item_fp8(const float* W, int ldn, int KBrow, unsigned char* WT, LAS float* scr, int kb, int nb, int lane, const RowMap& rm, float scale) {
    const int k0 = 64 * kb, n0 = 64 * nb;
    f32x4 v[16];
#pragma unroll
    for (int i = 0; i < 16; ++i) v[i] = *(const GAS f32x4*)(W + (size_t)(k0 + 4 * i + (lane >> 4)) * ldn + n0 + 4 * (lane & 15));
#pragma unroll
    for (int i = 0; i < 16; ++i) { LAS float* d = scr + (4 * i + (lane >> 4)) * 65 + 4 * (lane & 15); d[0] = v[i].x * scale; d[1] = v[i].y * scale; d[2] = v[i].z * scale; d[3] = v[i].w * scale; }
    LDS_WAIT(); asm volatile("" ::: "memory");
    const int c = lane & 3;
#pragma unroll
    for (int j = 0; j < 4; ++j) { const int n = (lane >> 2) + 16 * j; const LAS float* s = scr + (16 * c) * 65 + n;
        v4u o; o.x = pack4_fp8(s[0 * 65], s[1 * 65], s[2 * 65], s[3 * 65]); o.y = pack4_fp8(s[4 * 65], s[5 * 65], s[6 * 65], s[7 * 65]);
        o.z = pack4_fp8(s[8 * 65], s[9 * 65], s[10 * 65], s[11 * 65]); o.w = pack4_fp8(s[12 * 65], s[13 * 65], s[14 * 65], s[15 * 65]);
        *(GAS v4u*)(WT + (size_t)rm(n0 + n) * KBrow + k0 + 16 * c) = o; }
    LDS_WAIT(); asm volatile("" ::: "memory");
}
struct RmIdent { int off; __device__ __forceinline__ int operator()(int n) const { return off + n; } };
struct RmWin {
    __device__ __forceinline__ int operator()(int n) const {
        if (n < QOFF || n >= VOFF) return n;
        const int nn = n & 127, axis = nn >> 6, half = (nn >> 5) & 1, f = nn & 31;
        return (n - nn) + 2 * (axis * 32 + f) + half; }
};
struct RmGU { int base; int up; __device__ __forceinline__ int operator()(int f) const { return base + 32 * (f >> 4) + 16 * up + (f & 15); } };

__device__ __forceinline__ void p0_prologue(Frame& F) {
    const int gw = F.bid * NWAVES + F.wave, NGW = F.G * NWAVES;
    if (F.bid == 0) {
        GAS f32x2* rope = (GAS f32x2*)(F.ws + WS_ROPE);
        for (int i = F.tid; i < 64 * 32; i += NTHR) { const int pos = i >> 5, f = i & 31;
            const float inv = powf(10000.0f, -(float)f / 32.0f); const float ang = (float)pos * inv;
            rope[i] = (f32x2){(float)cos((double)ang), (float)sin((double)ang)}; }
    }
    {
        LAS float* act = (LAS float*)F.lds;
        LAS float* red = (LAS float*)(F.lds + 9 * 2048 * 4);
        for (int i = F.tid; i < 9 * 2048; i += NTHR) { const int r = i >> 11, k = i & 2047; const float v = r < 8 ? FIN(I_C)[r * 2048 + k] : FIN(I_CCTX)[k]; act[i] = silu_f(v); }
        __syncthreads();
        const float* wm = FIN(I_WMOD);
        for (int cb = F.bid; cb < 256; cb += F.G) {
            const int kq = F.wave * 5 + F.lane / 12, cq = F.lane % 12; const bool on = F.lane < 60;
            f32x4 a[9];
#pragma unroll
            for (int r = 0; r < 9; ++r) a[r] = (f32x4){0.f, 0.f, 0.f, 0.f};
            if (on) for (int k = kq; k < 2048; k += 40) { const f32x4 w = *(const GAS f32x4*)(wm + (size_t)k * 12288 + cb * 48 + cq * 4);
#pragma unroll
                for (int r = 0; r < 9; ++r) a[r] += w * act[r * 2048 + k]; }
#pragma unroll
            for (int r = 0; r < 9; ++r) {
                f32x4 s = a[r];
#pragma unroll
                for (int j = 1; j < 5; ++j) { const int src = (F.lane % 12) + 12 * j; f32x4 o; o.x = __shfl(a[r].x, src); o.y = __shfl(a[r].y, src); o.z = __shfl(a[r].z, src); o.w = __shfl(a[r].w, src); s += o; }
                if (F.lane < 12) *(LAS f32x4*)(red + (F.wave * 9 + r) * 48 + F.lane * 4) = s;
            }
            __syncthreads();
            if (F.tid < 9 * 48) { const int r = F.tid / 48, cc = F.tid % 48; float s = 0.f;
#pragma unroll
                for (int w = 0; w < 8; ++w) s += red[(w * 9 + r) * 48 + cc];
                ((GAS float*)(F.ws + WS_MOD))[r * 12288 + cb * 48 + cc] = s + FIN(I_BMOD)[cb * 48 + cc]; }
            __syncthreads();
        }
    }
    {
        LAS float* scr = (LAS float*)(F.lds + F.wave * 16896);
        bf16* Win = (bf16*)(F.ws + WS_WIN); bf16* Wout = (bf16*)(F.ws + WS_WOUT); unsigned char* Wgu = F.ws + WS_WGU; unsigned char* Wdn = F.ws + WS_WDN;
        constexpr int IT_IN = 32 * 96, IT_OUT = 32 * 32, IT_G = 64 * 32 * 8, IT_D = 64 * 8 * 32, IT_SG = 32 * 8, IT_SD = 8 * 32, IT_R = 32 * 2;
        constexpr int NIT = IT_IN + IT_OUT + 2 * IT_G + IT_D + 2 * IT_SG + IT_SD + IT_R;
        for (int it = gw; it < NIT; it += NGW) {
            int r = it;
            if (r < IT_IN) { transpose_item(FIN(I_WIN), NPROJ, DM, Win, scr, r / 96, r % 96, F.lane, RmWin{}); continue; } r -= IT_IN;
            if (r < IT_OUT) { transpose_item(FIN(I_WOUT), DM, DM, Wout, scr, r / 32, r % 32, F.lane, RmIdent{0}); continue; } r -= IT_OUT;
            if (r < IT_G) { const int e = r / 256, q = r % 256; transpose_item_fp8(FIN(I_WEG) + (size_t)e * DM * FE, FE, DM, Wgu, scr, q / 8, q % 8, F.lane, RmGU{e * 1024, 0}, 64.0f); continue; } r -= IT_G;
            if (r < IT_G) { const int e = r / 256, q = r % 256; transpose_item_fp8(FIN(I_WEU) + (size_t)e * DM * FE, FE, DM, Wgu, scr, q / 8, q % 8, F.lane, RmGU{e * 1024, 1}, 64.0f); continue; } r -= IT_G;
            if (r < IT_D) { const int e = r / 256, q = r % 256; transpose_item_fp8(FIN(I_WED) + (size_t)e * FE * DM, DM, FE, Wdn, scr, q / 32, q % 32, F.lane, RmIdent{e * 2048}, 32.0f); continue; } r -= IT_D;
            if (r < IT_SG) { transpose_item_fp8(FIN(I_WSG), FE, DM, Wgu, scr, r / 8, r % 8, F.lane, RmGU{64 * 1024, 0}, 64.0f); continue; } r -= IT_SG;
            if (r < IT_SG) { transpose_item_fp8(FIN(I_WSU), FE, DM, Wgu, scr, r / 8, r % 8, F.lane, RmGU{64 * 1024, 1}, 64.0f); continue; } r -= IT_SG;
            if (r < IT_SD) { transpose_item_fp8(FIN(I_WSD), DM, FE, Wdn, scr, r / 32, r % 32, F.lane, RmIdent{64 * 2048}, 32.0f); continue; } r -= IT_SD;
            {
                const int kb = r / 2, nb = r % 2; const float* W = FIN(I_WROUTER);
                bf16* WH = (bf16*)(F.ws + WS_WRH); bf16* WL = (bf16*)(F.ws + WS_WRL);
                for (int i = 0; i < 32; ++i) { const int kk = 2 * i + (F.lane >> 5), n = nb * 32 + (F.lane & 31), k = kb * 64 + kk;
                    const float v = W[(size_t)k * NE + n]; const unsigned hi = cvt_pk_bf16(v, 0.f) & 0xffffu; const float rem = v - bf_lo(hi);
                    WH[(size_t)n * DM + k] = (bf16)hi; WL[(size_t)n * DM + k] = (bf16)(cvt_pk_bf16(rem, 0.f) & 0xffffu); }
            }
        }
    }
}

__device__ __forceinline__ void p1_norm(Frame& F) {
    const int gw = F.bid * NWAVES + F.wave, NGW = F.G * NWAVES;
    const float* MOD = (const float*)(F.ws + WS_MOD); const float* g = FIN(I_GPREMIX);
    for (int row = gw; row < T + TC; row += NGW) {
        const bool lat = row < T; const int rr = lat ? row : row - T;
        const float* xr = (lat ? FIN(I_X) : FIN(I_CTX)) + (size_t)rr * DM;
        const float* md = MOD + (size_t)(lat ? (rr >> 11) : 8) * 12288;
        bf16* orow = (bf16*)(F.ws + (lat ? WS_HL : WS_HC)) + (size_t)rr * DM;
        f32x4 v[8]; float ss = 0.f;
#pragma unroll
        for (int j = 0; j < 8; ++j) { v[j] = *(const GAS f32x4*)(xr + 4 * F.lane + 256 * j); ss += (v[j].x * v[j].x + v[j].y * v[j].y) + (v[j].z * v[j].z + v[j].w * v[j].w); }
        const float rstd = 1.0f / sqrtf(wave_sum(ss) * (1.0f / DM) + EPS);
#pragma unroll
        for (int j = 0; j < 8; ++j) { const int c = 4 * F.lane + 256 * j;
            const f32x4 gg = *(const GAS f32x4*)(g + c), sh = *(const GAS f32x4*)(md + c), sc = *(const GAS f32x4*)(md + 2048 + c);
            const f32x4 o = (v[j] * rstd) * gg * (sc + 1.0f) + sh;
            *(GAS v2u*)(orow + c) = (v2u){cvt_pk_bf16(o.x, o.y), cvt_pk_bf16(o.z, o.w)}; }
    }
}

struct ProbProj {
    static constexpr int K = DM, KB = DM * 2, SCALE_A = 0, SCALE_B = 0; static constexpr bool GATHER = false, PERM = true, FP8 = false;
    const bf16 *HL, *HC, *Win; bf16 *PROJ, *KVC; const f32x2* rope; int G, c;
    static constexpr int NMAIN = 64 * 24, NTOT = NMAIN + 64;
    __device__ __forceinline__ bool next(int i, pg8::Unit& u) const {
        const int w = pg8::round_unit(i, G, c, NTOT); if (w < 0) return false;
        if (w < NMAIN) { const int gid = w / 192, r = w % 192; u.pm = gid * 8 + (r & 7); u.pn = r >> 3; u.g = 0; }
        else { const int j = w - NMAIN; u.pm = j & 7; u.pn = 16 + (j >> 3); u.g = 1; }
        return true; }
    __device__ __forceinline__ const char* a_base(const pg8::Unit& u) const { return (const char*)HL + (size_t)u.g * (size_t)(WS_HC - WS_HL) + (size_t)u.pm * 256 * K * 2; }
    __device__ __forceinline__ const char* b_base(const pg8::Unit& u) const { return (const char*)Win + (size_t)u.pn * 256 * K * 2; }
    __device__ __forceinline__ void rows(const pg8::Unit&, int, LAS unsigned*) const {}
    __device__ __forceinline__ void epi(const f32x4 (&acc)[2][2][4][2], const pg8::Unit& u, int wr, int wc, int fr, int fq) const {
        const int row0 = u.pm * 256 + wr * 64 + fr;
        const bool rot = (u.g == 0) && (u.pn >= 12) && (u.pn < 20);
        bf16* base = (bf16*)((char*)PROJ + (long)u.g * ((long)WS_KVC - (long)WS_PROJ));
        const int ldc = NPROJ - u.g * (NPROJ - DM), col0 = (u.pn - 16 * u.g) * 256 + wc * 32 + 8 * fq;
        const int p0 = (wc * 32 + 8 * fq) >> 1, axis = p0 >> 5, f0 = p0 & 31;
#pragma unroll
        for (int ai = 0; ai < 2; ++ai)
#pragma unroll
            for (int m = 0; m < 4; ++m) {
                const int row = row0 + ai * 128 + m * 16; bf16* rowp = base + (size_t)row * ldc + col0;
                const int t = row & (SEQ - 1); const int pos = axis ? (t & 63) : (t >> 6);
                const f32x4 csA = *(const GAS f32x4*)(rope + pos * 32 + f0), csB = *(const GAS f32x4*)(rope + pos * 32 + f0 + 2);
                const f32x2 cs0 = (f32x2){csA.x, csA.y}, cs1 = (f32x2){csA.z, csA.w}, cs2 = (f32x2){csB.x, csB.y}, cs3 = (f32x2){csB.z, csB.w};
#pragma unroll
                for (int bj = 0; bj < 2; ++bj) { f32x4 v0 = acc[ai][bj][m][0], v1 = acc[ai][bj][m][1];
                    if (rot) { f32x4 r0, r1;
                        r0.x = v0.x * cs0.x - v0.y * cs0.y; r0.y = v0.y * cs0.x + v0.x * cs0.y;
                        r0.z = v0.z * cs1.x - v0.w * cs1.y; r0.w = v0.w * cs1.x + v0.z * cs1.y;
                        r1.x = v1.x * cs2.x - v1.y * cs2.y; r1.y = v1.y * cs2.x + v1.x * cs2.y;
                        r1.z = v1.z * cs3.x - v1.w * cs3.y; r1.w = v1.w * cs3.x + v1.z * cs3.y; v0 = r0; v1 = r1; }
                    v4u w; w.x = cvt_pk_bf16(v0.x, v0.y); w.y = cvt_pk_bf16(v0.z, v0.w); w.z = cvt_pk_bf16(v1.x, v1.y); w.w = cvt_pk_bf16(v1.z, v1.w);
                    *(GAS v4u*)(rowp + bj * 128) = w; } }
    }
};

__device__ __forceinline__ float dot2bf(unsigned a, unsigned b, float c) { return __builtin_amdgcn_fdot2_f32_bf16(__builtin_bit_cast(v2bf, a), __builtin_bit_cast(v2bf, b), c, false); }
__device__ __forceinline__ void p3_attn_simple(Frame& F) {
    const bf16* PROJ = (const bf16*)(F.ws + WS_PROJ); const bf16* KVC = (const bf16*)(F.ws + WS_KVC); bf16* Y = (bf16*)(F.ws + WS_Y);
    const float* rpb = FIN(I_RPB); const float* gat = FIN(I_GATTN);
    const float scale = 0.08838834764831845f;
    const int per = (T * NH) / F.G;
    for (int i = F.wave; i < per; i += NWAVES) {
        const int task = F.bid * per + i; const int t = task & (SEQ - 1), bh = task >> 11, h = bh & 7, b = bh >> 3;
        const int r = t >> 6, c = t & 63; int r0 = r - 4; r0 = r0 < 0 ? 0 : (r0 > 24 ? 24 : r0); int cs = c - 8; cs = cs < 0 ? 0 : (cs > 48 ? 48 : cs);
        const unsigned qv = *(const GAS unsigned*)(PROJ + (size_t)(b * SEQ + t) * NPROJ + QOFF + h * HD + 2 * F.lane);
        const bf16* kp[6]; float sc[6];
#pragma unroll
        for (int j = 0; j < 6; ++j) { const int n = F.lane + 64 * j;
            if (j < 2) { const int ii = n >> 4, jj = n & 15; const int tk = (r0 + ii) * GW + cs + jj; kp[j] = PROJ + (size_t)(b * SEQ + tk) * NPROJ + KOFF + h * HD; }
            else kp[j] = KVC + (size_t)(b * LC + (n - 128)) * DM + h * HD;
            sc[j] = 0.f; }
#pragma unroll 4
        for (int pc = 0; pc < 16; ++pc) {
            v4u kk[6];
#pragma unroll
            for (int j = 0; j < 6; ++j) kk[j] = *(const GAS v4u*)(kp[j] + 8 * pc);
            const unsigned q0 = __builtin_amdgcn_readlane(qv, 4 * pc), q1 = __builtin_amdgcn_readlane(qv, 4 * pc + 1), q2 = __builtin_amdgcn_readlane(qv, 4 * pc + 2), q3 = __builtin_amdgcn_readlane(qv, 4 * pc + 3);
#pragma unroll
            for (int j = 0; j < 6; ++j) { sc[j] = dot2bf(q0, kk[j].x, sc[j]); sc[j] = dot2bf(q1, kk[j].y, sc[j]); sc[j] = dot2bf(q2, kk[j].z, sc[j]); sc[j] = dot2bf(q3, kk[j].w, sc[j]); }
        }
        float mx = -1e30f;
#pragma unroll
        for (int j = 0; j < 6; ++j) { sc[j] *= scale;
            if (j < 2) { const int n = F.lane + 64 * j, ii = n >> 4, jj = n & 15; sc[j] += rpb[(h * 15 + (r0 + ii - r + 7)) * 31 + (cs + jj - c + 15)]; }
            mx = fmaxf(mx, sc[j]); }
        mx = wave_max(mx);
        float ps = 0.f;
#pragma unroll
        for (int j = 0; j < 6; ++j) { sc[j] = __expf(sc[j] - mx); ps += sc[j]; }
        ps = wave_sum(ps);
        float o0 = 0.f, o1 = 0.f;
        const bf16* vl = PROJ + (size_t)(b * SEQ) * NPROJ + VOFF + h * HD + 2 * F.lane;
        const bf16* vc = KVC + (size_t)(b * LC) * DM + DC + h * HD + 2 * F.lane;
#pragma unroll
        for (int j = 0; j < 6; ++j) {
#pragma unroll 8
            for (int l = 0; l < 64; ++l) { const int n = l + 64 * j; const float p = __builtin_bit_cast(float, __builtin_amdgcn_readlane(__builtin_bit_cast(unsigned, sc[j]), l));
                unsigned vv;
                if (j < 2) { const int tk = (r0 + (n >> 4)) * GW + cs + (n & 15); vv = *(const GAS unsigned*)(vl + (size_t)tk * NPROJ); }
                else vv = *(const GAS unsigned*)(vc + (size_t)(n - 128) * DM);
                o0 += p * bf_lo(vv); o1 += p * bf_hi(vv); }
        }
        const float inv = 1.0f / ps; o0 *= inv; o1 *= inv;
        const float rstd = 1.0f / sqrtf(wave_sum(o0 * o0 + o1 * o1) * (1.0f / HD) + EPS);
        const f32x2 gg = *(const GAS f32x2*)(gat + h * HD + 2 * F.lane);
        *(GAS unsigned*)(Y + (size_t)(b * SEQ + t) * DM + DC + h * HD + 2 * F.lane) = cvt_pk_bf16(o0 * rstd * gg.x, o1 * rstd * gg.y);
    }
}

namespace at {
typedef short s16x4 __attribute__((ext_vector_type(4)));
typedef float f32x16 __attribute__((ext_vector_type(16)));
constexpr float SCALE = 0.088388347648318440f;
constexpr float THR = 8.f;
constexpr int SHM_V = 64 * 128 * 2, SHM_K = 64 * 128 * 2;
constexpr int WS_OFF = 2 * SHM_V + 2 * SHM_K, BT_OFF = WS_OFF + 8 * 64 * 4, BT_FLOATS = 15 * 32 + 192;
#define KSWZ(row, colB) ((row) * 256 + ((colB) ^ (((row) & 7) << 4)))
#define SBAR() __builtin_amdgcn_sched_barrier(0)
__device__ __forceinline__ int crow(int r, int hi) { return (r & 3) + 8 * (r >> 2) + 4 * hi; }
__device__ __forceinline__ void partialSM(f32x16& p0, f32x16& p1, float& m_reg, float& mn, float& alpha) {
  constexpr float C = SCALE * 1.4426950408889634f;
  float pmax = p0[0];
#pragma unroll
  for (int r = 1; r < 16; ++r) pmax = fmaxf(pmax, p0[r]);
#pragma unroll
  for (int r = 0; r < 16; ++r) pmax = fmaxf(pmax, p1[r]);
  { auto rr = __builtin_amdgcn_permlane32_swap(__builtin_bit_cast(unsigned, pmax), __builtin_bit_cast(unsigned, pmax), false, false);
    pmax = fmaxf(u2f(rr[0]), u2f(rr[1])); }
  if (__builtin_expect(__all(pmax - m_reg <= THR / SCALE), 1)) { mn = m_reg; alpha = 1.f; }
  else { mn = fmaxf(m_reg, pmax); alpha = __builtin_amdgcn_exp2f((m_reg - mn) * C); m_reg = mn; }
  const float mnC = -mn * C;
#pragma unroll
  for (int r = 0; r < 16; ++r) p0[r] = fmaf(p0[r], C, mnC);
#pragma unroll
  for (int r = 0; r < 16; ++r) p1[r] = fmaf(p1[r], C, mnC);
#pragma unroll
  for (int r = 0; r < 16; ++r) p0[r] = __builtin_amdgcn_exp2f(p0[r]);
}
__device__ __forceinline__ void finishSM(f32x16& p0, f32x16& p1, float alpha, float& l_reg, bf16x8& pa0, bf16x8& pa1, bf16x8& pa2, bf16x8& pa3) {
#pragma unroll
  for (int r = 0; r < 16; ++r) p1[r] = __builtin_amdgcn_exp2f(p1[r]);
  float ps = 0;
#pragma unroll
  for (int r = 0; r < 16; ++r) ps += p0[r];
#pragma unroll
  for (int r = 0; r < 16; ++r) ps += p1[r];
  { auto rr = __builtin_amdgcn_permlane32_swap(__builtin_bit_cast(unsigned, ps), __builtin_bit_cast(unsigned, ps), false, false);
    ps = u2f(rr[0]) + u2f(rr[1]); }
  l_reg = l_reg * alpha + ps;
#define PK4(P, BASE, OUT) do { unsigned a0 = cvt_pk_bf16(P[BASE + 0], P[BASE + 1]), a1 = cvt_pk_bf16(P[BASE + 2], P[BASE + 3]);   \
    unsigned b0 = cvt_pk_bf16(P[BASE + 4], P[BASE + 5]), b1 = cvt_pk_bf16(P[BASE + 6], P[BASE + 7]);                              \
    auto r0 = __builtin_amdgcn_permlane32_swap(a0, b0, false, false); auto r1 = __builtin_amdgcn_permlane32_swap(a1, b1, false, false); \
    v4u w = {r0[0], r1[0], r0[1], r1[1]}; OUT = __builtin_bit_cast(bf16x8, w); } while (0)
  PK4(p0, 0, pa0); PK4(p0, 8, pa1); PK4(p1, 0, pa2); PK4(p1, 8, pa3);
#undef PK4
}
__device__ __forceinline__ void qkt(f32x16& p0, f32x16& p1, const LAS char* Ks, const bf16x8* qr, int r32, int hi) {
  p0 = f32x16{}; p1 = f32x16{};
#pragma unroll
  for (int d0 = 0; d0 < 8; ++d0) { const int cb = (d0 * 16 + hi * 8) * 2;
    const bf16x8 b0 = *(const LAS bf16x8*)(Ks + KSWZ(r32, cb));
    const bf16x8 b1 = *(const LAS bf16x8*)(Ks + KSWZ(32 + r32, cb));
    p0 = __builtin_amdgcn_mfma_f32_32x32x16_bf16(b0, qr[d0], p0, 0, 0, 0);
    p1 = __builtin_amdgcn_mfma_f32_32x32x16_bf16(b1, qr[d0], p1, 0, 0, 0); }
}
__device__ __forceinline__ int v_st(int k, int c) { const int kk = (k & ~0xC) | ((k & 4) << 1) | ((k & 8) >> 1); return ((kk >> 3) * 4 + (c >> 5)) * 512 + ((kk & 7) * 32 + (c & 31)) * 2; }
__device__ __forceinline__ int v_rd_base(int lane) { return ((lane & 3) << 3) | (((lane >> 2) & 3) << 6) | (((lane >> 4) & 1) << 5) | (((lane >> 5) & 1) << 8); }
constexpr int v_rd_off(int d0, int ks, int half) { return d0 * 512 + ks * 4096 + half * 2048; }
template <int OFF> __device__ __forceinline__ s16x4 tr_read(int vb) {
  s16x4 r; asm volatile("ds_read_b64_tr_b16 %0, %1 offset:%2" : "=&v"(r) : "v"(vb), "i"(OFF) : "memory"); return r;
}
template <int D0> __device__ __forceinline__ void pv_one(f32x16& od, int vb, bf16x8 pa0, bf16x8 pa1, bf16x8 pa2, bf16x8 pa3) {
  const s16x4 l0 = tr_read<v_rd_off(D0, 0, 0)>(vb), h0 = tr_read<v_rd_off(D0, 0, 1)>(vb), l1 = tr_read<v_rd_off(D0, 1, 0)>(vb), h1 = tr_read<v_rd_off(D0, 1, 1)>(vb);
  const s16x4 l2 = tr_read<v_rd_off(D0, 2, 0)>(vb), h2 = tr_read<v_rd_off(D0, 2, 1)>(vb), l3 = tr_read<v_rd_off(D0, 3, 0)>(vb), h3 = tr_read<v_rd_off(D0, 3, 1)>(vb);
  asm volatile("s_waitcnt lgkmcnt(0)" ::: "memory"); SBAR();
#define PK(L, H) (bf16x8){L[0], L[1], L[2], L[3], H[0], H[1], H[2], H[3]}
  od = __builtin_amdgcn_mfma_f32_32x32x16_bf16(pa0, PK(l0, h0), od, 0, 0, 0);
  od = __builtin_amdgcn_mfma_f32_32x32x16_bf16(pa1, PK(l1, h1), od, 0, 0, 0);
  od = __builtin_amdgcn_mfma_f32_32x32x16_bf16(pa2, PK(l2, h2), od, 0, 0, 0);
  od = __builtin_amdgcn_mfma_f32_32x32x16_bf16(pa3, PK(l3, h3), od, 0, 0, 0);
#undef PK
}
__device__ __forceinline__ void pv_d0(f32x16* o, int vb, bf16x8 pa0, bf16x8 pa1, bf16x8 pa2, bf16x8 pa3) {
  pv_one<0>(o[0], vb, pa0, pa1, pa2, pa3); pv_one<1>(o[1], vb, pa0, pa1, pa2, pa3); pv_one<2>(o[2], vb, pa0, pa1, pa2, pa3); pv_one<3>(o[3], vb, pa0, pa1, pa2, pa3);
}
__device__ __forceinline__ void bias_mask(f32x16& p0, f32x16& p1, const LAS float* bt, int j, int kr_lo, int rq, int r0w, int c, int cs, int hi) {
  if (j < 4) return;
  const int kr = kr_lo + (j - 4);
  if (kr < r0w || kr > r0w + 7) {
#pragma unroll
    for (int r = 0; r < 16; ++r) { p0[r] = -1e30f; p1[r] = -1e30f; }
    return; }
  const LAS float* bp = bt + 64 + (kr - rq + 7) * 32 + 15 - c + 4 * hi;
  const int kc0 = 4 * hi - cs;
#pragma unroll
  for (int r = 0; r < 16; ++r) { const int KC = (r & 3) + 8 * (r >> 2);
    const float b0 = bp[KC], b1 = bp[KC + 32];
    p0[r] = ((unsigned)(kc0 + KC) < 16u) ? p0[r] + b0 : -1e30f;
    p1[r] = ((unsigned)(kc0 + KC + 32) < 16u) ? p1[r] + b1 : -1e30f;
    if ((r & 3) == 3) asm volatile("" ::: "memory"); }
}
}

__device__ __forceinline__ void attn_unit(Frame& F, int b, int h, int g) {
  using namespace at;
  const bf16* PROJ = (const bf16*)(F.ws + WS_PROJ); const bf16* KVC = (const bf16*)(F.ws + WS_KVC); bf16* Y = (bf16*)(F.ws + WS_Y);
  const int tid = F.tid, wid = F.wave, lane = F.lane, r32 = lane & 31, hi = lane >> 5;
  const LAS char* ldsc = (const LAS char*)F.lds;
  LAS char* V_lds = (LAS char*)F.lds; LAS char* K_lds = (LAS char*)F.lds + 2 * SHM_V;
  LAS float* wsl = (LAS float*)(F.lds + WS_OFF) + wid * 64; LAS float* li_l = wsl; LAS float* al_l = wsl + 32;
  LAS float* bt = (LAS float*)(F.lds + BT_OFF);
  const int nloc = (g == 0 || g == 7) ? 8 : 12; const int kr_lo = (g == 0) ? 0 : (g == 7 ? 24 : 4 * g - 4); const int NT = 4 + nloc;
  const int rq = 4 * g + (wid >> 1); int r0w = rq - 4; r0w = r0w < 0 ? 0 : (r0w > 24 ? 24 : r0w);
  const int c = (wid & 1) * 32 + r32; int cs = c - 8; cs = cs < 0 ? 0 : (cs > 48 ? 48 : cs);
  __syncthreads();
  for (int i = tid; i < BT_FLOATS; i += NTHR) { const int k = i - 64; float v = 0.f;
    if (k >= 0 && k < 15 * 32 && (k & 31) < 31) v = FIN(I_RPB)[(h * 15 + (k >> 5)) * 31 + (k & 31)] * (1.0f / SCALE);
    bt[i] = v; }
  float m_reg = -1e30f, l_reg = 0; f32x16 o[4] = {}; bf16x8 qr[8];
  const bf16* Qw = PROJ + (size_t)(b * SEQ + rq * GW + c) * NPROJ + QOFF + h * HD + hi * 8;
#pragma unroll
  for (int d0 = 0; d0 < 8; ++d0) qr[d0] = *(const GAS bf16x8*)(Qw + d0 * 16);
  const int sr = tid >> 4, sc = (tid & 15) * 8, vst0 = v_st(sr, sc), vst1 = v_st(32 + sr, sc);
  const int vb0 = (int)(uintptr_t)V_lds + v_rd_base(lane);
  const GAS char* Kc = (const GAS char*)(KVC + (size_t)(b * LC) * DM + h * HD);
  const GAS char* Kl = (const GAS char*)(PROJ + (size_t)(b * SEQ) * NPROJ + KOFF + h * HD);
  const unsigned vo_c = (unsigned)(sr * DM + sc) * 2u, vo_l = (unsigned)(sr * NPROJ + sc) * 2u;
  struct { bf16x8 vs0, vs1, ks0, ks1; } st_;
#define SLOAD(j) do { const int _j = (j); const GAS char* _k; unsigned _vo; size_t _h; \
    if (_j < 4) { _k = Kc + (size_t)(_j * 64) * DM * 2; _vo = vo_c; _h = (size_t)32 * DM * 2; } else { _k = Kl + (size_t)((kr_lo + _j - 4) * GW) * NPROJ * 2; _vo = vo_l; _h = (size_t)32 * NPROJ * 2; } \
    st_.ks0 = *(const GAS bf16x8*)(_k + _vo); st_.ks1 = *(const GAS bf16x8*)(_k + _h + _vo); \
    st_.vs0 = *(const GAS bf16x8*)(_k + 2048 + _vo); st_.vs1 = *(const GAS bf16x8*)(_k + _h + 2048 + _vo); } while (0)
#define SWRITE(bb) do { *(LAS bf16x8*)(V_lds + (bb) * SHM_V + vst0) = st_.vs0; *(LAS bf16x8*)(V_lds + (bb) * SHM_V + vst1) = st_.vs1; const int kc = sc * 2; \
    *(LAS bf16x8*)(K_lds + (bb) * SHM_K + KSWZ(sr, kc)) = st_.ks0; *(LAS bf16x8*)(K_lds + (bb) * SHM_K + KSWZ(32 + sr, kc)) = st_.ks1; } while (0)
#define RESC(a) do { if (__any((a) < 1.f)) { if (hi == 0) al_l[r32] = (a); asm volatile("s_waitcnt lgkmcnt(0)" ::: "memory"); \
    _Pragma("unroll") for (int d = 0; d < 4; ++d) _Pragma("unroll") for (int r = 0; r < 16; ++r) o[d][r] *= al_l[crow(r, hi)]; } } while (0)
#define BIAS(P0, P1, j) bias_mask(P0, P1, bt, (j), kr_lo, rq, r0w, c, cs, hi)
  f32x16 p0, p1; float mn, al; bf16x8 pa0, pa1, pa2, pa3;
#define STEP(j, B) do { SWRITE(B); if ((j) + 1 < NT) SLOAD((j) + 1); __syncthreads(); \
    qkt(p0, p1, K_lds + (B) * SHM_K, qr, r32, hi); BIAS(p0, p1, (j)); partialSM(p0, p1, m_reg, mn, al); RESC(al); \
    finishSM(p0, p1, al, l_reg, pa0, pa1, pa2, pa3); SBAR(); pv_d0(o, vb0 + (B) * SHM_V, pa0, pa1, pa2, pa3); } while (0)
  SLOAD(0);
  for (int j = 0; j < NT; j += 2) { STEP(j, 0); STEP(j + 1, 1); }
#undef STEP
  asm volatile("s_waitcnt vmcnt(0)" ::: "memory");
  if (hi == 0) li_l[r32] = l_reg; asm volatile("s_waitcnt lgkmcnt(0)" ::: "memory");
  const float* ga = FIN(I_GATTN) + h * HD;
  float gg[4];
#pragma unroll
  for (int d0 = 0; d0 < 4; ++d0) gg[d0] = ga[d0 * 32 + r32];
  bf16* Yw = Y + (size_t)(b * SEQ + rq * GW + (wid & 1) * 32) * DM + DC + h * HD + r32;
#pragma unroll
  for (int r = 0; r < 16; ++r) { const int orow = crow(r, hi); const float rl = 1.0f / li_l[orow];
    float v0 = o[0][r] * rl, v1 = o[1][r] * rl, v2 = o[2][r] * rl, v3 = o[3][r] * rl;
    float ss = (v0 * v0 + v1 * v1) + (v2 * v2 + v3 * v3);
    ss += __shfl_xor(ss, 1); ss += __shfl_xor(ss, 2); ss += __shfl_xor(ss, 4); ss += __shfl_xor(ss, 8); ss += __shfl_xor(ss, 16);
    const float rstd = 1.0f / sqrtf(ss * (1.0f / HD) + EPS);
    bf16* yr = Yw + (size_t)orow * DM;
    yr[0] = (bf16)(cvt_pk_bf16(v0 * rstd * gg[0], 0.f) & 0xffffu); yr[32] = (bf16)(cvt_pk_bf16(v1 * rstd * gg[1], 0.f) & 0xffffu);
    yr[64] = (bf16)(cvt_pk_bf16(v2 * rstd * gg[2], 0.f) & 0xffffu); yr[96] = (bf16)(cvt_pk_bf16(v3 * rstd * gg[3], 0.f) & 0xffffu); }
#undef SLOAD
#undef SWRITE
#undef RESC
#undef BIAS
}
__device__ __forceinline__ void p3_attn_mfma(Frame& F) {
  const int cx = (F.bid & 7) * 32 + (F.bid >> 3);
  for (int u = cx; u < 512; u += 256) {
    int bh, g;
    if (u < 384) { bh = u / 6; g = 1 + u % 6; } else { const int s = u - 384; bh = s >> 1; g = (s & 1) ? 7 : 0; }
    attn_unit(F, bh >> 3, bh & 7, g);
  }
}

__device__ __forceinline__ void p3_conv(Frame& F) {
    const bf16* PROJ = (const bf16*)(F.ws + WS_PROJ); bf16* Y = (bf16*)(F.ws + WS_Y);
    const float* cw = FIN(I_CONVW); const float* cb = FIN(I_CONVB); const float* gc = FIN(I_GCONV);
    const int gw = F.bid * NWAVES + F.wave, NGW = F.G * NWAVES;
    const int ch0 = 16 * F.lane;
    for (int row = gw; row < T; row += NGW) {
        const int t = row & (SEQ - 1);
        const bf16* pr = PROJ + (size_t)row * NPROJ + ch0;
        float pm[16], p0[16], pp[16], ub[16];
#pragma unroll
        for (int hh = 0; hh < 2; ++hh) {
            const v4u vb = *(const GAS v4u*)(pr + 8 * hh), vc0 = *(const GAS v4u*)(pr + 1024 + 8 * hh), vx0 = *(const GAS v4u*)(pr + 2048 + 8 * hh);
            v4u vcm = (v4u){0, 0, 0, 0}, vxm = vcm, vcp = vcm, vxp = vcm;
            if (t > 0) { vcm = *(const GAS v4u*)(pr - NPROJ + 1024 + 8 * hh); vxm = *(const GAS v4u*)(pr - NPROJ + 2048 + 8 * hh); }
            if (t < SEQ - 1) { vcp = *(const GAS v4u*)(pr + NPROJ + 1024 + 8 * hh); vxp = *(const GAS v4u*)(pr + NPROJ + 2048 + 8 * hh); }
#pragma unroll
            for (int q = 0; q < 4; ++q) { const int e = 8 * hh + 2 * q;
                ub[e] = bf_lo(vb[q]); ub[e + 1] = bf_hi(vb[q]);
                p0[e] = bf_lo(vc0[q]) * bf_lo(vx0[q]); p0[e + 1] = bf_hi(vc0[q]) * bf_hi(vx0[q]);
                pm[e] = bf_lo(vcm[q]) * bf_lo(vxm[q]); pm[e + 1] = bf_hi(vcm[q]) * bf_hi(vxm[q]);
                pp[e] = bf_lo(vcp[q]) * bf_lo(vxp[q]); pp[e + 1] = bf_hi(vcp[q]) * bf_hi(vxp[q]); }
        }
        float o[16]; float ss = 0.f;
#pragma unroll
        for (int q = 0; q < 4; ++q) { const f32x4 w0 = *(const GAS f32x4*)(cw + ch0 + 4 * q), w1 = *(const GAS f32x4*)(cw + 1024 + ch0 + 4 * q), w2 = *(const GAS f32x4*)(cw + 2048 + ch0 + 4 * q), bb = *(const GAS f32x4*)(cb + ch0 + 4 * q);
#pragma unroll
            for (int e = 0; e < 4; ++e) { const int k = 4 * q + e; const float cv = pm[k] * w0[e] + p0[k] * w1[e] + pp[k] * w2[e] + bb[e]; o[k] = ub[k] * cv; ss += o[k] * o[k]; } }
        ss += __shfl_xor(ss, 1); ss += __shfl_xor(ss, 2); ss += __shfl_xor(ss, 4);
        const float rstd = 1.0f / sqrtf(ss * (1.0f / 128.0f) + EPS);
        unsigned w[8];
#pragma unroll
        for (int q = 0; q < 4; ++q) { const f32x4 gg = *(const GAS f32x4*)(gc + ch0 + 4 * q);
            w[2 * q] = cvt_pk_bf16(o[4 * q] * rstd * gg[0], o[4 * q + 1] * rstd * gg[1]); w[2 * q + 1] = cvt_pk_bf16(o[4 * q + 2] * rstd * gg[2], o[4 * q + 3] * rstd * gg[3]); }
        *(GAS v4u*)(Y + (size_t)row * DM + ch0) = (v4u){w[0], w[1], w[2], w[3]};
        *(GAS v4u*)(Y + (size_t)row * DM + ch0 + 8) = (v4u){w[4], w[5], w[6], w[7]};
    }
}

struct ProbOut {
    static constexpr int K = DM, KB = DM * 2, SCALE_A = 0, SCALE_B = 0; static constexpr bool GATHER = false, PERM = true, FP8 = false;
    const bf16 *Y, *Wout; bf16* YL; float* SSQ; int G, c;
    __device__ __forceinline__ bool next(int i, pg8::Unit& u) const {
        const int w = pg8::round_unit(i, G, c, 512); if (w < 0) return false;
        u.pm = (w >> 6) * 8 + (w & 7); u.pn = (w & 63) >> 3; u.g = 0; return true; }
    __device__ __forceinline__ const char* a_base(const pg8::Unit& u) const { return (const char*)Y + (size_t)u.pm * 256 * K * 2; }
    __device__ __forceinline__ const char* b_base(const pg8::Unit& u) const { return (const char*)Wout + (size_t)u.pn * 256 * K * 2; }
    __device__ __forceinline__ void rows(const pg8::Unit&, int, LAS unsigned*) const {}
    __device__ __forceinline__ void epi(const f32x4 (&acc)[2][2][4][2], const pg8::Unit& u, int wr, int wc, int fr, int fq) const {
        const int row0 = u.pm * 256 + wr * 64 + fr, col0 = u.pn * 256 + wc * 32 + 8 * fq;
#pragma unroll
        for (int ai = 0; ai < 2; ++ai)
#pragma unroll
            for (int m = 0; m < 4; ++m) { const int row = row0 + ai * 128 + m * 16; bf16* rowp = YL + (size_t)row * DM + col0; float ss = 0.f;
#pragma unroll
                for (int bj = 0; bj < 2; ++bj) { const f32x4 v0 = acc[ai][bj][m][0], v1 = acc[ai][bj][m][1];
                    ss += (v0.x * v0.x + v0.y * v0.y) + (v0.z * v0.z + v0.w * v0.w) + (v1.x * v1.x + v1.y * v1.y) + (v1.z * v1.z + v1.w * v1.w);
                    v4u w; w.x = cvt_pk_bf16(v0.x, v0.y); w.y = cvt_pk_bf16(v0.z, v0.w); w.z = cvt_pk_bf16(v1.x, v1.y); w.w = cvt_pk_bf16(v1.z, v1.w);
                    *(GAS v4u*)(rowp + bj * 128) = w; }
                ss += __shfl_xor(ss, 16); ss += __shfl_xor(ss, 32);
                if (fq == 0) SSQ[(size_t)row * 32 + u.pn * 4 + wc] = ss; }
    }
};

__device__ __forceinline__ void p5_route(Frame& F) {
    const float* MOD = (const float*)(F.ws + WS_MOD);
    const bf16* YL = (const bf16*)(F.ws + WS_YL); const float* SSQ = (const float*)(F.ws + WS_SSQ);
    bf16* H2 = (bf16*)(F.ws + WS_HL); bf16* H2L = (bf16*)(F.ws + WS_H2LO);
    const bf16* WRH = (const bf16*)(F.ws + WS_WRH); const bf16* WRL = (const bf16*)(F.ws + WS_WRL);
    unsigned* gcnt = (unsigned*)(F.ws + WS_CTL) + CW_CNT;
    v2u* LIST = (v2u*)(F.ws + WS_LIST);
    LAS float* logit = (LAS float*)F.lds;
    LAS unsigned* lcnt = (LAS unsigned*)(F.lds + 16384);
    LAS unsigned* lbase = (LAS unsigned*)(F.lds + 16384 + 256);
    LAS unsigned* ent = (LAS unsigned*)(F.lds + 16384 + 512);
    for (int blk = F.bid; blk < T / 64; blk += F.G) {
        const int row0 = blk * 64;
        if (F.tid < 64) lcnt[F.tid] = 0u;
        for (int rr = F.wave; rr < 64; rr += NWAVES) {
            const int row = row0 + rr, b = row >> 11; const float* md = MOD + (size_t)b * 12288;
            const float* xr = FIN(I_X) + (size_t)row * DM; const bf16* yr = YL + (size_t)row * DM;
            float sq = F.lane < 32 ? SSQ[(size_t)row * 32 + F.lane] : 0.f; sq = wave_sum(sq);
            const float rstd1 = 1.0f / sqrtf(sq * (1.0f / DM) + EPS);
            f32x4 v[8]; float ss = 0.f;
#pragma unroll
            for (int j = 0; j < 8; ++j) { const int c = 4 * F.lane + 256 * j;
                const f32x4 xv = *(const GAS f32x4*)(xr + c); const v2u yv = *(const GAS v2u*)(yr + c);
                const f32x4 gp = *(const GAS f32x4*)(FIN(I_GPOSTMIX) + c), gt = *(const GAS f32x4*)(md + 4096 + c);
                const f32x4 yl = (f32x4){bf_lo(yv.x), bf_hi(yv.x), bf_lo(yv.y), bf_hi(yv.y)};
                v[j] = xv + gt * (yl * rstd1 * gp);
                *(GAS f32x4*)(FOUT + (size_t)row * DM + c) = v[j];
                ss += (v[j].x * v[j].x + v[j].y * v[j].y) + (v[j].z * v[j].z + v[j].w * v[j].w); }
            const float rstd2 = 1.0f / sqrtf(wave_sum(ss) * (1.0f / DM) + EPS);
#pragma unroll
            for (int j = 0; j < 8; ++j) { const int c = 4 * F.lane + 256 * j;
                const f32x4 gg = *(const GAS f32x4*)(FIN(I_GPREFFN) + c), sh = *(const GAS f32x4*)(md + 6144 + c), sc = *(const GAS f32x4*)(md + 8192 + c);
                const f32x4 h = (v[j] * rstd2) * gg * (sc + 1.0f) + sh;
                const unsigned h0 = cvt_pk_bf16(h.x, h.y), h1 = cvt_pk_bf16(h.z, h.w);
                const unsigned l0 = cvt_pk_bf16(h.x - bf_lo(h0), h.y - bf_hi(h0)), l1 = cvt_pk_bf16(h.z - bf_lo(h1), h.w - bf_hi(h1));
                *(GAS v2u*)(H2 + (size_t)row * DM + c) = (v2u){h0, h1}; *(GAS v2u*)(H2L + (size_t)row * DM + c) = (v2u){l0, l1};
                *(GAS unsigned*)(F.ws + WS_H2Q + (size_t)row * DM + c) = pack4_fp8(clamp448(h.x * 4.0f), clamp448(h.y * 4.0f), clamp448(h.z * 4.0f), clamp448(h.w * 4.0f)); }
        }
        VM_WAIT(); __syncthreads();
        {
            const int rt = F.wave & 3, nh = F.wave >> 2, fr = F.lane & 15, fq = F.lane >> 4;
            const bf16* ah = H2 + (size_t)(row0 + rt * 16 + fr) * DM + 8 * fq; const bf16* al = H2L + (size_t)(row0 + rt * 16 + fr) * DM + 8 * fq;
            f32x4 acc[2] = {(f32x4){0.f, 0.f, 0.f, 0.f}, (f32x4){0.f, 0.f, 0.f, 0.f}};
#pragma unroll 2
            for (int s = 0; s < 64; ++s) {
                const bf16x8 a_h = *(const GAS bf16x8*)(ah + 32 * s), a_l = *(const GAS bf16x8*)(al + 32 * s);
#pragma unroll
                for (int n2 = 0; n2 < 2; ++n2) { const size_t eo = (size_t)(nh * 32 + n2 * 16 + fr) * DM + 32 * s + 8 * fq;
                    const bf16x8 b_h = *(const GAS bf16x8*)(WRH + eo), b_l = *(const GAS bf16x8*)(WRL + eo);
                    acc[n2] = __builtin_amdgcn_mfma_f32_16x16x32_bf16(a_l, b_h, acc[n2], 0, 0, 0);
                    acc[n2] = __builtin_amdgcn_mfma_f32_16x16x32_bf16(a_h, b_l, acc[n2], 0, 0, 0);
                    acc[n2] = __builtin_amdgcn_mfma_f32_16x16x32_bf16(a_h, b_h, acc[n2], 0, 0, 0); }
            }
#pragma unroll
            for (int n2 = 0; n2 < 2; ++n2)
#pragma unroll
                for (int r = 0; r < 4; ++r) logit[(rt * 16 + 4 * fq + r) * 64 + nh * 32 + n2 * 16 + fr] = acc[n2][r];
        }
        __syncthreads();
        for (int rr = F.wave; rr < 64; rr += NWAVES) {
            const int row = row0 + rr; const int e = F.lane;
            const float lg = logit[rr * 64 + e]; const float score = 1.0f / (1.0f + expf(-lg)); const float sel = score + FIN(I_RBIAS)[e];
            float m1 = sel; m1 = fmaxf(m1, __shfl_xor(m1, 1)); m1 = fmaxf(m1, __shfl_xor(m1, 2)); m1 = fmaxf(m1, __shfl_xor(m1, 4));
            int i1 = (sel == m1) ? e : 1000; i1 = min(i1, __shfl_xor(i1, 1)); i1 = min(i1, __shfl_xor(i1, 2)); i1 = min(i1, __shfl_xor(i1, 4));
            float s2 = (e == i1) ? -INFINITY : sel; s2 = fmaxf(s2, __shfl_xor(s2, 1)); s2 = fmaxf(s2, __shfl_xor(s2, 2)); s2 = fmaxf(s2, __shfl_xor(s2, 4));
            const float gs = m1 + s2; const int g = e >> 3; int grank = 0;
#pragma unroll
            for (int g2 = 0; g2 < 8; ++g2) { const float o = __builtin_bit_cast(float, __builtin_amdgcn_readlane(__builtin_bit_cast(unsigned, gs), 8 * g2)); grank += (o > gs || (o == gs && g2 < g)) ? 1 : 0; }
            const float ms = grank < 4 ? sel : -INFINITY; int rank = 0;
#pragma unroll 4
            for (int e2 = 0; e2 < 64; ++e2) { const float o = __builtin_bit_cast(float, __builtin_amdgcn_readlane(__builtin_bit_cast(unsigned, ms), e2)); rank += (o > ms || (o == ms && e2 < e)) ? 1 : 0; }
            const bool chosen = rank < 8;
            const float ssum = wave_sum(chosen ? score : 0.f);
            const float w = score / ssum * 2.5f;
            if (chosen) { const unsigned lp = __hip_atomic_fetch_add(lcnt + e, 1u, __ATOMIC_RELAXED, __HIP_MEMORY_SCOPE_WORKGROUP);
                LAS unsigned* en = ent + (rr * 8 + rank) * 4; en[0] = (unsigned)e; en[1] = lp; en[2] = (unsigned)row * 16u + (unsigned)rank; en[3] = __builtin_bit_cast(unsigned, w); }
            if (F.lane == 0) LIST[(size_t)64 * LIST_CAP + row] = (v2u){(unsigned)row * 16u + 8u, __builtin_bit_cast(unsigned, 1.0f)};
        }
        __syncthreads();
        if (F.tid < 64) lbase[F.tid] = __hip_atomic_fetch_add(gcnt + 64 * F.tid, lcnt[F.tid], RLX_AGENT);
        __syncthreads();
        { const LAS unsigned* en = ent + F.tid * 4; const unsigned e = en[0], idx = lbase[e] + en[1]; LIST[(size_t)e * LIST_CAP + idx] = (v2u){en[2], en[3]};
          ((v2u*)(F.ws + WS_TOK))[(size_t)(en[2] >> 4) * 8 + (en[2] & 15u)] = (v2u){(e << 16) | idx, en[3]}; }
        __syncthreads();
    }
}

struct TileTab { LAS int* cnt; LAS int* tstart; };
__device__ __forceinline__ TileTab build_tiles(Frame& F) {
    TileTab tt; tt.cnt = (LAS int*)(F.lds + MISC_OFF); tt.tstart = tt.cnt + 128;
    const unsigned* gcnt = (const unsigned*)(F.ws + WS_CTL) + CW_CNT;
    if (F.tid < 64) tt.cnt[F.tid] = (int)__hip_atomic_load(gcnt + 64 * F.tid, RLX_AGENT);
    if (F.tid == 64) tt.cnt[64] = T;
    __syncthreads();
    if (F.tid == 0) { int s = 0; for (int e = 0; e < 65; ++e) { tt.tstart[e] = s; s += (tt.cnt[e] + 255) >> 8; } tt.tstart[65] = s; }
    __syncthreads();
    return tt;
}
__device__ __forceinline__ int tile_expert(const TileTab& tt, int tile) { int e = 0; while (tt.tstart[e + 1] <= tile) ++e; return e; }

struct ProbGU {
    static constexpr int KB = DM, SCALE_A = 0x7D7D7D7D  , SCALE_B = 0x79797979  ; static constexpr bool GATHER = true, PERM = false, FP8 = true;
    const unsigned char *H2Q, *Wgu; unsigned char* HID; const v2u* LIST; TileTab tt; int G, c;
    __device__ __forceinline__ bool next(int i, pg8::Unit& u) const {
        const int total = tt.tstart[65] * 4; const int w = pg8::round_unit(i, G, c, total); if (w < 0) return false;
        u.pm = w >> 2; u.pn = w & 3; u.g = tile_expert(tt, u.pm); return true; }
    __device__ __forceinline__ const char* a_base(const pg8::Unit&) const { return (const char*)H2Q; }
    __device__ __forceinline__ const char* b_base(const pg8::Unit& u) const { return (const char*)Wgu + ((size_t)u.g * 1024 + (size_t)u.pn * 256) * KB; }
    __device__ __forceinline__ void rows(const pg8::Unit& u, int tid, LAS unsigned* dst) const {
        const int lt = u.pm - tt.tstart[u.g]; const int nrow = tt.cnt[u.g] - lt * 256; const v2u* lp = LIST + (size_t)u.g * LIST_CAP + lt * 256;
        unsigned tk[2][2];
#pragma unroll
        for (int i = 0; i < 2; ++i) { int R0, C; pg8::stage_rc(tid * 16 + i * 8192, R0, C);
#pragma unroll
            for (int h = 0; h < 2; ++h) { int R = R0 + 128 * h; R = R < nrow ? R : nrow - 1; tk[h][i] = lp[R].x; } }
#pragma unroll
        for (int i = 0; i < 2; ++i) { int R0, C; pg8::stage_rc(tid * 16 + i * 8192, R0, C);
#pragma unroll
            for (int h = 0; h < 2; ++h) dst[(h * 2 + i) * 512 + tid] = (tk[h][i] >> 4) * (unsigned)KB + (unsigned)(C * 2); }
    }
    __device__ __forceinline__ void epi(const f32x4 (&acc)[2][2][4][2], const pg8::Unit& u, int wr, int wc, int fr, int fq) const {
#pragma unroll
        for (int ai = 0; ai < 2; ++ai)
#pragma unroll
            for (int m = 0; m < 4; ++m) { const int R = ai * 128 + wr * 64 + m * 16 + fr;
                unsigned char* rowp = HID + ((size_t)u.pm * 256 + R) * FE + u.pn * 128 + wc * 16 + 4 * fq;
#pragma unroll
                for (int bj = 0; bj < 2; ++bj) { const f32x4 g = acc[ai][bj][m][0], up = acc[ai][bj][m][1]; f32x4 hv;
#pragma unroll
                    for (int q = 0; q < 4; ++q) hv[q] = clamp448(g[q] / (1.0f + __expf(-g[q])) * up[q] * 4.0f);
                    *(GAS unsigned*)(rowp + bj * 64) = pack4_fp8(hv.x, hv.y, hv.z, hv.w); } }
    }
};
struct ProbDown {
    static constexpr int KB = FE, SCALE_A = 0x7D7D7D7D  , SCALE_B = 0x7A7A7A7A  ; static constexpr bool GATHER = false, PERM = true, FP8 = true;
    const unsigned char *HID, *Wdn; bf16* SLOT; const v2u* LIST; TileTab tt; int G, c;
    __device__ __forceinline__ bool next(int i, pg8::Unit& u) const {
        const int total = tt.tstart[65] * 8; const int w = pg8::round_unit(i, G, c, total); if (w < 0) return false;
        u.pm = w >> 3; u.pn = w & 7; u.g = tile_expert(tt, u.pm); return true; }
    __device__ __forceinline__ const char* a_base(const pg8::Unit& u) const { return (const char*)HID + (size_t)u.pm * 256 * KB; }
    __device__ __forceinline__ const char* b_base(const pg8::Unit& u) const { return (const char*)Wdn + ((size_t)u.g * 2048 + (size_t)u.pn * 256) * KB; }
    __device__ __forceinline__ void rows(const pg8::Unit&, int, LAS unsigned*) const {}
    __device__ __forceinline__ void epi(const f32x4 (&acc)[2][2][4][2], const pg8::Unit& u, int wr, int wc, int fr, int fq) const {
        const int col0 = u.pn * 256 + wc * 32 + 8 * fq;
#pragma unroll
        for (int ai = 0; ai < 2; ++ai)
#pragma unroll
            for (int m = 0; m < 4; ++m) { const int R = ai * 128 + wr * 64 + m * 16 + fr; bf16* rowp = SLOT + ((size_t)u.pm * 256 + R) * DM + col0;
#pragma unroll
                for (int bj = 0; bj < 2; ++bj) { const f32x4 v0 = acc[ai][bj][m][0], v1 = acc[ai][bj][m][1];
                    v4u w; w.x = cvt_pk_bf16(v0.x, v0.y); w.y = cvt_pk_bf16(v0.z, v0.w); w.z = cvt_pk_bf16(v1.x, v1.y); w.w = cvt_pk_bf16(v1.z, v1.w);
                    *(GAS v4u*)(rowp + bj * 128) = w; } }
    }
};

__device__ __forceinline__ void p8_final(Frame& F) {
    const int gw = F.bid * NWAVES + F.wave, NGW = F.G * NWAVES;
    const TileTab tt = build_tiles(F);
    const float* MOD = (const float*)(F.ws + WS_MOD); const bf16* SLOT = (const bf16*)(F.ws + WS_SLOT); const float* g = FIN(I_GPOSTFFN);
    const v2u* TOK = (const v2u*)(F.ws + WS_TOK);
    const int sh0 = tt.tstart[64] * 256;
    for (int row = gw; row < T; row += NGW) {
        const float* md = MOD + (size_t)(row >> 11) * 12288;
        unsigned mypos = 0u; float myw = 0.f;
        if (F.lane < 8) { const v2u tk = TOK[(size_t)row * 8 + F.lane]; const unsigned e = tk.x >> 16; mypos = (unsigned)tt.tstart[e] * 256u + (tk.x & 0xffffu); myw = u2f(tk.y); }
        f32x4 v[8];
        { const bf16* sr = SLOT + (size_t)(sh0 + row) * DM;
#pragma unroll
          for (int j = 0; j < 8; ++j) { const v2u yv = *(const GAS v2u*)(sr + 4 * F.lane + 256 * j); v[j] = (f32x4){bf_lo(yv.x), bf_hi(yv.x), bf_lo(yv.y), bf_hi(yv.y)}; } }
#pragma unroll
        for (int s = 0; s < 8; ++s) { const unsigned pos = __builtin_amdgcn_readlane(mypos, s); const float w = u2f(__builtin_amdgcn_readlane(__builtin_bit_cast(unsigned, myw), s));
            const bf16* sr = SLOT + (size_t)pos * DM;
#pragma unroll
            for (int j = 0; j < 8; ++j) { const v2u yv = *(const GAS v2u*)(sr + 4 * F.lane + 256 * j); v[j] += (f32x4){bf_lo(yv.x), bf_hi(yv.x), bf_lo(yv.y), bf_hi(yv.y)} * w; } }
        float ss = 0.f;
#pragma unroll
        for (int j = 0; j < 8; ++j) ss += (v[j].x * v[j].x + v[j].y * v[j].y) + (v[j].z * v[j].z + v[j].w * v[j].w);
        const float rstd = 1.0f / sqrtf(wave_sum(ss) * (1.0f / DM) + EPS);
#pragma unroll
        for (int j = 0; j < 8; ++j) { const int c = 4 * F.lane + 256 * j;
            const f32x4 gg = *(const GAS f32x4*)(g + c), gt = *(const GAS f32x4*)(md + 10240 + c);
            GAS f32x4* op = (GAS f32x4*)(FOUT + (size_t)row * DM + c);
            *op = *op + gt * (v[j] * rstd * gg); }
    }
}

constexpr int N_PHASES = 9;
typedef KArgs Args;
__global__ void __launch_bounds__(NTHR, 2) fwd_kernel(Args args) {
    extern __shared__ __attribute__((aligned(16))) unsigned char lds_raw[];
    Frame F;
    F.lds = (LAS unsigned char*)lds_raw;
    F.tid = threadIdx.x; F.lane = F.tid & 63; F.wave = __builtin_amdgcn_readfirstlane(F.tid >> 6);
    F.G = gridDim.x; F.bid = blockIdx.x;
    F.ka = (CKArgs*)__builtin_amdgcn_kernarg_segment_ptr(); F.ws = args.ws;
#define LAUNDER() do { CKArgs* _p = (CKArgs*)__builtin_amdgcn_kernarg_segment_ptr(); asm volatile("" : "+s"(_p) :: "memory"); F.ka = _p; unsigned char* _w = _p->ws; F.ws = _w; } while (0)
    volatile LAS unsigned* barw = (volatile LAS unsigned*)(F.lds + BARW_OFF);
    if (F.tid < 16) barw[F.tid] = 0u;
    __syncthreads();
    XcdBarrier bar; bar.bar = (unsigned*)(F.ws + WS_CTL) + CW_BAR + args.li * XCD_BAR_WORDS; bar.x = 0; bar.st = nullptr;
    const int lo = args.ph_lo, hi = args.ph_hi;
    if (hi - lo > 1) bar = xcd_barrier_post((unsigned*)(F.ws + WS_CTL) + CW_BAR + args.li * XCD_BAR_WORDS, barw);
#ifndef PH_MASK
#define PH_MASK 0x1ff
#endif
#define IN(k) (((PH_MASK >> (k)) & 1) && lo <= (k) && (k) < hi)
#define SEAM(k) do { if (IN(k) && IN((k) + 1)) xcd_barrier(bar); } while (0)
#ifndef REPEAT_MASK
#define REPEAT_MASK 0
#endif
#define NREP(k) (((REPEAT_MASK >> (k)) & 1) ? 2 : 1)
    if (IN(0)) { for (int rep = 0; rep < NREP(0); ++rep) { if (rep) xcd_barrier(bar); LAUNDER(); p0_prologue(F); } } SEAM(0);
    if (IN(1)) { LAUNDER(); p1_norm(F); } SEAM(1);
    if (IN(2)) { LAUNDER();
        ProbProj P; P.HL = (const bf16*)(F.ws + WS_HL); P.HC = (const bf16*)(F.ws + WS_HC); P.Win = (const bf16*)(F.ws + WS_WIN); P.PROJ = (bf16*)(F.ws + WS_PROJ); P.KVC = (bf16*)(F.ws + WS_KVC);
        P.rope = (const f32x2*)(F.ws + WS_ROPE); P.G = F.G; P.c = F.bid;
        for (int rep = 0; rep < NREP(2); ++rep) { if (rep) xcd_barrier(bar); pg8::gemm_phase<ProbProj>(F.lds, P); }
    } SEAM(2);
    if (IN(3)) { LAUNDER();
#ifdef ATTN_SIMPLE
        p3_attn_simple(F);
#else
        p3_attn_mfma(F);
#endif
        LAUNDER(); p3_conv(F); } SEAM(3);
    if (IN(4)) { LAUNDER();
        ProbOut P; P.Y = (const bf16*)(F.ws + WS_Y); P.Wout = (const bf16*)(F.ws + WS_WOUT); P.YL = (bf16*)(F.ws + WS_YL); P.SSQ = (float*)(F.ws + WS_SSQ); P.G = F.G; P.c = F.bid;
        pg8::gemm_phase<ProbOut>(F.lds, P);
    } SEAM(4);
    if (IN(5)) { LAUNDER(); p5_route(F); } SEAM(5);
    if (IN(6)) { LAUNDER();
#ifdef DIAG
        if (F.bid == 0 && F.wave == 0) { const bf16* Wgu = (const bf16*)(F.ws + WS_WGU); const bf16* H2 = (const bf16*)(F.ws + WS_HL);
            const float s0 = wave_sum(fabsf(bf_lo(Wgu[((size_t)5 * 1024 + 100) * 2048 + F.lane]))); const float s1 = wave_sum(fabsf(bf_lo(H2[(size_t)1000 * 2048 + F.lane])));
            unsigned st = 0; if (!(s0 > 1e-3f)) st |= 1u; if (!(s1 > 1e-3f)) st |= 2u;
            if (F.lane == 0) __hip_atomic_store((unsigned*)(F.ws + WS_CTL) + 100, st, RLX_AGENT); }
#endif
        ProbGU P; P.tt = build_tiles(F); P.H2Q = F.ws + WS_H2Q; P.Wgu = F.ws + WS_WGU; P.HID = F.ws + WS_HID; P.LIST = (const v2u*)(F.ws + WS_LIST); P.G = F.G; P.c = F.bid;
        for (int rep = 0; rep < NREP(6); ++rep) { if (rep) xcd_barrier(bar); pg8::gemm_phase<ProbGU>(F.lds, P); }
#ifdef DIAG
        VM_WAIT(); __syncthreads();
        if (F.bid == 96 && F.wave == 0) { const bf16* HID = (const bf16*)(F.ws + WS_HID); const float s2 = wave_sum(fabsf(bf_lo(HID[(size_t)1000 * 512 + F.lane])));
            if (F.lane == 0) __hip_atomic_store((unsigned*)(F.ws + WS_CTL) + 102, (s2 > 1e-6f) ? 1u : 2u, RLX_AGENT); }
#endif
    } SEAM(6);
    if (IN(7)) { LAUNDER();
#ifdef DIAG
        if (F.bid == 0 && F.wave == 0) { const bf16* HID = (const bf16*)(F.ws + WS_HID); const float s2 = wave_sum(fabsf(bf_lo(HID[(size_t)1000 * 512 + F.lane])));
            if (F.lane == 0) __hip_atomic_store((unsigned*)(F.ws + WS_CTL) + 103, (s2 > 1e-6f) ? 1u : 2u, RLX_AGENT); }
#endif
        ProbDown P; P.tt = build_tiles(F); P.HID = F.ws + WS_HID; P.Wdn = F.ws + WS_WDN; P.SLOT = (bf16*)(F.ws + WS_SLOT); P.LIST = (const v2u*)(F.ws + WS_LIST); P.G = F.G; P.c = F.bid;
        for (int rep = 0; rep < NREP(7); ++rep) { if (rep) xcd_barrier(bar); pg8::gemm_phase<ProbDown>(F.lds, P); }
    } SEAM(7);
    if (IN(8)) { LAUNDER(); p8_final(F); }
#undef IN
#undef SEAM
}

extern "C" void kernel_launch(void* const* d_in, const int* in_sizes, int n_in, void* d_out, int out_size, void* d_ws, size_t ws_size, hipStream_t stream) {
    static int grid = 0;
    if (grid == 0) {
        if (n_in != 25 || in_sizes[0] != T * DM || out_size != T * DM || ws_size < WS_END) { fprintf(stderr, "kernel_launch: shape/workspace mismatch (n_in %d, in0 %d, out %d, ws %zu < %zu)\n", n_in, n_in > 0 ? in_sizes[0] : -1, out_size, ws_size, (size_t)WS_END); grid = -1; return; }
        int dev = 0, cus = 0, per_cu = 0;
        if (hipGetDevice(&dev) != hipSuccess || hipDeviceGetAttribute(&cus, hipDeviceAttributeMultiprocessorCount, dev) != hipSuccess) { grid = -1; return; }
        if (hipFuncSetAttribute((const void*)fwd_kernel, hipFuncAttributeMaxDynamicSharedMemorySize, LDS_BYTES) != hipSuccess) { fprintf(stderr, "kernel_launch: hipFuncSetAttribute failed\n"); grid = -1; return; }
        if (hipOccupancyMaxActiveBlocksPerMultiprocessor(&per_cu, (const void*)fwd_kernel, NTHR, LDS_BYTES) != hipSuccess || per_cu < 1) fprintf(stderr, "kernel_launch: occupancy query says %d\n", per_cu);
        (void)hipGetLastError();
        grid = cus;
        if (grid != 256) fprintf(stderr, "kernel_launch: %d CUs (built for 256)\n", grid);
    }
    if (grid < 0) return;
    if (hipMemsetAsync((char*)d_ws + WS_CTL, 0, CTL_ZERO_BYTES, stream) != hipSuccess) return;
    Args a{};
    for (int i = 0; i < 25; ++i) a.in[i] = (const float*)d_in[i];
    a.out = (float*)d_out; a.ws = (unsigned char*)d_ws; a.pad = 0;
    if (MK_N_LAUNCHES == 1) {
        a.ph_lo = 0; a.ph_hi = N_PHASES; a.li = 0;
        hipLaunchKernelGGL(fwd_kernel, dim3(grid), dim3(NTHR), LDS_BYTES, stream, a);
    } else {
        for (int li = 0; li < N_PHASES; ++li) { a.ph_lo = li; a.ph_hi = li + 1; a.li = 0;
            hipLaunchKernelGGL(fwd_kernel, dim3(grid), dim3(NTHR), LDS_BYTES, stream, a); }
    }
    const hipError_t le = hipPeekAtLastError();
    if (le != hipSuccess) fprintf(stderr, "kernel_launch: launch failed: %s\n", hipGetErrorName(le));
}
```

```cpp
#include <hip/hip_runtime.h>
#include <cstdio>
#include <cstdint>


#ifndef MK_N_LAUNCHES
#define MK_N_LAUNCHES 1
#endif

#define GAS __attribute__((address_space(1)))
#define LAS __attribute__((address_space(3)))
typedef unsigned short bf16;
typedef unsigned v4u __attribute__((ext_vector_type(4)));
typedef unsigned v2u __attribute__((ext_vector_type(2)));
typedef float f32x4 __attribute__((ext_vector_type(4)));
typedef float f32x2 __attribute__((ext_vector_type(2)));
typedef short bf16x8 __attribute__((ext_vector_type(8)));
typedef __bf16 v2bf __attribute__((ext_vector_type(2)));
typedef int v4i __attribute__((ext_vector_type(4)));
typedef int v8i __attribute__((ext_vector_type(8)));

constexpr int NB = 8, SEQ = 2048, DM = 2048, T = NB * SEQ, LC = 256, TC = NB * LC;
constexpr int GW = 64, DC = 1024, NH = 8, HD = 128;
constexpr int NPROJ = 6144, QOFF = 3072, KOFF = 4096, VOFF = 5120;
constexpr int NE = 64, FE = 512, NSLOT = 9;
constexpr float EPS = 1e-6f;
constexpr int NWAVES = 8, NTHR = 512;
constexpr int LIST_CAP = 16384;
constexpr int MAX_TILES = 640;

constexpr size_t MiB = 1u << 20;
constexpr size_t WS_CTL = 0, CTL_ZERO_BYTES = 1 * MiB;
constexpr size_t WS_MOD = 1 * MiB;
constexpr size_t WS_ROPE = 1 * MiB + 512 * 1024;
constexpr size_t WS_RS2 = 1 * MiB + 768 * 1024;
constexpr size_t WS_SSQ = 2 * MiB;
constexpr size_t WS_LIST = 4 * MiB;
constexpr size_t WS_WRH = 13 * MiB, WS_WRL = 13 * MiB + 256 * 1024;
constexpr size_t WS_WDN = 14 * MiB;
constexpr size_t WS_YL = 144 * MiB;
constexpr size_t WS_HID = 208 * MiB;
constexpr size_t WS_WGU = 368 * MiB;
constexpr size_t WS_WIN = 628 * MiB;
constexpr size_t WS_WOUT = 652 * MiB;
constexpr size_t WS_HL = 660 * MiB;
constexpr size_t WS_HC = 724 * MiB;
constexpr size_t WS_KVC = 732 * MiB;
constexpr size_t WS_PROJ = 740 * MiB;
constexpr size_t WS_H2LO = 740 * MiB;
constexpr size_t WS_Y = 932 * MiB;
constexpr size_t WS_H2Q = 932 * MiB;
constexpr size_t WS_SLOT = 368 * MiB;
constexpr size_t WS_TOK = 1008 * MiB;
constexpr size_t WS_END = 1009 * MiB;
static_assert(WS_SLOT + (size_t)MAX_TILES * 256 * DM <= WS_TOK, "slot buffer");
constexpr int CW_BAR = 4096;
constexpr int CW_CNT = 65536;

constexpr int RING_BYTES = 131072;
constexpr int MISC_OFF = RING_BYTES;
constexpr int BARW_OFF = 163840 - 64;
constexpr int LDS_BYTES = 163840;

#define RLX_AGENT __ATOMIC_RELAXED, __HIP_MEMORY_SCOPE_AGENT
#define LDS_WAIT() asm volatile("s_waitcnt lgkmcnt(0)" ::: "memory")
#define VM_WAIT() asm volatile("s_waitcnt vmcnt(0)" ::: "memory")
__device__ __forceinline__ unsigned cvt_pk_bf16(float lo, float hi) { unsigned r; asm volatile("v_cvt_pk_bf16_f32 %0, %1, %2" : "=v"(r) : "v"(lo), "v"(hi)); return r; }
__device__ __forceinline__ float u2f(unsigned u) { return __builtin_bit_cast(float, u); }
__device__ __forceinline__ float bf_lo(unsigned u) { return __builtin_bit_cast(float, u << 16); }
__device__ __forceinline__ float bf_hi(unsigned u) { return __builtin_bit_cast(float, u & 0xffff0000u); }
__device__ __forceinline__ float clamp448(float v) { return fminf(fmaxf(v, -448.0f), 448.0f); }
__device__ __forceinline__ unsigned pack4_fp8(float a, float b, float c, float d) {
    int p = __builtin_amdgcn_cvt_pk_fp8_f32(a, b, 0, false); p = __builtin_amdgcn_cvt_pk_fp8_f32(c, d, p, true); return (unsigned)p; }
__device__ __forceinline__ float wave_sum(float v) {
#pragma unroll
    for (int o = 1; o < 64; o <<= 1) v += __shfl_xor(v, o);
    return v;
}
__device__ __forceinline__ float wave_max(float v) {
#pragma unroll
    for (int o = 1; o < 64; o <<= 1) v = fmaxf(v, __shfl_xor(v, o));
    return v;
}
__device__ __forceinline__ float silu_f(float v) { return v / (1.0f + expf(-v)); }

#define XB_TMO      128
#define XB_XCNT(j)  (256  + 64 * (j))
#define XB_XSUB(j)  (1280 + 64 * (j))
#define XB_XGEN(j)  (2304 + 64 * (j))
#define XB_TOP      3328
#define XB_TOPGEN   3392
#define XCD_BAR_WORDS 3456
#define XB_SPIN_CAP (1u << 18)
__device__ __forceinline__ unsigned xb_ld(unsigned* p)              { return __hip_atomic_load(p, __ATOMIC_RELAXED, __HIP_MEMORY_SCOPE_AGENT); }
__device__ __forceinline__ unsigned xb_add(unsigned* p, unsigned v) { return __hip_atomic_fetch_add(p, v, __ATOMIC_RELAXED, __HIP_MEMORY_SCOPE_AGENT); }
__device__ __forceinline__ unsigned xb_xcc_id() { return (unsigned)__builtin_amdgcn_s_getreg((3 << 11) | 20) & 0xFu; }
#define XB_SPIN(cond, bar) do { unsigned _sp = 0; while (cond) { __builtin_amdgcn_s_sleep(1); \
    if ((++_sp & 255u) == 0u) { if (xb_ld(&(bar)[XB_TMO])) break; if (_sp > XB_SPIN_CAP) { atomicAdd(&(bar)[XB_TMO], 1u); break; } } } } while (0)
struct XcdBarrier { unsigned* bar; unsigned x; volatile LAS unsigned* st; };
__device__ __forceinline__ XcdBarrier xcd_barrier_post(unsigned* bar, volatile LAS unsigned* st) {
    XcdBarrier b; b.bar = bar; b.x = xb_xcc_id(); b.st = st;
    if (threadIdx.x == 0) (void)xb_add(&bar[XB_XCNT(b.x)], 1u);
    return b;
}
__device__ __forceinline__ void xcd_barrier_complete(unsigned* bar, unsigned x, unsigned& nloc, unsigned& nx) {
    const unsigned G = gridDim.x * gridDim.y * gridDim.z;
    unsigned sum, cnt, mine, sp = 0u;
    for (;;) {
        sum = 0u; cnt = 0u; mine = 0u;
#pragma unroll
        for (unsigned j = 0; j < 16; ++j) { const unsigned c = xb_ld(&bar[XB_XCNT(j)]); sum += c; cnt += (c > 0u) ? 1u : 0u; mine = (j == x) ? c : mine; }
        if (sum == G) break;
        __builtin_amdgcn_s_sleep(1);
        if ((++sp & 255u) == 0u) { if (xb_ld(&bar[XB_TMO])) break; if (sp > XB_SPIN_CAP) { atomicAdd(&bar[XB_TMO], 1u); break; } }
    }
    nloc = mine > 0u ? mine : 1u; nx = cnt > 0u ? cnt : 1u;
}
__device__ __forceinline__ void xcd_barrier(const XcdBarrier& b) {
    asm volatile("s_waitcnt vmcnt(0)" ::: "memory");
    __syncthreads();
    if (threadIdx.x == 0) {
        unsigned* bar = b.bar;
        __builtin_amdgcn_s_waitcnt(0);
        unsigned nloc = b.st[0], nx = b.st[1];
        if (nloc == 0u) { xcd_barrier_complete(bar, b.x, nloc, nx); b.st[0] = nloc; b.st[1] = nx; }
        const unsigned old = xb_add(&bar[XB_XSUB(b.x)], 1u);
        const unsigned gen = old / nloc;
        if (old + 1u == (gen + 1u) * nloc) {
            __builtin_amdgcn_fence(__ATOMIC_RELEASE, "agent");
            asm volatile("s_waitcnt vmcnt(0)" ::: "memory");
            const unsigned og = xb_add(&bar[XB_TOP], 1u);
            const unsigned tg = og / nx;
            if (og + 1u == (tg + 1u) * nx) xb_add(&bar[XB_TOPGEN], 1u);
            else XB_SPIN(xb_ld(&bar[XB_TOPGEN]) == tg, bar);
            __builtin_amdgcn_fence(__ATOMIC_ACQUIRE, "agent");
            xb_add(&bar[XB_XGEN(b.x)], 1u);
            asm volatile("s_waitcnt vmcnt(0)" ::: "memory");
        } else {
            XB_SPIN(xb_ld(&bar[XB_XGEN(b.x)]) == gen, bar);
            __builtin_amdgcn_fence(__ATOMIC_ACQUIRE, "agent");
            asm volatile("s_waitcnt vmcnt(0)" ::: "memory");
        }
    }
    __syncthreads();
}

namespace pg8 {
constexpr int BM = 256, BK = 64, HALF = 128, HTB = HALF * BK * 2, STAGE_BYTES = 8 * HTB;
__host__ __device__ __forceinline__ int lds_byte(int r, int c) { const int st = (r >> 4) * 2 + (c >> 5), rr = r & 15, cc = c & 31, ob = rr * 64 + cc * 2; return st * 1024 + (ob ^ (((ob >> 9) & 1) << 5)); }
__host__ __device__ __forceinline__ void stage_rc(int b, int& R, int& C) { const int st = b / 1024, sb = b % 1024, swz = sb ^ (((sb >> 9) & 1) << 5); R = (st >> 1) * 16 + swz / 64; C = (st & 1) * 32 + (swz % 64) / 2; }
__host__ __device__ __forceinline__ int perm32(int rho) { const int n = rho >> 4, i = rho & 15; return 8 * (i >> 2) + 4 * n + (i & 3); }
struct Unit { int pm, pn, g; };

__device__ __forceinline__ int round_unit(int i, int G, int c, int total) {
    const int base = i * G; if (base + c >= total && (total - base) >= G) return -1;
    const int R = (total - base) < G ? (total - base) : G;
    if (R <= 0) return -1;
    if (R == G && (G & 7) == 0) return base + (c & 7) * (G >> 3) + (c >> 3);
    return c < R ? base + c : -1;
}

template <class P>
__device__ __forceinline__ void gemm_phase(LAS unsigned char* lds, const P& p) {
    constexpr int KB = P::KB, nt = KB / (BK * 2);
    const int tid = threadIdx.x, wid = __builtin_amdgcn_readfirstlane(tid >> 6), lane = tid & 63, wr = wid >> 2, wc = wid & 3, fr = lane & 15, fq = lane >> 4;
    unsigned voffB[2], voffA[2];
#pragma unroll
    for (int i = 0; i < 2; ++i) { int R, C; stage_rc(tid * 16 + i * 8192, R, C); const int Rb = P::PERM ? ((R & ~31) + perm32(R & 31)) : R;
        voffA[i] = (unsigned)(R * KB + C * 2); voffB[i] = (unsigned)(Rb * KB + C * 2); }
    LAS unsigned* goffs = (LAS unsigned*)(lds + STAGE_BYTES + 1024);
    constexpr size_t kstep = (size_t)(BK * 2);
    constexpr size_t hstep = (size_t)HALF * KB;
    const unsigned ldsw = (unsigned)wid * 1024u;
    const int aoff = lds_byte(wr * 64 + fr, fq * 8), boff = lds_byte(wc * 32 + fr, fq * 8);
#define PG8_SA(b, h) (((b) * 2 + (h)) * HTB)
#define PG8_SB(b, h) ((4 + (b) * 2 + (h)) * HTB)
#define PG8_STAGE(bufoff, gbase, voff) do { _Pragma("unroll") for (int _i = 0; _i < 2; ++_i) \
        __builtin_amdgcn_global_load_lds((const unsigned*)((const char*)(gbase) + (voff)[_i]), (LAS unsigned*)(lds + (bufoff) + ldsw + _i * 8192), 16, 0, 0); } while (0)
#define PG8_STAGE_A(bufoff, h, nextu, kb) do { if constexpr (P::GATHER) { \
            _Pragma("unroll") for (int _i = 0; _i < 2; ++_i) { const unsigned _o = goffs[((((nextu) ? ui + 1 : ui) & 1) * 4 + (h) * 2 + _i) * 512 + tid]; \
                __builtin_amdgcn_global_load_lds((const unsigned*)(gA + (kb) + _o), (LAS unsigned*)(lds + (bufoff) + ldsw + _i * 8192), 16, 0, 0); } } \
        else { const char* _b = ((nextu) ? nA : cA) + (h) * hstep + (kb); PG8_STAGE(bufoff, _b, voffA); } } while (0)
#define PG8_RD2(p) __builtin_shufflevector(*(const LAS v4i*)(p), *(const LAS v4i*)((p) + 1024), 0, 1, 2, 3, 4, 5, 6, 7)
#define PG8_LDA(dst, b, h) do { _Pragma("unroll") for (int m = 0; m < 4; ++m) dst[m] = PG8_RD2(lds + PG8_SA(b, h) + aoff + m * 2048); } while (0)
#define PG8_LDB(dst, b, h) do { _Pragma("unroll") for (int n = 0; n < 2; ++n) dst[n] = PG8_RD2(lds + PG8_SB(b, h) + boff + n * 2048); } while (0)
#define PG8_LO(x) __builtin_bit_cast(bf16x8, __builtin_shufflevector((x), (x), 0, 1, 2, 3))
#define PG8_HI(x) __builtin_bit_cast(bf16x8, __builtin_shufflevector((x), (x), 4, 5, 6, 7))
#define PG8_MMA(ai, bj, At, Bt) do { __builtin_amdgcn_s_setprio(1); if constexpr (P::FP8) { _Pragma("unroll") for (int m = 0; m < 4; ++m) _Pragma("unroll") for (int n = 0; n < 2; ++n) \
            asm volatile("v_mfma_scale_f32_16x16x128_f8f6f4 %0, %1, %2, %0, %3, %4 op_sel_hi:[0,0,0]" : "+v"(acc[ai][bj][m][n]) : "v"(Bt[n]), "v"(At[m]), "v"(n == 0 ? sclB : sclB1), "v"(sclA)); } \
        else { _Pragma("unroll") for (int m = 0; m < 4; ++m) _Pragma("unroll") for (int n = 0; n < 2; ++n) { \
            acc[ai][bj][m][n] = __builtin_amdgcn_mfma_f32_16x16x32_bf16(PG8_LO(Bt[n]), PG8_LO(At[m]), acc[ai][bj][m][n], 0, 0, 0); \
            acc[ai][bj][m][n] = __builtin_amdgcn_mfma_f32_16x16x32_bf16(PG8_HI(Bt[n]), PG8_HI(At[m]), acc[ai][bj][m][n], 0, 0, 0); } } __builtin_amdgcn_s_setprio(0); } while (0)
#define PG8_WAIT_V(n) asm volatile("s_waitcnt vmcnt(" #n ")" ::: "memory")
#define PG8_WAIT_L(n) asm volatile("s_waitcnt lgkmcnt(" #n ")" ::: "memory")
#define PG8_BAR __builtin_amdgcn_s_barrier()
#define PG8_SCHED __builtin_amdgcn_sched_barrier(0)
    Unit cur, nxt; int ui = 0;
    if (!p.next(0, cur)) return;
    f32x4 acc[2][2][4][2];
#pragma unroll
    for (int a = 0; a < 2; ++a)
#pragma unroll
        for (int b = 0; b < 2; ++b)
#pragma unroll
            for (int m = 0; m < 4; ++m)
#pragma unroll
                for (int n = 0; n < 2; ++n) acc[a][b][m][n] = (f32x4){0.f, 0.f, 0.f, 0.f};
    v8i At[4], B0[2], B1[2];
    int sclA = P::SCALE_A, sclB = P::SCALE_B, sclB1 = P::SCALE_B1; if constexpr (P::FP8) { asm volatile("" : "+v"(sclA), "+v"(sclB), "+v"(sclB1)); }
    const char* cA = p.a_base(cur); const char* cB = p.b_base(cur);
    const char* nA = cA; const char* gA = cA;
    if constexpr (P::GATHER) { p.rows(cur, tid, goffs); p.rows(cur, tid, goffs + 4 * 512); }
    PG8_STAGE(PG8_SB(0, 0), cB, voffB); PG8_STAGE(PG8_SB(0, 1), cB + hstep, voffB); PG8_STAGE_A(PG8_SA(0, 0), 0, false, 0); PG8_STAGE_A(PG8_SA(0, 1), 1, false, 0);
    if (wr == 1) PG8_BAR;
    PG8_WAIT_V(2); PG8_BAR;
    PG8_STAGE(PG8_SB(1, 0), cB + kstep, voffB); PG8_STAGE_A(PG8_SA(1, 0), 0, false, kstep); PG8_STAGE(PG8_SB(1, 1), cB + hstep + kstep, voffB);
    PG8_WAIT_V(6); PG8_BAR;
    for (;;) {
        const bool has_next = p.next(ui + 1, nxt);
        nA = has_next ? p.a_base(nxt) : cA; const char* nB = has_next ? p.b_base(nxt) : cB;
        if constexpr (P::GATHER) { p.rows(has_next ? nxt : cur, tid, goffs + ((ui + 1) & 1) * 4 * 512); }
#pragma unroll 1
        for (int t = 0; t < nt; t += 2) {
            const bool last = (t == nt - 2);
            const size_t k1 = (size_t)(t + 1) * kstep;
            const size_t k2 = last ? 0 : (size_t)(t + 2) * kstep;
            const char* b2 = last ? nB : cB + (size_t)(t + 2) * kstep;
            const size_t k3 = k2 + kstep; const char* b3 = b2 + kstep;
            const bool relax = (P::EPI_STORES > 0) && (t == 0) && (ui > 0);
            PG8_LDB(B0, 0, 0); PG8_LDB(B1, 0, 1); PG8_SCHED; PG8_LDA(At, 0, 0); PG8_STAGE_A(PG8_SA(1, 1), 1, false, k1);
            if (relax) { asm volatile("s_waitcnt vmcnt(%0)" :: "n"(8 + P::EPI_STORES) : "memory"); } else { PG8_WAIT_V(8); } PG8_WAIT_L(0); PG8_BAR; PG8_MMA(0, 0, At, B0); PG8_MMA(0, 1, At, B1); PG8_BAR; PG8_SCHED;
            PG8_LDA(At, 0, 1); PG8_STAGE(PG8_SB(0, 0), b2, voffB); PG8_STAGE(PG8_SB(0, 1), b2 + hstep, voffB); PG8_STAGE_A(PG8_SA(0, 0), 0, last, k2);
            if (relax) { asm volatile("s_waitcnt vmcnt(%0)" :: "n"(8 + P::EPI_STORES) : "memory"); } else { PG8_WAIT_V(8); } PG8_WAIT_L(0); PG8_BAR; PG8_MMA(1, 0, At, B0); PG8_MMA(1, 1, At, B1); PG8_BAR; PG8_SCHED;
            PG8_LDB(B0, 1, 0); PG8_LDB(B1, 1, 1); PG8_SCHED; PG8_LDA(At, 1, 0); PG8_STAGE_A(PG8_SA(0, 1), 1, last, k2);
            PG8_WAIT_V(8); PG8_WAIT_L(0); PG8_BAR; PG8_MMA(0, 0, At, B0); PG8_MMA(0, 1, At, B1); PG8_BAR; PG8_SCHED;
            PG8_LDA(At, 1, 1); PG8_STAGE(PG8_SB(1, 0), b3, voffB); PG8_STAGE(PG8_SB(1, 1), b3 + hstep, voffB); PG8_STAGE_A(PG8_SA(1, 0), 0, last, k3);
            PG8_WAIT_V(8); PG8_WAIT_L(0); PG8_BAR; PG8_MMA(1, 0, At, B0); PG8_MMA(1, 1, At, B1); PG8_BAR; PG8_SCHED;
        }
        if (wr == 0) PG8_BAR;
        if constexpr (P::FP8) { asm volatile("s_nop 15\n\ts_nop 15" ::: "memory"); }
        { int tz = threadIdx.x; asm volatile("" : "+v"(tz));
          const int ewid = tz >> 6, elane = tz & 63; p.epi(acc, cur, ewid >> 2, ewid & 3, elane & 15, elane >> 4); }
        if (!has_next) break;
#pragma unroll
        for (int a = 0; a < 2; ++a)
#pragma unroll
            for (int b = 0; b < 2; ++b)
#pragma unroll
                for (int m = 0; m < 4; ++m)
#pragma unroll
                    for (int n = 0; n < 2; ++n) acc[a][b][m][n] = (f32x4){0.f, 0.f, 0.f, 0.f};
        cur = nxt; cA = nA; cB = nB; ++ui;
        if (wr == 1) PG8_BAR;
    }
    PG8_WAIT_V(0);
    PG8_BAR;
#undef PG8_SA
#undef PG8_SB
#undef PG8_STAGE
#undef PG8_STAGE_A
#undef PG8_LDA
#undef PG8_LDB
#undef PG8_MMA
#undef PG8_LO
#undef PG8_HI
#undef PG8_RD2
#undef PG8_WAIT_V
#undef PG8_WAIT_L
#undef PG8_BAR
#undef PG8_SCHED
}
}

struct KArgs { const float* in[25]; float* out; unsigned char* ws; int ph_lo, ph_hi, li, pad; };
typedef const KArgs __attribute__((address_space(4))) CKArgs;
struct Frame {
    LAS unsigned char* lds;
    int tid, lane, wave, G, bid;
    CKArgs* ka;
    unsigned char* ws;
};
#define FIN(i) (F.ka->in[i])
#define FOUT (F.ka->out)
enum { I_X = 0, I_C, I_CTX, I_CCTX, I_WMOD, I_BMOD, I_GPREMIX, I_GPOSTMIX, I_GPREFFN, I_GPOSTFFN, I_WIN, I_CONVW, I_CONVB, I_RPB, I_GCONV, I_GATTN, I_WOUT, I_WROUTER, I_RBIAS,
       I_WEG, I_WEU, I_WED, I_WSG, I_WSU, I_WSD };

template <class RowMap>
__device__ __forceinline__ void transpose_item(const float* W, int ldn, int K, bf16* WT, LAS float* scr, int kb, int nb, int lane, const RowMap& rm) {
    const int k0 = 64 * kb, n0 = 64 * nb;
    f32x4 v[16];
#pragma unroll
    for (int i = 0; i < 16; ++i) v[i] = *(const GAS f32x4*)(W + (size_t)(k0 + 4 * i + (lane >> 4)) * ldn + n0 + 4 * (lane & 15));
#pragma unroll
    for (int i = 0; i < 16; ++i) { LAS float* d = scr + (4 * i + (lane >> 4)) * 65 + 4 * (lane & 15); d[0] = v[i].x; d[1] = v[i].y; d[2] = v[i].z; d[3] = v[i].w; }
    LDS_WAIT(); asm volatile("" ::: "memory");
    const int c = lane & 7;
#pragma unroll
    for (int j = 0; j < 8; ++j) { const int n = (lane >> 3) + 8 * j; const LAS float* s = scr + (8 * c) * 65 + n;
        v4u o; o.x = cvt_pk_bf16(s[0 * 65], s[1 * 65]); o.y = cvt_pk_bf16(s[2 * 65], s[3 * 65]); o.z = cvt_pk_bf16(s[4 * 65], s[5 * 65]); o.w = cvt_pk_bf16(s[6 * 65], s[7 * 65]);
        *(GAS v4u*)(WT + (size_t)rm(n0 + n) * K + k0 + 8 * c) = o; }
    LDS_WAIT(); asm volatile("" ::: "memory");
}
template <class RowMap>
__device__ __forceinline__ void transpose_item_fp8(const float* W, int ldn, int KBrow, unsigned char* WT, LAS float* scr, int kb, int nb, int lane, const RowMap& rm, float scale) {
    const int k0 = 64 * kb, n0 = 64 * nb;
    f32x4 v[16];
#pragma unroll
    for (int i = 0; i < 16; ++i) v[i] = *(const GAS f32x4*)(W + (size_t)(k0 + 4 * i + (lane >> 4)) * ldn + n0 + 4 * (lane & 15));
#pragma unroll
    for (int i = 0; i < 16; ++i) { LAS float* d = scr + (4 * i + (lane >> 4)) * 65 + 4 * (lane & 15); d[0] = v[i].x * scale; d[1] = v[i].y * scale; d[2] = v[i].z * scale; d[3] = v[i].w * scale; }
    LDS_WAIT(); asm volatile("" ::: "memory");
    const int c = lane & 3;
#pragma unroll
    for (int j = 0; j < 4; ++j) { const int n = (lane >> 2) + 16 * j; const LAS float* s = scr + (16 * c) * 65 + n;
        v4u o; o.x = pack4_fp8(s[0 * 65], s[1 * 65], s[2 * 65], s[3 * 65]); o.y = pack4_fp8(s[4 * 65], s[5 * 65], s[6 * 65], s[7 * 65]);
        o.z = pack4_fp8(s[8 * 65], s[9 * 65], s[10 * 65], s[11 * 65]); o.w = pack4_fp8(s[12 * 65], s[13 * 65], s[14 * 65], s[15 * 65]);
        *(GAS v4u*)(WT + (size_t)rm(n0 + n) * KBrow + k0 + 16 * c) = o; }
    LDS_WAIT(); asm volatile("" ::: "memory");
}
struct RmIdent { int off; __device__ __forceinline__ int operator()(int n) const { return off + n; } };
struct RmWin {
    __device__ __forceinline__ int operator()(int n) const {
        if (n < QOFF || n >= VOFF) return n;
        const int nn = n & 127, axis = nn >> 6, half = (nn >> 5) & 1, f = nn & 31;
        return (n - nn) + 2 * (axis * 32 + f) + half; }
};
struct RmGU { int base; int up; __device__ __forceinline__ int operator()(int f) const { return base + 32 * (f >> 4) + 16 * up + (f & 15); } };

constexpr int NF8 = 195 * 256;
constexpr int CONV_SCR = 17024;
__device__ __forceinline__ void conv_fp8_items(Frame& F, int it_lo, int it_hi, int gw, int NGW) {
    LAS float* scr = (LAS float*)(F.lds + F.wave * CONV_SCR);
    LAS unsigned long long* ptab = (LAS unsigned long long*)(F.lds + 8 * CONV_SCR);
    __syncthreads();
    if (F.tid == 0) { ptab[0] = (unsigned long long)FIN(I_WEG); ptab[1] = (unsigned long long)FIN(I_WEU); ptab[2] = (unsigned long long)FIN(I_WED);
        ptab[3] = (unsigned long long)FIN(I_WSG); ptab[4] = (unsigned long long)FIN(I_WSU); ptab[5] = (unsigned long long)FIN(I_WSD); }
    __syncthreads();
    const int lr = F.lane >> 3, lc = 4 * (F.lane & 7);
    f32x4 v[16], vn[16];
#define F8_DECODE(it_, kind_, e_, isdn_, k0_, n0_) const int _mi = (it_) >> 8, _q = (it_) & 255; const int kind_ = _mi < 192 ? (_mi >> 6) : (_mi - 189); const int e_ = _mi < 192 ? (_mi & 63) : 0; \
    const bool isdn_ = (kind_ == 2 || kind_ == 5); const int k0_ = 128 * (isdn_ ? (_q >> 6) : (_q >> 4)), n0_ = 32 * (isdn_ ? (_q & 63) : (_q & 15));
#define F8_LOAD(dst_, it_) do { F8_DECODE(it_, _kind, _e, _isdn, _k0, _n0) const float* _W = (const float*)ptab[_kind] + (size_t)_e * DM * FE; const int _ldn = _isdn ? DM : FE; \
    _Pragma("unroll") for (int i = 0; i < 16; ++i) dst_[i] = __builtin_nontemporal_load((const GAS f32x4*)(_W + (size_t)(_k0 + 8 * i + lr) * _ldn + _n0 + lc)); } while (0)
    f32x4 vnn[16];
    int it = it_lo + gw;
    if (it < it_hi) F8_LOAD(v, it);
    if (it + NGW < it_hi) F8_LOAD(vn, it + NGW);
    for (; it < it_hi; it += NGW) {
        const int itn = it + 2 * NGW;
        if (itn < it_hi) F8_LOAD(vnn, itn);
        {
            F8_DECODE(it, kind, e, isdn, k0, n0)
            const float scale = isdn ? 32.0f : 64.0f; const int KBrow = isdn ? FE : DM; unsigned char* WT = isdn ? (F.ws + WS_WDN) : (F.ws + WS_WGU);
            const int ee = kind < 3 ? e : 64; const int up = (kind == 1 || kind == 4) ? 16 : 0;
#pragma unroll
            for (int i = 0; i < 16; ++i) { LAS float* d = scr + (8 * i + lr) * 33 + (i >> 1) * 4 + lc; d[0] = v[i].x * scale; d[1] = v[i].y * scale; d[2] = v[i].z * scale; d[3] = v[i].w * scale; }
            LDS_WAIT(); asm volatile("" ::: "memory");
            const int c = F.lane >> 3;
#pragma unroll
            for (int j = 0; j < 4; ++j) { const int n = (F.lane & 7) + 8 * j; const LAS float* sp = scr + (16 * c) * 33 + 4 * c + n; const int nn = n0 + n;
                const int drow = isdn ? (ee * 2048 + (nn & ~255) + 128 * ((nn >> 3) & 1) + 32 * ((nn >> 6) & 3) + 16 * ((nn >> 2) & 1) + 4 * ((nn >> 4) & 3) + (nn & 3))
                                      : (ee * 1024 + 2 * (nn & ~127) + 128 * ((nn >> 2) & 1) + 32 * ((nn >> 5) & 3) + up + 4 * ((nn >> 3) & 3) + (nn & 3));
                v4u o; o.x = pack4_fp8(sp[0 * 33], sp[1 * 33], sp[2 * 33], sp[3 * 33]); o.y = pack4_fp8(sp[4 * 33], sp[5 * 33], sp[6 * 33], sp[7 * 33]);
                o.z = pack4_fp8(sp[8 * 33], sp[9 * 33], sp[10 * 33], sp[11 * 33]); o.w = pack4_fp8(sp[12 * 33], sp[13 * 33], sp[14 * 33], sp[15 * 33]);
                __builtin_nontemporal_store(o, (GAS v4u*)(WT + (size_t)drow * KBrow + k0 + 16 * c)); }
            LDS_WAIT(); asm volatile("" ::: "memory");
        }
#pragma unroll
        for (int i = 0; i < 16; ++i) { v[i] = vn[i]; vn[i] = vnn[i]; }
    }
#undef F8_DECODE
#undef F8_LOAD
}

constexpr int NITB = 32 * 96 + 32 * 32;
__device__ __forceinline__ void conv_bf16_items(Frame& F, int it_lo, int it_hi, int gw, int NGW) {
    LAS float* scr = (LAS float*)(F.lds + F.wave * CONV_SCR);
    LAS unsigned long long* ptab = (LAS unsigned long long*)(F.lds + 8 * CONV_SCR);
    __syncthreads();
    if (F.tid == 0) { ptab[0] = (unsigned long long)FIN(I_WIN); ptab[1] = (unsigned long long)FIN(I_WOUT); }
    __syncthreads();
    constexpr int IT_IN = 32 * 96;
    f32x4 v[16], vn[16];
#define B16_DECODE(it_, isout_, k0_, n0_, ldn_) const bool isout_ = (it_) >= IT_IN; const int _r = isout_ ? (it_) - IT_IN : (it_); const int ldn_ = isout_ ? DM : NPROJ; \
    const int k0_ = 64 * (isout_ ? (_r >> 5) : (_r / 96)), n0_ = 64 * (isout_ ? (_r & 31) : (_r % 96));
#define B16_LOAD(dst_, it_) do { B16_DECODE(it_, _io, _k0, _n0, _ldn) const float* _W = (const float*)ptab[_io ? 1 : 0]; \
    _Pragma("unroll") for (int i = 0; i < 16; ++i) dst_[i] = *(const GAS f32x4*)(_W + (size_t)(_k0 + 4 * i + (F.lane >> 4)) * _ldn + _n0 + 4 * (F.lane & 15)); } while (0)
    int it = it_lo + gw;
    if (it < it_hi) B16_LOAD(v, it);
    for (; it < it_hi; it += NGW) {
        if (it + NGW < it_hi) B16_LOAD(vn, it + NGW);
        {
            B16_DECODE(it, isout, k0, n0, ldn)
            bf16* WT = (bf16*)(F.ws + (isout ? WS_WOUT : WS_WIN));
#pragma unroll
            for (int i = 0; i < 16; ++i) { LAS float* d = scr + (4 * i + (F.lane >> 4)) * 65 + 4 * (F.lane & 15); d[0] = v[i].x; d[1] = v[i].y; d[2] = v[i].z; d[3] = v[i].w; }
            LDS_WAIT(); asm volatile("" ::: "memory");
            const int c = F.lane & 7;
#pragma unroll
            for (int j = 0; j < 8; ++j) { const int n = (F.lane >> 3) + 8 * j; const LAS float* sp = scr + (8 * c) * 65 + n;
                const int nn = n0 + n; const int drow = isout ? nn : RmWin{}(nn);
                v4u o; o.x = cvt_pk_bf16(sp[0 * 65], sp[1 * 65]); o.y = cvt_pk_bf16(sp[2 * 65], sp[3 * 65]); o.z = cvt_pk_bf16(sp[4 * 65], sp[5 * 65]); o.w = cvt_pk_bf16(sp[6 * 65], sp[7 * 65]);
                *(GAS v4u*)(WT + (size_t)drow * DM + k0 + 8 * c) = o; }
            LDS_WAIT(); asm volatile("" ::: "memory");
        }
#pragma unroll
        for (int i = 0; i < 16; ++i) v[i] = vn[i];
    }
#undef B16_DECODE
#undef B16_LOAD
}

#ifndef P0_MOD_WGS
#define P0_MOD_WGS 192
#endif
#ifndef P0_B16_STAGE1
#define P0_B16_STAGE1 2560
#endif
__device__ __forceinline__ void p0_prologue(Frame& F) {
    const int gw = F.bid * NWAVES + F.wave, NGW = F.G * NWAVES;
    if (F.tid < 8) {
        GAS f32x2* rope = (GAS f32x2*)(F.ws + WS_ROPE);
        for (int i = F.bid * 8 + F.tid; i < 64 * 32; i += F.G * 8) { const int pos = i >> 5, f = i & 31;
            const float inv = powf(10000.0f, -(float)f / 32.0f); const float ang = (float)pos * inv;
            rope[i] = (f32x2){(float)cos((double)ang), (float)sin((double)ang)}; }
    }
    {
        const int idx = F.bid * NTHR + F.tid;
        if (idx < DM * NE) { const int k = idx >> 6, n = idx & 63; const float v = FIN(I_WROUTER)[idx];
            const unsigned hi = cvt_pk_bf16(v, 0.f) & 0xffffu; const float rem = v - bf_lo(hi);
            ((bf16*)(F.ws + WS_WRH))[(size_t)n * DM + k] = (bf16)hi; ((bf16*)(F.ws + WS_WRL))[(size_t)n * DM + k] = (bf16)(cvt_pk_bf16(rem, 0.f) & 0xffffu); }
    }
    if (F.bid < P0_MOD_WGS) {
        LAS float* act = (LAS float*)F.lds;
        LAS float* red = (LAS float*)(F.lds + 9 * 2048 * 4);
        for (int i = F.tid; i < 9 * 2048; i += NTHR) { const int r = i >> 11, k = i & 2047; const float v = r < 8 ? FIN(I_C)[r * 2048 + k] : FIN(I_CCTX)[k]; act[i] = silu_f(v); }
        __syncthreads();
        const float* wm = FIN(I_WMOD);
        for (int cb = F.bid; cb < 192; cb += P0_MOD_WGS) {
            const int kq = F.wave * 4 + (F.lane >> 4), cq = F.lane & 15;
            f32x4 a[9];
#pragma unroll
            for (int r = 0; r < 9; ++r) a[r] = (f32x4){0.f, 0.f, 0.f, 0.f};
            for (int kb = kq; kb < 2048; kb += 512) {
                f32x4 w[16];
#pragma unroll
                for (int u = 0; u < 16; ++u) w[u] = *(const GAS f32x4*)(wm + (size_t)(kb + 32 * u) * 12288 + cb * 64 + cq * 4);
#pragma unroll
                for (int u = 0; u < 16; ++u)
#pragma unroll
                    for (int r = 0; r < 9; ++r) a[r] += w[u] * act[r * 2048 + kb + 32 * u]; }
#pragma unroll
            for (int r = 0; r < 9; ++r) { f32x4 s = a[r];
#pragma unroll
                for (int o = 16; o < 64; o <<= 1) { f32x4 t; t.x = __shfl_xor(s.x, o); t.y = __shfl_xor(s.y, o); t.z = __shfl_xor(s.z, o); t.w = __shfl_xor(s.w, o); s += t; }
                if (F.lane < 16) *(LAS f32x4*)(red + (F.wave * 9 + r) * 64 + F.lane * 4) = s; }
            __syncthreads();
            for (int i = F.tid; i < 9 * 64; i += NTHR) { const int r = i >> 6, cc = i & 63; float s = 0.f;
#pragma unroll
                for (int w = 0; w < 8; ++w) s += red[(w * 9 + r) * 64 + cc];
                ((GAS float*)(F.ws + WS_MOD))[r * 12288 + cb * 64 + cc] = s + FIN(I_BMOD)[cb * 64 + cc]; }
            __syncthreads();
        }
    } else conv_bf16_items(F, 0, P0_B16_STAGE1, (F.bid - P0_MOD_WGS) * NWAVES + F.wave, (F.G - P0_MOD_WGS) * NWAVES);
    conv_bf16_items(F, P0_B16_STAGE1, NITB, gw, NGW);
}

__device__ __forceinline__ void p1_norm(Frame& F, int row_lo, int row_hi, int gw, int NGW) {
    const float* MOD = (const float*)(F.ws + WS_MOD); const float* g = FIN(I_GPREMIX);
    for (int row = row_lo + gw; row < row_hi; row += NGW) {
        const bool lat = row < T; const int rr = lat ? row : row - T;
        const float* xr = (lat ? FIN(I_X) : FIN(I_CTX)) + (size_t)rr * DM;
        const float* md = MOD + (size_t)(lat ? (rr >> 11) : 8) * 12288;
        bf16* orow = (bf16*)(F.ws + (lat ? WS_HL : WS_HC)) + (size_t)rr * DM;
        f32x4 v[8]; float ss = 0.f;
#pragma unroll
        for (int j = 0; j < 8; ++j) { v[j] = *(const GAS f32x4*)(xr + 4 * F.lane + 256 * j); ss += (v[j].x * v[j].x + v[j].y * v[j].y) + (v[j].z * v[j].z + v[j].w * v[j].w); }
        const float rstd = 1.0f / sqrtf(wave_sum(ss) * (1.0f / DM) + EPS);
#pragma unroll
        for (int j = 0; j < 8; ++j) { const int c = 4 * F.lane + 256 * j;
            const f32x4 gg = *(const GAS f32x4*)(g + c), sh = *(const GAS f32x4*)(md + c), sc = *(const GAS f32x4*)(md + 2048 + c);
            const f32x4 o = (v[j] * rstd) * gg * (sc + 1.0f) + sh;
            *(GAS v2u*)(orow + c) = (v2u){cvt_pk_bf16(o.x, o.y), cvt_pk_bf16(o.z, o.w)}; }
    }
}

struct ProbProj {
    static constexpr int K = DM, KB = DM * 2, SCALE_A = 0, SCALE_B = 0, SCALE_B1 = 0, EPI_STORES = 16; static constexpr bool GATHER = false, PERM = true, FP8 = false;
    const bf16 *HL, *HC, *Win; bf16 *PROJ, *KVC; const f32x2* rope; int G, c, base, total;
    static constexpr int NMAIN = 64 * 24;
    __device__ __forceinline__ bool next(int i, pg8::Unit& u) const {
        int w = pg8::round_unit(i, G, c, total); if (w < 0) return false; w += base;
        if (w < NMAIN) { const int gid = w / 192, r = w % 192; u.pm = gid * 8 + (r & 7); u.pn = r >> 3; u.g = 0; }
        else { const int j = w - NMAIN; u.pm = j & 7; u.pn = 16 + (j >> 3); u.g = 1; }
        return true; }
    __device__ __forceinline__ const char* a_base(const pg8::Unit& u) const { return (const char*)HL + (size_t)u.g * (size_t)(WS_HC - WS_HL) + (size_t)u.pm * 256 * K * 2; }
    __device__ __forceinline__ const char* b_base(const pg8::Unit& u) const { return (const char*)Win + (size_t)u.pn * 256 * K * 2; }
    __device__ __forceinline__ void rows(const pg8::Unit&, int, LAS unsigned*) const {}
    __device__ __forceinline__ void epi(const f32x4 (&acc)[2][2][4][2], const pg8::Unit& u, int wr, int wc, int fr, int fq) const {
        const int row0 = u.pm * 256 + wr * 64 + fr;
        const bool rot = (u.g == 0) && (u.pn >= 12) && (u.pn < 20);
        bf16* base = (bf16*)((char*)PROJ + (long)u.g * ((long)WS_KVC - (long)WS_PROJ));
        const int ldc = NPROJ - u.g * (NPROJ - DM), col0 = (u.pn - 16 * u.g) * 256 + wc * 32 + 8 * fq;
        const int p0 = (wc * 32 + 8 * fq) >> 1, axis = p0 >> 5, f0 = p0 & 31;
#pragma unroll
        for (int ai = 0; ai < 2; ++ai)
#pragma unroll
            for (int m = 0; m < 4; ++m) {
                const int row = row0 + ai * 128 + m * 16; bf16* rowp = base + (size_t)row * ldc + col0;
                const int t = row & (SEQ - 1); const int pos = axis ? (t & 63) : (t >> 6);
                const f32x4 csA = *(const GAS f32x4*)(rope + pos * 32 + f0), csB = *(const GAS f32x4*)(rope + pos * 32 + f0 + 2);
                const f32x2 cs0 = (f32x2){csA.x, csA.y}, cs1 = (f32x2){csA.z, csA.w}, cs2 = (f32x2){csB.x, csB.y}, cs3 = (f32x2){csB.z, csB.w};
#pragma unroll
                for (int bj = 0; bj < 2; ++bj) { f32x4 v0 = acc[ai][bj][m][0], v1 = acc[ai][bj][m][1];
                    if (rot) { f32x4 r0, r1;
                        r0.x = v0.x * cs0.x - v0.y * cs0.y; r0.y = v0.y * cs0.x + v0.x * cs0.y;
                        r0.z = v0.z * cs1.x - v0.w * cs1.y; r0.w = v0.w * cs1.x + v0.z * cs1.y;
                        r1.x = v1.x * cs2.x - v1.y * cs2.y; r1.y = v1.y * cs2.x + v1.x * cs2.y;
                        r1.z = v1.z * cs3.x - v1.w * cs3.y; r1.w = v1.w * cs3.x + v1.z * cs3.y; v0 = r0; v1 = r1; }
                    v4u w; w.x = cvt_pk_bf16(v0.x, v0.y); w.y = cvt_pk_bf16(v0.z, v0.w); w.z = cvt_pk_bf16(v1.x, v1.y); w.w = cvt_pk_bf16(v1.z, v1.w);
                    *(GAS v4u*)(rowp + bj * 128) = w; } }
    }
};

__device__ __forceinline__ float dot2bf(unsigned a, unsigned b, float c) { return __builtin_amdgcn_fdot2_f32_bf16(__builtin_bit_cast(v2bf, a), __builtin_bit_cast(v2bf, b), c, false); }
__device__ __forceinline__ void p3_attn_simple(Frame& F) {
    const bf16* PROJ = (const bf16*)(F.ws + WS_PROJ); const bf16* KVC = (const bf16*)(F.ws + WS_KVC); bf16* Y = (bf16*)(F.ws + WS_Y);
    const float* rpb = FIN(I_RPB); const float* gat = FIN(I_GATTN);
    const float scale = 0.08838834764831845f;
    const int per = (T * NH) / F.G;
    for (int i = F.wave; i < per; i += NWAVES) {
        const int task = F.bid * per + i; const int t = task & (SEQ - 1), bh = task >> 11, h = bh & 7, b = bh >> 3;
        const int r = t >> 6, c = t & 63; int r0 = r - 4; r0 = r0 < 0 ? 0 : (r0 > 24 ? 24 : r0); int cs = c - 8; cs = cs < 0 ? 0 : (cs > 48 ? 48 : cs);
        const unsigned qv = *(const GAS unsigned*)(PROJ + (size_t)(b * SEQ + t) * NPROJ + QOFF + h * HD + 2 * F.lane);
        const bf16* kp[6]; float sc[6];
#pragma unroll
        for (int j = 0; j < 6; ++j) { const int n = F.lane + 64 * j;
            if (j < 2) { const int ii = n >> 4, jj = n & 15; const int tk = (r0 + ii) * GW + cs + jj; kp[j] = PROJ + (size_t)(b * SEQ + tk) * NPROJ + KOFF + h * HD; }
            else kp[j] = KVC + (size_t)(b * LC + (n - 128)) * DM + h * HD;
            sc[j] = 0.f; }
#pragma unroll 4
        for (int pc = 0; pc < 16; ++pc) {
            v4u kk[6];
#pragma unroll
            for (int j = 0; j < 6; ++j) kk[j] = *(const GAS v4u*)(kp[j] + 8 * pc);
            const unsigned q0 = __builtin_amdgcn_readlane(qv, 4 * pc), q1 = __builtin_amdgcn_readlane(qv, 4 * pc + 1), q2 = __builtin_amdgcn_readlane(qv, 4 * pc + 2), q3 = __builtin_amdgcn_readlane(qv, 4 * pc + 3);
#pragma unroll
            for (int j = 0; j < 6; ++j) { sc[j] = dot2bf(q0, kk[j].x, sc[j]); sc[j] = dot2bf(q1, kk[j].y, sc[j]); sc[j] = dot2bf(q2, kk[j].z, sc[j]); sc[j] = dot2bf(q3, kk[j].w, sc[j]); }
        }
        float mx = -1e30f;
#pragma unroll
        for (int j = 0; j < 6; ++j) { sc[j] *= scale;
            if (j < 2) { const int n = F.lane + 64 * j, ii = n >> 4, jj = n & 15; sc[j] += rpb[(h * 15 + (r0 + ii - r + 7)) * 31 + (cs + jj - c + 15)]; }
            mx = fmaxf(mx, sc[j]); }
        mx = wave_max(mx);
        float ps = 0.f;
#pragma unroll
        for (int j = 0; j < 6; ++j) { sc[j] = __expf(sc[j] - mx); ps += sc[j]; }
        ps = wave_sum(ps);
        float o0 = 0.f, o1 = 0.f;
        const bf16* vl = PROJ + (size_t)(b * SEQ) * NPROJ + VOFF + h * HD + 2 * F.lane;
        const bf16* vc = KVC + (size_t)(b * LC) * DM + DC + h * HD + 2 * F.lane;
#pragma unroll
        for (int j = 0; j < 6; ++j) {
#pragma unroll 8
            for (int l = 0; l < 64; ++l) { const int n = l + 64 * j; const float p = __builtin_bit_cast(float, __builtin_amdgcn_readlane(__builtin_bit_cast(unsigned, sc[j]), l));
                unsigned vv;
                if (j < 2) { const int tk = (r0 + (n >> 4)) * GW + cs + (n & 15); vv = *(const GAS unsigned*)(vl + (size_t)tk * NPROJ); }
                else vv = *(const GAS unsigned*)(vc + (size_t)(n - 128) * DM);
                o0 += p * bf_lo(vv); o1 += p * bf_hi(vv); }
        }
        const float inv = 1.0f / ps; o0 *= inv; o1 *= inv;
        const float rstd = 1.0f / sqrtf(wave_sum(o0 * o0 + o1 * o1) * (1.0f / HD) + EPS);
        const f32x2 gg = *(const GAS f32x2*)(gat + h * HD + 2 * F.lane);
        *(GAS unsigned*)(Y + (size_t)(b * SEQ + t) * DM + DC + h * HD + 2 * F.lane) = cvt_pk_bf16(o0 * rstd * gg.x, o1 * rstd * gg.y);
    }
}

namespace at {
typedef short s16x4 __attribute__((ext_vector_type(4)));
typedef float f32x16 __attribute__((ext_vector_type(16)));
constexpr float SCALE = 0.088388347648318440f;
constexpr float THR = 8.f;
constexpr int SHM_V = 64 * 128 * 2, SHM_K = 64 * 128 * 2;
constexpr int WS_OFF = 2 * SHM_V + 2 * SHM_K, BT_OFF = WS_OFF + 8 * 64 * 4, BT_FLOATS = 15 * 32 + 192;
#define KSWZ(row, colB) ((row) * 256 + ((colB) ^ (((row) & 7) << 4)))
#define SBAR() __builtin_amdgcn_sched_barrier(0)
__device__ __forceinline__ int crow(int r, int hi) { return (r & 3) + 8 * (r >> 2) + 4 * hi; }
__device__ __forceinline__ void partialSM(f32x16& p0, f32x16& p1, float& m_reg, float& mn, float& alpha) {
  constexpr float C = SCALE * 1.4426950408889634f;
  float pmax = p0[0];
#pragma unroll
  for (int r = 1; r < 16; ++r) pmax = fmaxf(pmax, p0[r]);
#pragma unroll
  for (int r = 0; r < 16; ++r) pmax = fmaxf(pmax, p1[r]);
  { auto rr = __builtin_amdgcn_permlane32_swap(__builtin_bit_cast(unsigned, pmax), __builtin_bit_cast(unsigned, pmax), false, false);
    pmax = fmaxf(u2f(rr[0]), u2f(rr[1])); }
  if (__builtin_expect(__all(pmax - m_reg <= THR / SCALE), 1)) { mn = m_reg; alpha = 1.f; }
  else { mn = fmaxf(m_reg, pmax); alpha = __builtin_amdgcn_exp2f((m_reg - mn) * C); m_reg = mn; }
  const float mnC = -mn * C;
#pragma unroll
  for (int r = 0; r < 16; ++r) p0[r] = fmaf(p0[r], C, mnC);
#pragma unroll
  for (int r = 0; r < 16; ++r) p1[r] = fmaf(p1[r], C, mnC);
#pragma unroll
  for (int r = 0; r < 16; ++r) p0[r] = __builtin_amdgcn_exp2f(p0[r]);
}
__device__ __forceinline__ void finishSM(f32x16& p0, f32x16& p1, float alpha, float& l_reg, bf16x8& pa0, bf16x8& pa1, bf16x8& pa2, bf16x8& pa3) {
#pragma unroll
  for (int r = 0; r < 16; ++r) p1[r] = __builtin_amdgcn_exp2f(p1[r]);
  float ps = 0;
#pragma unroll
  for (int r = 0; r < 16; ++r) ps += p0[r];
#pragma unroll
  for (int r = 0; r < 16; ++r) ps += p1[r];
  { auto rr = __builtin_amdgcn_permlane32_swap(__builtin_bit_cast(unsigned, ps), __builtin_bit_cast(unsigned, ps), false, false);
    ps = u2f(rr[0]) + u2f(rr[1]); }
  l_reg = l_reg * alpha + ps;
#define PK4(P, BASE, OUT) do { unsigned a0 = cvt_pk_bf16(P[BASE + 0], P[BASE + 1]), a1 = cvt_pk_bf16(P[BASE + 2], P[BASE + 3]);   \
    unsigned b0 = cvt_pk_bf16(P[BASE + 4], P[BASE + 5]), b1 = cvt_pk_bf16(P[BASE + 6], P[BASE + 7]);                              \
    auto r0 = __builtin_amdgcn_permlane32_swap(a0, b0, false, false); auto r1 = __builtin_amdgcn_permlane32_swap(a1, b1, false, false); \
    v4u w = {r0[0], r1[0], r0[1], r1[1]}; OUT = __builtin_bit_cast(bf16x8, w); } while (0)
  PK4(p0, 0, pa0); PK4(p0, 8, pa1); PK4(p1, 0, pa2); PK4(p1, 8, pa3);
#undef PK4
}
__device__ __forceinline__ void qkt(f32x16& p0, f32x16& p1, const LAS char* Ks, const bf16x8* qr, int r32, int hi) {
  p0 = f32x16{}; p1 = f32x16{};
#pragma unroll
  for (int d0 = 0; d0 < 8; ++d0) { const int cb = (d0 * 16 + hi * 8) * 2;
    const bf16x8 b0 = *(const LAS bf16x8*)(Ks + KSWZ(r32, cb));
    const bf16x8 b1 = *(const LAS bf16x8*)(Ks + KSWZ(32 + r32, cb));
    p0 = __builtin_amdgcn_mfma_f32_32x32x16_bf16(b0, qr[d0], p0, 0, 0, 0);
    p1 = __builtin_amdgcn_mfma_f32_32x32x16_bf16(b1, qr[d0], p1, 0, 0, 0); }
}
__device__ __forceinline__ int v_st(int k, int c) { const int kk = (k & ~0xC) | ((k & 4) << 1) | ((k & 8) >> 1); return ((kk >> 3) * 4 + (c >> 5)) * 512 + ((kk & 7) * 32 + (c & 31)) * 2; }
__device__ __forceinline__ int v_rd_base(int lane) { return ((lane & 3) << 3) | (((lane >> 2) & 3) << 6) | (((lane >> 4) & 1) << 5) | (((lane >> 5) & 1) << 8); }
constexpr int v_rd_off(int d0, int ks, int half) { return d0 * 512 + ks * 4096 + half * 2048; }
template <int OFF> __device__ __forceinline__ s16x4 tr_read(int vb) {
  s16x4 r; asm volatile("ds_read_b64_tr_b16 %0, %1 offset:%2" : "=&v"(r) : "v"(vb), "i"(OFF) : "memory"); return r;
}
template <int D0> __device__ __forceinline__ void pv_one(f32x16& od, int vb, bf16x8 pa0, bf16x8 pa1, bf16x8 pa2, bf16x8 pa3) {
  const s16x4 l0 = tr_read<v_rd_off(D0, 0, 0)>(vb), h0 = tr_read<v_rd_off(D0, 0, 1)>(vb), l1 = tr_read<v_rd_off(D0, 1, 0)>(vb), h1 = tr_read<v_rd_off(D0, 1, 1)>(vb);
  const s16x4 l2 = tr_read<v_rd_off(D0, 2, 0)>(vb), h2 = tr_read<v_rd_off(D0, 2, 1)>(vb), l3 = tr_read<v_rd_off(D0, 3, 0)>(vb), h3 = tr_read<v_rd_off(D0, 3, 1)>(vb);
  asm volatile("s_waitcnt lgkmcnt(0)" ::: "memory"); SBAR();
#define PK(L, H) (bf16x8){L[0], L[1], L[2], L[3], H[0], H[1], H[2], H[3]}
  od = __builtin_amdgcn_mfma_f32_32x32x16_bf16(pa0, PK(l0, h0), od, 0, 0, 0);
  od = __builtin_amdgcn_mfma_f32_32x32x16_bf16(pa1, PK(l1, h1), od, 0, 0, 0);
  od = __builtin_amdgcn_mfma_f32_32x32x16_bf16(pa2, PK(l2, h2), od, 0, 0, 0);
  od = __builtin_amdgcn_mfma_f32_32x32x16_bf16(pa3, PK(l3, h3), od, 0, 0, 0);
#undef PK
}
__device__ __forceinline__ void pv_d0(f32x16* o, int vb, bf16x8 pa0, bf16x8 pa1, bf16x8 pa2, bf16x8 pa3) {
  pv_one<0>(o[0], vb, pa0, pa1, pa2, pa3); pv_one<1>(o[1], vb, pa0, pa1, pa2, pa3); pv_one<2>(o[2], vb, pa0, pa1, pa2, pa3); pv_one<3>(o[3], vb, pa0, pa1, pa2, pa3);
}
__device__ __forceinline__ void bias_mask(f32x16& p0, f32x16& p1, const LAS float* bt, int j, int kr_lo, int rq, int r0w, int c, int cs, int hi) {
  if (j < 4) return;
  const int kr = kr_lo + (j - 4);
  if (kr < r0w || kr > r0w + 7) {
#pragma unroll
    for (int r = 0; r < 16; ++r) { p0[r] = -1e30f; p1[r] = -1e30f; }
    return; }
  const LAS float* bp = bt + 64 + (kr - rq + 7) * 32 + 15 - c + 4 * hi;
  const int kc0 = 4 * hi - cs;
#pragma unroll
  for (int r = 0; r < 16; ++r) { const int KC = (r & 3) + 8 * (r >> 2);
    const float b0 = bp[KC], b1 = bp[KC + 32];
    p0[r] = ((unsigned)(kc0 + KC) < 16u) ? p0[r] + b0 : -1e30f;
    p1[r] = ((unsigned)(kc0 + KC + 32) < 16u) ? p1[r] + b1 : -1e30f;
    if ((r & 3) == 3) asm volatile("" ::: "memory"); }
}
}

__device__ __forceinline__ void attn_unit(Frame& F, int b, int h, int g) {
  using namespace at;
  const bf16* PROJ = (const bf16*)(F.ws + WS_PROJ); const bf16* KVC = (const bf16*)(F.ws + WS_KVC); bf16* Y = (bf16*)(F.ws + WS_Y);
  const int tid = F.tid, wid = F.wave, lane = F.lane, r32 = lane & 31, hi = lane >> 5;
  const LAS char* ldsc = (const LAS char*)F.lds;
  LAS char* V_lds = (LAS char*)F.lds; LAS char* K_lds = (LAS char*)F.lds + 2 * SHM_V;
  LAS float* wsl = (LAS float*)(F.lds + WS_OFF) + wid * 64; LAS float* li_l = wsl; LAS float* al_l = wsl + 32;
  LAS float* bt = (LAS float*)(F.lds + BT_OFF);
  const int nloc = (g == 0 || g == 7) ? 8 : 11; const int kr_lo = (g == 0) ? 0 : (g == 7 ? 24 : 4 * g - 4); const int NT = 4 + nloc;
  const int rq = 4 * g + (wid >> 1); int r0w = rq - 4; r0w = r0w < 0 ? 0 : (r0w > 24 ? 24 : r0w);
  const int c = (wid & 1) * 32 + r32; int cs = c - 8; cs = cs < 0 ? 0 : (cs > 48 ? 48 : cs);
  __syncthreads();
  for (int i = tid; i < BT_FLOATS; i += NTHR) { const int k = i - 64; float v = 0.f;
    if (k >= 0 && k < 15 * 32 && (k & 31) < 31) v = FIN(I_RPB)[(h * 15 + (k >> 5)) * 31 + (k & 31)] * (1.0f / SCALE);
    bt[i] = v; }
  float m_reg = -1e30f, l_reg = 0; f32x16 o[4] = {}; bf16x8 qr[8];
  const bf16* Qw = PROJ + (size_t)(b * SEQ + rq * GW + c) * NPROJ + QOFF + h * HD + hi * 8;
#pragma unroll
  for (int d0 = 0; d0 < 8; ++d0) qr[d0] = *(const GAS bf16x8*)(Qw + d0 * 16);
  const int sr = tid >> 4, sc = (tid & 15) * 8, vst0 = v_st(sr, sc), vst1 = v_st(32 + sr, sc);
  const int vb0 = (int)(uintptr_t)V_lds + v_rd_base(lane);
  const GAS char* Kc = (const GAS char*)(KVC + (size_t)(b * LC) * DM + h * HD);
  const GAS char* Kl = (const GAS char*)(PROJ + (size_t)(b * SEQ) * NPROJ + KOFF + h * HD);
  const unsigned vo_c = (unsigned)(sr * DM + sc) * 2u, vo_l = (unsigned)(sr * NPROJ + sc) * 2u;
  struct { bf16x8 vs0, vs1, ks0, ks1; } st_;
#define SLOAD(j) do { const int _j = (j); const GAS char* _k; unsigned _vo; size_t _h; \
    if (_j < 4) { _k = Kc + (size_t)(_j * 64) * DM * 2; _vo = vo_c; _h = (size_t)32 * DM * 2; } else { _k = Kl + (size_t)((kr_lo + _j - 4) * GW) * NPROJ * 2; _vo = vo_l; _h = (size_t)32 * NPROJ * 2; } \
    st_.ks0 = *(const GAS bf16x8*)(_k + _vo); st_.ks1 = *(const GAS bf16x8*)(_k + _h + _vo); \
    st_.vs0 = *(const GAS bf16x8*)(_k + 2048 + _vo); st_.vs1 = *(const GAS bf16x8*)(_k + _h + 2048 + _vo); } while (0)
#define SWRITE(bb) do { *(LAS bf16x8*)(V_lds + (bb) * SHM_V + vst0) = st_.vs0; *(LAS bf16x8*)(V_lds + (bb) * SHM_V + vst1) = st_.vs1; const int kc = sc * 2; \
    *(LAS bf16x8*)(K_lds + (bb) * SHM_K + KSWZ(sr, kc)) = st_.ks0; *(LAS bf16x8*)(K_lds + (bb) * SHM_K + KSWZ(32 + sr, kc)) = st_.ks1; } while (0)
#define RESC(a) do { if (__any((a) < 1.f)) { if (hi == 0) al_l[r32] = (a); asm volatile("s_waitcnt lgkmcnt(0)" ::: "memory"); \
    _Pragma("unroll") for (int d = 0; d < 4; ++d) _Pragma("unroll") for (int r = 0; r < 16; ++r) o[d][r] *= al_l[crow(r, hi)]; } } while (0)
#define BIAS(P0, P1, j) bias_mask(P0, P1, bt, (j), kr_lo, rq, r0w, c, cs, hi)
  f32x16 p0, p1; float mn, al; bf16x8 pa0, pa1, pa2, pa3;
#define STEP(j, B) do { SWRITE(B); if ((j) + 1 < NT) SLOAD((j) + 1); __syncthreads(); \
    qkt(p0, p1, K_lds + (B) * SHM_K, qr, r32, hi); BIAS(p0, p1, (j)); partialSM(p0, p1, m_reg, mn, al); RESC(al); \
    finishSM(p0, p1, al, l_reg, pa0, pa1, pa2, pa3); SBAR(); pv_d0(o, vb0 + (B) * SHM_V, pa0, pa1, pa2, pa3); } while (0)
  SLOAD(0);
  for (int j = 0; j + 1 < NT; j += 2) { STEP(j, 0); STEP(j + 1, 1); }
  if (NT & 1) STEP(NT - 1, 0);
#undef STEP
  asm volatile("s_waitcnt vmcnt(0)" ::: "memory");
  if (hi == 0) li_l[r32] = l_reg; asm volatile("s_waitcnt lgkmcnt(0)" ::: "memory");
  const float* ga = FIN(I_GATTN) + h * HD;
  float gg[4];
#pragma unroll
  for (int d0 = 0; d0 < 4; ++d0) gg[d0] = ga[d0 * 32 + r32];
  bf16* Yw = Y + (size_t)(b * SEQ + rq * GW + (wid & 1) * 32) * DM + DC + h * HD + r32;
#pragma unroll
  for (int r = 0; r < 16; ++r) { const int orow = crow(r, hi); const float rl = 1.0f / li_l[orow];
    float v0 = o[0][r] * rl, v1 = o[1][r] * rl, v2 = o[2][r] * rl, v3 = o[3][r] * rl;
    float ss = (v0 * v0 + v1 * v1) + (v2 * v2 + v3 * v3);
    ss += __shfl_xor(ss, 1); ss += __shfl_xor(ss, 2); ss += __shfl_xor(ss, 4); ss += __shfl_xor(ss, 8); ss += __shfl_xor(ss, 16);
    const float rstd = 1.0f / sqrtf(ss * (1.0f / HD) + EPS);
    bf16* yr = Yw + (size_t)orow * DM;
    yr[0] = (bf16)(cvt_pk_bf16(v0 * rstd * gg[0], 0.f) & 0xffffu); yr[32] = (bf16)(cvt_pk_bf16(v1 * rstd * gg[1], 0.f) & 0xffffu);
    yr[64] = (bf16)(cvt_pk_bf16(v2 * rstd * gg[2], 0.f) & 0xffffu); yr[96] = (bf16)(cvt_pk_bf16(v3 * rstd * gg[3], 0.f) & 0xffffu); }
#undef SLOAD
#undef SWRITE
#undef RESC
#undef BIAS
}
__device__ __forceinline__ void p3_attn_mfma(Frame& F) {
  const int cx = (F.bid & 7) * 32 + (F.bid >> 3);
  for (int u = cx; u < 512; u += 256) {
    int bh, g;
    if (u < 384) { bh = u / 6; g = 1 + u % 6; } else { const int s = u - 384; bh = s >> 1; g = (s & 1) ? 7 : 0; }
    attn_unit(F, bh >> 3, bh & 7, g);
  }
}

__device__ __forceinline__ void p3_conv(Frame& F) {
    const bf16* PROJ = (const bf16*)(F.ws + WS_PROJ); bf16* Y = (bf16*)(F.ws + WS_Y);
    const float* cw = FIN(I_CONVW); const float* cb = FIN(I_CONVB); const float* gc = FIN(I_GCONV);
    const int gw = F.bid * NWAVES + F.wave, NGW = F.G * NWAVES;
    for (int task = gw; task < T / 2; task += NGW) {
        const int row0 = 4 * (task >> 1), t0 = row0 & (SEQ - 1), ch0 = (task & 1) * 512 + 8 * F.lane;
        const bf16* pr = PROJ + (size_t)row0 * NPROJ + ch0;
        v4u rc[6], rx[6], rb[4];
#pragma unroll
        for (int k = 0; k < 6; ++k) { const bool ok = (k == 0) ? (t0 > 0) : ((k == 5) ? (t0 + 4 < SEQ) : true);
            rc[k] = (v4u){0, 0, 0, 0}; rx[k] = (v4u){0, 0, 0, 0};
            if (ok) { rc[k] = *(const GAS v4u*)(pr + (long)(k - 1) * NPROJ + 1024); rx[k] = *(const GAS v4u*)(pr + (long)(k - 1) * NPROJ + 2048); } }
#pragma unroll
        for (int k = 0; k < 4; ++k) rb[k] = *(const GAS v4u*)(pr + (long)k * NPROJ);
        float w0[8], w1[8], w2[8], bb[8], gg[8];
#pragma unroll
        for (int q = 0; q < 2; ++q) { const f32x4 a0 = *(const GAS f32x4*)(cw + ch0 + 4 * q), a1 = *(const GAS f32x4*)(cw + 1024 + ch0 + 4 * q), a2 = *(const GAS f32x4*)(cw + 2048 + ch0 + 4 * q),
                a3 = *(const GAS f32x4*)(cb + ch0 + 4 * q), a4 = *(const GAS f32x4*)(gc + ch0 + 4 * q);
#pragma unroll
            for (int e = 0; e < 4; ++e) { w0[4 * q + e] = a0[e]; w1[4 * q + e] = a1[e]; w2[4 * q + e] = a2[e]; bb[4 * q + e] = a3[e]; gg[4 * q + e] = a4[e]; } }
        float p[6][8];
#pragma unroll
        for (int k = 0; k < 6; ++k)
#pragma unroll
            for (int q = 0; q < 4; ++q) { p[k][2 * q] = bf_lo(rc[k][q]) * bf_lo(rx[k][q]); p[k][2 * q + 1] = bf_hi(rc[k][q]) * bf_hi(rx[k][q]); }
#pragma unroll
        for (int i = 0; i < 4; ++i) {
            float o[8]; float ss = 0.f;
#pragma unroll
            for (int q = 0; q < 4; ++q)
#pragma unroll
                for (int z = 0; z < 2; ++z) { const int e = 2 * q + z; const float ubv = z ? bf_hi(rb[i][q]) : bf_lo(rb[i][q]);
                    const float cv = p[i][e] * w0[e] + p[i + 1][e] * w1[e] + p[i + 2][e] * w2[e] + bb[e]; o[e] = ubv * cv; ss += o[e] * o[e]; }
            ss += __shfl_xor(ss, 1); ss += __shfl_xor(ss, 2); ss += __shfl_xor(ss, 4); ss += __shfl_xor(ss, 8);
            const float rstd = 1.0f / sqrtf(ss * (1.0f / 128.0f) + EPS);
            unsigned w[4];
#pragma unroll
            for (int q = 0; q < 4; ++q) w[q] = cvt_pk_bf16(o[2 * q] * rstd * gg[2 * q], o[2 * q + 1] * rstd * gg[2 * q + 1]);
            *(GAS v4u*)(Y + (size_t)(row0 + i) * DM + ch0) = (v4u){w[0], w[1], w[2], w[3]};
        }
    }
}

struct ProbOut {
    static constexpr int K = DM, KB = DM * 2, SCALE_A = 0, SCALE_B = 0, SCALE_B1 = 0, EPI_STORES = 16; static constexpr bool GATHER = false, PERM = true, FP8 = false;
    const bf16 *Y, *Wout; bf16* YL; float* SSQ; int G, c;
    __device__ __forceinline__ bool next(int i, pg8::Unit& u) const {
        const int w = pg8::round_unit(i, G, c, 512); if (w < 0) return false;
        u.pm = (w >> 6) * 8 + (w & 7); u.pn = (w & 63) >> 3; u.g = 0; return true; }
    __device__ __forceinline__ const char* a_base(const pg8::Unit& u) const { return (const char*)Y + (size_t)u.pm * 256 * K * 2; }
    __device__ __forceinline__ const char* b_base(const pg8::Unit& u) const { return (const char*)Wout + (size_t)u.pn * 256 * K * 2; }
    __device__ __forceinline__ void rows(const pg8::Unit&, int, LAS unsigned*) const {}
    __device__ __forceinline__ void epi(const f32x4 (&acc)[2][2][4][2], const pg8::Unit& u, int wr, int wc, int fr, int fq) const {
        const int row0 = u.pm * 256 + wr * 64 + fr, col0 = u.pn * 256 + wc * 32 + 8 * fq;
#pragma unroll
        for (int ai = 0; ai < 2; ++ai)
#pragma unroll
            for (int m = 0; m < 4; ++m) { const int row = row0 + ai * 128 + m * 16; bf16* rowp = YL + (size_t)row * DM + col0; float ss = 0.f;
#pragma unroll
                for (int bj = 0; bj < 2; ++bj) { const f32x4 v0 = acc[ai][bj][m][0], v1 = acc[ai][bj][m][1];
                    ss += (v0.x * v0.x + v0.y * v0.y) + (v0.z * v0.z + v0.w * v0.w) + (v1.x * v1.x + v1.y * v1.y) + (v1.z * v1.z + v1.w * v1.w);
                    v4u w; w.x = cvt_pk_bf16(v0.x, v0.y); w.y = cvt_pk_bf16(v0.z, v0.w); w.z = cvt_pk_bf16(v1.x, v1.y); w.w = cvt_pk_bf16(v1.z, v1.w);
                    *(GAS v4u*)(rowp + bj * 128) = w; }
                ss += __shfl_xor(ss, 16); ss += __shfl_xor(ss, 32);
                if (fq == 0) SSQ[(size_t)row * 32 + u.pn * 4 + wc] = ss; }
    }
};

__device__ __forceinline__ void p5_route(Frame& F) {
    const float* MOD = (const float*)(F.ws + WS_MOD);
    const bf16* YL = (const bf16*)(F.ws + WS_YL); const float* SSQ = (const float*)(F.ws + WS_SSQ);
    const bf16* WRH = (const bf16*)(F.ws + WS_WRH); const bf16* WRL = (const bf16*)(F.ws + WS_WRL);
    unsigned* gcnt = (unsigned*)(F.ws + WS_CTL) + CW_CNT;
    v2u* LIST = (v2u*)(F.ws + WS_LIST);
    LAS float* part = (LAS float*)F.lds;
    LAS float* logit = (LAS float*)(F.lds + 131072);
    LAS unsigned* lcnt = (LAS unsigned*)(F.lds + 147456);
    LAS unsigned* lbase = (LAS unsigned*)(F.lds + 147456 + 256);
    LAS unsigned* ent = (LAS unsigned*)(F.lds + 147456 + 512);
    for (int blk = F.bid; blk < T / 64; blk += F.G) {
        const int row0 = blk * 64;
        if (F.tid < 64) lcnt[F.tid] = 0u;
        {
            const float* md = MOD + (size_t)(row0 >> 11) * 12288;
            f32x4 nx[8]; v2u ny[8]; float nsq;
#define P5_LOAD(rr_) do { const int _row = row0 + (rr_); const float* _xr = FIN(I_X) + (size_t)_row * DM; const bf16* _yr = YL + (size_t)_row * DM; \
                nsq = F.lane < 32 ? SSQ[(size_t)_row * 32 + F.lane] : 0.f; \
                _Pragma("unroll") for (int j = 0; j < 8; ++j) { nx[j] = *(const GAS f32x4*)(_xr + 4 * F.lane + 256 * j); ny[j] = *(const GAS v2u*)(_yr + 4 * F.lane + 256 * j); } } while (0)
            P5_LOAD(F.wave);
            for (int rr = F.wave; rr < 64; rr += NWAVES) {
                const int row = row0 + rr;
                f32x4 v[8]; v2u yv[8]; float sq = nsq;
#pragma unroll
                for (int j = 0; j < 8; ++j) { v[j] = nx[j]; yv[j] = ny[j]; }
                if (rr + NWAVES < 64) P5_LOAD(rr + NWAVES);
                sq = wave_sum(sq);
                const float rstd1 = 1.0f / sqrtf(sq * (1.0f / DM) + EPS);
                float ss = 0.f;
#pragma unroll
                for (int j = 0; j < 8; ++j) { const int c = 4 * F.lane + 256 * j;
                    const f32x4 gp = *(const GAS f32x4*)(FIN(I_GPOSTMIX) + c), gt = *(const GAS f32x4*)(md + 4096 + c);
                    const f32x4 yl = (f32x4){bf_lo(yv[j].x), bf_hi(yv[j].x), bf_lo(yv[j].y), bf_hi(yv[j].y)};
                    v[j] = v[j] + gt * (yl * rstd1 * gp);
                    { const unsigned h0 = cvt_pk_bf16(v[j].x, v[j].y), h1 = cvt_pk_bf16(v[j].z, v[j].w);
                      const unsigned l0 = cvt_pk_bf16(v[j].x - bf_lo(h0), v[j].y - bf_hi(h0)), l1 = cvt_pk_bf16(v[j].z - bf_lo(h1), v[j].w - bf_hi(h1));
                      unsigned char* xp = (unsigned char*)FOUT + (size_t)row * (DM * 4) + (j >> 2) * 4096 + (4 * F.lane + 256 * (j & 3)) * 2;
                      *(GAS v2u*)xp = (v2u){h0, h1}; *(GAS v2u*)(xp + 2048) = (v2u){l0, l1}; }
                    ss += (v[j].x * v[j].x + v[j].y * v[j].y) + (v[j].z * v[j].z + v[j].w * v[j].w); }
                const float rstd2 = 1.0f / sqrtf(wave_sum(ss) * (1.0f / DM) + EPS);
                if (F.lane == 0) ((GAS float*)(F.ws + WS_RS2))[row] = rstd2;
#pragma unroll
                for (int j = 0; j < 8; ++j) { const int c = 4 * F.lane + 256 * j;
                    const f32x4 gg = *(const GAS f32x4*)(FIN(I_GPREFFN) + c), sh = *(const GAS f32x4*)(md + 6144 + c), sc = *(const GAS f32x4*)(md + 8192 + c);
                    const f32x4 h = (v[j] * rstd2) * gg * (sc + 1.0f) + sh;
                    *(GAS unsigned*)(F.ws + WS_H2Q + (size_t)row * DM + c) = pack4_fp8(clamp448(h.x * 4.0f), clamp448(h.y * 4.0f), clamp448(h.z * 4.0f), clamp448(h.w * 4.0f)); }
            }
#undef P5_LOAD
        }
        VM_WAIT(); __syncthreads();
        {
            const int fr = F.lane & 15, fq = F.lane >> 4, k0 = F.wave * 256 + 8 * fq;
            const unsigned char* xh = (const unsigned char*)FOUT + (size_t)(row0 + fr) * (DM * 4) + (F.wave >> 2) * 4096 + ((F.wave & 3) * 256 + 8 * fq) * 2;
            const float* mdb = MOD + (size_t)(row0 >> 11) * 12288;
            float rs[4];
#pragma unroll
            for (int i = 0; i < 4; ++i) rs[i] = ((const GAS float*)(F.ws + WS_RS2))[row0 + 16 * i + fr];
            const bf16* bh = WRH + (size_t)fr * DM + k0; const bf16* bl = WRL + (size_t)fr * DM + k0;
            f32x4 acc[4][4];
#pragma unroll
            for (int i = 0; i < 4; ++i)
#pragma unroll
                for (int n = 0; n < 4; ++n) acc[i][n] = (f32x4){0.f, 0.f, 0.f, 0.f};
#pragma unroll 2
            for (int s = 0; s < 8; ++s) {
                v4u XH[4], XL[4]; bf16x8 a_h[4], a_l[4], b_h[4], b_l[4];
#pragma unroll
                for (int i = 0; i < 4; ++i) { XH[i] = *(const GAS v4u*)(xh + (size_t)i * 16 * (DM * 4) + 64 * s); XL[i] = *(const GAS v4u*)(xh + (size_t)i * 16 * (DM * 4) + 64 * s + 2048);
                    b_h[i] = *(const GAS bf16x8*)(bh + (size_t)i * 16 * DM + 32 * s); b_l[i] = *(const GAS bf16x8*)(bl + (size_t)i * 16 * DM + 32 * s); }
                const int kc = k0 + 32 * s;
                f32x4 G[2], S[2];
#pragma unroll
                for (int z = 0; z < 2; ++z) { const f32x4 gg = *(const GAS f32x4*)(FIN(I_GPREFFN) + kc + 4 * z), sc = *(const GAS f32x4*)(mdb + 8192 + kc + 4 * z); G[z] = gg * (sc + 1.0f); S[z] = *(const GAS f32x4*)(mdb + 6144 + kc + 4 * z); }
#pragma unroll
                for (int i = 0; i < 4; ++i) { unsigned hh[4], ll[4];
#pragma unroll
                    for (int z = 0; z < 2; ++z) { const unsigned ha = z ? XH[i].z : XH[i].x, hb = z ? XH[i].w : XH[i].y, la = z ? XL[i].z : XL[i].x, lb = z ? XL[i].w : XL[i].y;
                        const f32x4 xq = (f32x4){bf_lo(ha) + bf_lo(la), bf_hi(ha) + bf_hi(la), bf_lo(hb) + bf_lo(lb), bf_hi(hb) + bf_hi(lb)};
                        const f32x4 h = (xq * rs[i]) * G[z] + S[z];
                        hh[2 * z] = cvt_pk_bf16(h.x, h.y); hh[2 * z + 1] = cvt_pk_bf16(h.z, h.w);
                        ll[2 * z] = cvt_pk_bf16(h.x - bf_lo(hh[2 * z]), h.y - bf_hi(hh[2 * z])); ll[2 * z + 1] = cvt_pk_bf16(h.z - bf_lo(hh[2 * z + 1]), h.w - bf_hi(hh[2 * z + 1])); }
                    a_h[i] = __builtin_bit_cast(bf16x8, (v4u){hh[0], hh[1], hh[2], hh[3]}); a_l[i] = __builtin_bit_cast(bf16x8, (v4u){ll[0], ll[1], ll[2], ll[3]}); }
#pragma unroll
                for (int i = 0; i < 4; ++i)
#pragma unroll
                    for (int n = 0; n < 4; ++n) {
                        acc[i][n] = __builtin_amdgcn_mfma_f32_16x16x32_bf16(a_l[i], b_h[n], acc[i][n], 0, 0, 0);
                        acc[i][n] = __builtin_amdgcn_mfma_f32_16x16x32_bf16(a_h[i], b_l[n], acc[i][n], 0, 0, 0);
                        acc[i][n] = __builtin_amdgcn_mfma_f32_16x16x32_bf16(a_h[i], b_h[n], acc[i][n], 0, 0, 0); }
            }
            LAS float* pw = part + F.wave * 4096;
#pragma unroll
            for (int i = 0; i < 4; ++i)
#pragma unroll
                for (int n = 0; n < 4; ++n)
#pragma unroll
                    for (int r = 0; r < 4; ++r) pw[(i * 16 + 4 * fq + r) * 64 + n * 16 + fr] = acc[i][n][r];
        }
        __syncthreads();
#pragma unroll
        for (int q = 0; q < 8; ++q) { const int idx = F.tid + 512 * q; float sacc = 0.f;
#pragma unroll
            for (int w = 0; w < 8; ++w) sacc += part[w * 4096 + idx];
            logit[idx] = sacc; }
        __syncthreads();
        for (int rr = F.wave; rr < 64; rr += NWAVES) {
            const int row = row0 + rr; const int e = F.lane;
            const float lg = logit[rr * 64 + e]; const float score = 1.0f / (1.0f + expf(-lg)); const float sel = score + FIN(I_RBIAS)[e];
            float m1 = sel; m1 = fmaxf(m1, __shfl_xor(m1, 1)); m1 = fmaxf(m1, __shfl_xor(m1, 2)); m1 = fmaxf(m1, __shfl_xor(m1, 4));
            int i1 = (sel == m1) ? e : 1000; i1 = min(i1, __shfl_xor(i1, 1)); i1 = min(i1, __shfl_xor(i1, 2)); i1 = min(i1, __shfl_xor(i1, 4));
            float s2 = (e == i1) ? -INFINITY : sel; s2 = fmaxf(s2, __shfl_xor(s2, 1)); s2 = fmaxf(s2, __shfl_xor(s2, 2)); s2 = fmaxf(s2, __shfl_xor(s2, 4));
            const float gs = m1 + s2; const int g = e >> 3; int grank = 0;
#pragma unroll
            for (int g2 = 0; g2 < 8; ++g2) { const float o = __builtin_bit_cast(float, __builtin_amdgcn_readlane(__builtin_bit_cast(unsigned, gs), 8 * g2)); grank += (o > gs || (o == gs && g2 < g)) ? 1 : 0; }
            const float ms = grank < 4 ? sel : -INFINITY; int rank = 0;
#pragma unroll 8
            for (int e2 = 0; e2 < 64; ++e2) { const float o = __builtin_bit_cast(float, __builtin_amdgcn_readlane(__builtin_bit_cast(unsigned, ms), e2)); rank += (o > ms || (o == ms && e2 < e)) ? 1 : 0; }
            const bool chosen = rank < 8;
            const float ssum = wave_sum(chosen ? score : 0.f);
            const float w = score / ssum * 2.5f;
            if (chosen) { const unsigned lp = __hip_atomic_fetch_add(lcnt + e, 1u, __ATOMIC_RELAXED, __HIP_MEMORY_SCOPE_WORKGROUP);
                LAS unsigned* en = ent + (rr * 8 + rank) * 4; en[0] = (unsigned)e; en[1] = lp; en[2] = (unsigned)row * 16u + (unsigned)rank; en[3] = __builtin_bit_cast(unsigned, w); }
            if (F.lane == 0) LIST[(size_t)64 * LIST_CAP + row] = (v2u){(unsigned)row * 16u + 8u, __builtin_bit_cast(unsigned, 1.0f)};
        }
        __syncthreads();
        if (F.tid < 64) lbase[F.tid] = __hip_atomic_fetch_add(gcnt + 64 * F.tid, lcnt[F.tid], RLX_AGENT);
        __syncthreads();
        { const LAS unsigned* en = ent + F.tid * 4; const unsigned e = en[0], idx = lbase[e] + en[1]; LIST[(size_t)e * LIST_CAP + idx] = (v2u){en[2], en[3]};
          ((v2u*)(F.ws + WS_TOK))[(size_t)(en[2] >> 4) * 8 + (en[2] & 15u)] = (v2u){(e << 16) | idx, en[3]}; }
        __syncthreads();
    }
}

struct TileTab { LAS int* cnt; LAS int* tstart; };
__device__ __forceinline__ TileTab build_tiles(Frame& F) {
    TileTab tt; tt.cnt = (LAS int*)(F.lds + MISC_OFF); tt.tstart = tt.cnt + 128;
    const unsigned* gcnt = (const unsigned*)(F.ws + WS_CTL) + CW_CNT;
    if (F.tid < 64) tt.cnt[F.tid] = (int)__hip_atomic_load(gcnt + 64 * F.tid, RLX_AGENT);
    if (F.tid == 64) tt.cnt[64] = T;
    __syncthreads();
    if (F.tid == 0) { int s = 0; for (int e = 0; e < 65; ++e) { tt.tstart[e] = s; s += (tt.cnt[e] + 255) >> 8; } tt.tstart[65] = s; }
    __syncthreads();
    return tt;
}
__device__ __forceinline__ int tile_expert(const TileTab& tt, int tile, int e) { while (tt.tstart[e + 1] <= tile) ++e; return e; }

struct ProbGU {
    static constexpr int KB = DM, SCALE_A = 0x7D7D7D7D  , SCALE_B = 0x79797979  , SCALE_B1 = 0x7B7B7B7B  , EPI_STORES = 0  ; static constexpr bool GATHER = true, PERM = false, FP8 = true;
    const unsigned char *H2Q, *Wgu; unsigned char* HID; const v2u* LIST; TileTab tt; int G, c; mutable int eh;
    __device__ __forceinline__ bool next(int i, pg8::Unit& u) const {
        const int total = tt.tstart[65] * 4; const int w = pg8::round_unit(i, G, c, total); if (w < 0) return false;
        u.pm = w >> 2; u.pn = w & 3; eh = tile_expert(tt, u.pm, eh); u.g = eh; return true; }
    __device__ __forceinline__ const char* a_base(const pg8::Unit&) const { return (const char*)H2Q; }
    __device__ __forceinline__ const char* b_base(const pg8::Unit& u) const { return (const char*)Wgu + ((size_t)u.g * 1024 + (size_t)u.pn * 256) * KB; }
    __device__ __forceinline__ void rows(const pg8::Unit& u, int tid, LAS unsigned* dst) const {
        const int lt = u.pm - tt.tstart[u.g]; const int nrow = tt.cnt[u.g] - lt * 256; const v2u* lp = LIST + (size_t)u.g * LIST_CAP + lt * 256;
        unsigned tk[2][2];
#pragma unroll
        for (int i = 0; i < 2; ++i) { int R0, C; pg8::stage_rc(tid * 16 + i * 8192, R0, C);
#pragma unroll
            for (int h = 0; h < 2; ++h) { int R = R0 + 128 * h; R = R < nrow ? R : nrow - 1; tk[h][i] = lp[R].x; } }
#pragma unroll
        for (int i = 0; i < 2; ++i) { int R0, C; pg8::stage_rc(tid * 16 + i * 8192, R0, C);
#pragma unroll
            for (int h = 0; h < 2; ++h) dst[(h * 2 + i) * 512 + tid] = (tk[h][i] >> 4) * (unsigned)KB + (unsigned)(C * 2); }
    }
    __device__ __forceinline__ void epi(const f32x4 (&acc)[2][2][4][2], const pg8::Unit& u, int wr, int wc, int fr, int fq) const {
#pragma unroll
        for (int ai = 0; ai < 2; ++ai)
#pragma unroll
            for (int m = 0; m < 4; ++m) { const int R = ai * 128 + wr * 64 + m * 16 + fr;
                unsigned char* rowp = HID + ((size_t)u.pm * 256 + R) * FE + u.pn * 128 + wc * 32 + 8 * fq;
                unsigned pk[2];
#pragma unroll
                for (int bj = 0; bj < 2; ++bj) { const f32x4 g = acc[ai][bj][m][0], up = acc[ai][bj][m][1]; f32x4 hv;
#pragma unroll
                    for (int q = 0; q < 4; ++q) hv[q] = __builtin_amdgcn_fmed3f(g[q] * __builtin_amdgcn_rcpf(1.0f + __expf(-g[q])) * up[q], -448.0f, 448.0f);
                    pk[bj] = pack4_fp8(hv.x, hv.y, hv.z, hv.w); }
                *(GAS v2u*)rowp = (v2u){pk[0], pk[1]}; }
    }
};
struct ProbDown {
    static constexpr int KB = FE, SCALE_A = 0x7D7D7D7D  , SCALE_B = 0x7E7E7E7E  , SCALE_B1 = 0x7E7E7E7E, EPI_STORES = 8; static constexpr bool GATHER = false, PERM = false, FP8 = true;
    const unsigned char *HID, *Wdn; unsigned char* SLOT; const v2u* LIST; TileTab tt; int G, c; mutable int eh;
    __device__ __forceinline__ bool next(int i, pg8::Unit& u) const {
        const int total = tt.tstart[65] * 8; const int w = pg8::round_unit(i, G, c, total); if (w < 0) return false;
        u.pm = w >> 3; u.pn = w & 7; eh = tile_expert(tt, u.pm, eh); u.g = eh; return true; }
    __device__ __forceinline__ const char* a_base(const pg8::Unit& u) const { return (const char*)HID + (size_t)u.pm * 256 * KB; }
    __device__ __forceinline__ const char* b_base(const pg8::Unit& u) const { return (const char*)Wdn + ((size_t)u.g * 2048 + (size_t)u.pn * 256) * KB; }
    __device__ __forceinline__ void rows(const pg8::Unit&, int, LAS unsigned*) const {}
    __device__ __forceinline__ void epi(const f32x4 (&acc)[2][2][4][2], const pg8::Unit& u, int wr, int wc, int fr, int fq) const {
        const int col0 = u.pn * 256 + wc * 64 + 16 * fq;
#pragma unroll
        for (int ai = 0; ai < 2; ++ai)
#pragma unroll
            for (int m = 0; m < 4; ++m) { const int R = ai * 128 + wr * 64 + m * 16 + fr; unsigned char* rowp = SLOT + ((size_t)u.pm * 256 + R) * DM + col0;
                unsigned pk[4];
#pragma unroll
                for (int bj = 0; bj < 2; ++bj)
#pragma unroll
                    for (int n = 0; n < 2; ++n) { const f32x4 v = acc[ai][bj][m][n];
                        pk[bj * 2 + n] = pack4_fp8(__builtin_amdgcn_fmed3f(v.x, -448.0f, 448.0f), __builtin_amdgcn_fmed3f(v.y, -448.0f, 448.0f), __builtin_amdgcn_fmed3f(v.z, -448.0f, 448.0f), __builtin_amdgcn_fmed3f(v.w, -448.0f, 448.0f)); }
                *(GAS v4u*)rowp = (v4u){pk[0], pk[1], pk[2], pk[3]}; }
    }
};

__device__ __forceinline__ void fp8x4_to_f32(unsigned u, float* o) { const f32x2 a = __builtin_amdgcn_cvt_pk_f32_fp8((int)u, false), b = __builtin_amdgcn_cvt_pk_f32_fp8((int)u, true); o[0] = a.x; o[1] = a.y; o[2] = b.x; o[3] = b.y; }
__device__ __forceinline__ void p8_final(Frame& F, float* dst) {
    const int gw = F.bid * NWAVES + F.wave, NGW = F.G * NWAVES;
    const TileTab tt = build_tiles(F);
    const float* MOD = (const float*)(F.ws + WS_MOD); const unsigned char* SLOT = F.ws + WS_SLOT; const float* g = FIN(I_GPOSTFFN);
    const v2u* TOK = (const v2u*)(F.ws + WS_TOK);
    const int sh0 = tt.tstart[64] * 256;
    v2u ntk = (v2u){0u, 0u}; if (gw < T && F.lane < 8) ntk = TOK[(size_t)gw * 8 + F.lane];
    for (int row = gw; row < T; row += NGW) {
        const float* md = MOD + (size_t)(row >> 11) * 12288;
        unsigned mypos = 0u; float myw = 0.f;
        { const v2u tk = ntk; const unsigned e = tk.x >> 16; if (F.lane < 8) { mypos = (unsigned)tt.tstart[e & 63u] * 256u + (tk.x & 0xffffu); myw = u2f(tk.y) * (1.0f / 16.0f); } }
        if (row + NGW < T && F.lane < 8) ntk = TOK[(size_t)(row + NGW) * 8 + F.lane];
        v4u raw[9][2];
        { const unsigned char* sr = SLOT + (size_t)(sh0 + row) * DM + 16 * F.lane;
#pragma unroll
          for (int j = 0; j < 2; ++j) raw[8][j] = *(const GAS v4u*)(sr + 1024 * j); }
        float wv[9]; wv[8] = 1.0f / 16.0f;
#pragma unroll
        for (int s = 0; s < 8; ++s) { const unsigned pos = __builtin_amdgcn_readlane(mypos, s); wv[s] = u2f(__builtin_amdgcn_readlane(__builtin_bit_cast(unsigned, myw), s));
            const unsigned char* sr = SLOT + (size_t)pos * DM + 16 * F.lane;
#pragma unroll
            for (int j = 0; j < 2; ++j) raw[s][j] = *(const GAS v4u*)(sr + 1024 * j); }
        f32x4 xin[2][4];
#pragma unroll
        for (int j = 0; j < 2; ++j) { const GAS v4u* op = (const GAS v4u*)((const unsigned char*)FOUT + (size_t)row * (DM * 4) + j * 4096 + 32 * F.lane);
#pragma unroll
            for (int q = 0; q < 2; ++q) { const v4u H = op[q];
                xin[j][2 * q] = (f32x4){bf_lo(H.x), bf_hi(H.x), bf_lo(H.y), bf_hi(H.y)}; xin[j][2 * q + 1] = (f32x4){bf_lo(H.z), bf_hi(H.z), bf_lo(H.w), bf_hi(H.w)}; } }
        float f[2][16]; float ss = 0.f;
#pragma unroll
        for (int j = 0; j < 2; ++j) {
#pragma unroll
            for (int i = 0; i < 16; ++i) f[j][i] = 0.f;
#pragma unroll
            for (int s = 0; s < 9; ++s) { const int sx = (s + 8) % 9; const v4u r = raw[sx][j]; float t[16];
                fp8x4_to_f32(r.x, t); fp8x4_to_f32(r.y, t + 4); fp8x4_to_f32(r.z, t + 8); fp8x4_to_f32(r.w, t + 12);
#pragma unroll
                for (int i = 0; i < 16; ++i) f[j][i] += t[i] * wv[sx]; }
#pragma unroll
            for (int i = 0; i < 16; ++i) ss += f[j][i] * f[j][i]; }
        const float rstd = 1.0f / sqrtf(wave_sum(ss) * (1.0f / DM) + EPS);
#pragma unroll
        for (int j = 0; j < 2; ++j) { const int c = 16 * F.lane + 1024 * j; GAS f32x4* dp = (GAS f32x4*)(dst + (size_t)row * DM + c);
#pragma unroll
            for (int q = 0; q < 4; ++q) { const f32x4 ga = *(const GAS f32x4*)(g + c + 4 * q), ta = *(const GAS f32x4*)(md + 10240 + c + 4 * q);
                const f32x4 fv = (f32x4){f[j][4 * q], f[j][4 * q + 1], f[j][4 * q + 2], f[j][4 * q + 3]};
                dp[q] = xin[j][q] + ta * (fv * rstd * ga); } }
    }
}

constexpr int N_PHASES = 9;
#ifndef F8_IN_P0
#define F8_IN_P0 4992
#endif
#ifndef P2_GEMM_WGS
#define P2_GEMM_WGS 192
#endif
typedef KArgs Args;
__global__ void __launch_bounds__(NTHR, 2) fwd_kernel(Args args) {
    extern __shared__ __attribute__((aligned(16))) unsigned char lds_raw[];
    Frame F;
    F.lds = (LAS unsigned char*)lds_raw;
    F.tid = threadIdx.x; F.lane = F.tid & 63; F.wave = __builtin_amdgcn_readfirstlane(F.tid >> 6);
    F.G = gridDim.x; F.bid = blockIdx.x;
    F.ka = (CKArgs*)__builtin_amdgcn_kernarg_segment_ptr(); F.ws = args.ws;
#define LAUNDER() do { CKArgs* _p = (CKArgs*)__builtin_amdgcn_kernarg_segment_ptr(); asm volatile("" : "+s"(_p) :: "memory"); F.ka = _p; unsigned char* _w = _p->ws; F.ws = _w; } while (0)
    volatile LAS unsigned* barw = (volatile LAS unsigned*)(F.lds + BARW_OFF);
    if (F.tid < 16) barw[F.tid] = 0u;
    __syncthreads();
    XcdBarrier bar; bar.bar = (unsigned*)(F.ws + WS_CTL) + CW_BAR + args.li * XCD_BAR_WORDS; bar.x = 0; bar.st = nullptr;
    const int lo = args.ph_lo, hi = args.ph_hi;
    bar = xcd_barrier_post((unsigned*)(F.ws + WS_CTL) + CW_BAR + args.li * XCD_BAR_WORDS, barw);
#ifndef PH_MASK
#define PH_MASK 0x1ff
#endif
#define IN(k) (((PH_MASK >> (k)) & 1) && lo <= (k) && (k) < hi)
#ifdef TIME_PHASE
    volatile LAS unsigned long long* tstamp = (volatile LAS unsigned long long*)(F.lds + BARW_OFF - 128);
#define TSTAMP(k) do { if (F.tid == 0) tstamp[k] = __builtin_amdgcn_s_memrealtime(); } while (0)
#else
#define TSTAMP(k) do { } while (0)
#endif
#define SEAM(k) do { if (IN(k) && IN((k) + 1)) xcd_barrier(bar); TSTAMP((k) + 1); } while (0)
#ifndef REPEAT_MASK
#define REPEAT_MASK 0
#endif
#define NREP(k) (((REPEAT_MASK >> (k)) & 1) ? 2 : 1)
    TSTAMP(0);
    if (IN(0)) { for (int rep = 0; rep < NREP(0); ++rep) { if (rep) xcd_barrier(bar); LAUNDER(); p0_prologue(F); if (F8_IN_P0 > 0) conv_fp8_items(F, 0, F8_IN_P0, F.bid * NWAVES + F.wave, F.G * NWAVES); } } SEAM(0);
    if (IN(1)) {
        LAUNDER(); p1_norm(F, T, T + TC, F.bid * NWAVES + F.wave, F.G * NWAVES);
        xcd_barrier(bar); LAUNDER();
        if (F.bid < 64) {
            ProbProj P; P.HL = (const bf16*)(F.ws + WS_HL); P.HC = (const bf16*)(F.ws + WS_HC); P.Win = (const bf16*)(F.ws + WS_WIN); P.PROJ = (bf16*)(F.ws + WS_PROJ); P.KVC = (bf16*)(F.ws + WS_KVC);
            P.rope = (const f32x2*)(F.ws + WS_ROPE); P.G = 64; P.c = F.bid; P.base = ProbProj::NMAIN; P.total = 64;
            pg8::gemm_phase<ProbProj>(F.lds, P);
        } else p1_norm(F, 0, T, (F.bid - 64) * NWAVES + F.wave, (F.G - 64) * NWAVES);
    } SEAM(1);
    if (IN(2)) { LAUNDER();
        ProbProj P; P.HL = (const bf16*)(F.ws + WS_HL); P.HC = (const bf16*)(F.ws + WS_HC); P.Win = (const bf16*)(F.ws + WS_WIN); P.PROJ = (bf16*)(F.ws + WS_PROJ); P.KVC = (bf16*)(F.ws + WS_KVC);
        P.rope = (const f32x2*)(F.ws + WS_ROPE); P.G = F.G; P.c = F.bid; P.base = 0; P.total = ProbProj::NMAIN;
        P.G = P2_GEMM_WGS;
        if (F.bid < P2_GEMM_WGS) { for (int rep = 0; rep < NREP(2); ++rep) { if (rep) xcd_barrier(bar); pg8::gemm_phase<ProbProj>(F.lds, P); } }
        else conv_fp8_items(F, F8_IN_P0, NF8, (F.bid - P2_GEMM_WGS) * NWAVES + F.wave, (F.G - P2_GEMM_WGS) * NWAVES);
    } SEAM(2);
    if (IN(3)) { for (int rep = 0; rep < NREP(3); ++rep) { if (rep) xcd_barrier(bar); LAUNDER();
#ifdef ATTN_SIMPLE
        p3_attn_simple(F);
#else
        p3_attn_mfma(F);
#endif
        LAUNDER(); p3_conv(F); } } SEAM(3);
    if (IN(4)) { LAUNDER();
        ProbOut P; P.Y = (const bf16*)(F.ws + WS_Y); P.Wout = (const bf16*)(F.ws + WS_WOUT); P.YL = (bf16*)(F.ws + WS_YL); P.SSQ = (float*)(F.ws + WS_SSQ); P.G = F.G; P.c = F.bid;
        for (int rep = 0; rep < NREP(4); ++rep) { if (rep) xcd_barrier(bar); pg8::gemm_phase<ProbOut>(F.lds, P); }
    } SEAM(4);
    if (IN(5)) { LAUNDER(); p5_route(F); } SEAM(5);
    if (IN(6)) { LAUNDER();
        ProbGU P; P.eh = 0; P.tt = build_tiles(F); P.H2Q = F.ws + WS_H2Q; P.Wgu = F.ws + WS_WGU; P.HID = F.ws + WS_HID; P.LIST = (const v2u*)(F.ws + WS_LIST); P.G = F.G; P.c = F.bid;
        for (int rep = 0; rep < NREP(6); ++rep) { if (rep) xcd_barrier(bar); P.eh = 0; pg8::gemm_phase<ProbGU>(F.lds, P); }
    } SEAM(6);
    if (IN(7)) { LAUNDER();
        ProbDown P; P.eh = 0; P.tt = build_tiles(F); P.HID = F.ws + WS_HID; P.Wdn = F.ws + WS_WDN; P.SLOT = F.ws + WS_SLOT; P.LIST = (const v2u*)(F.ws + WS_LIST); P.G = F.G; P.c = F.bid;
        for (int rep = 0; rep < NREP(7); ++rep) { if (rep) xcd_barrier(bar); P.eh = 0; pg8::gemm_phase<ProbDown>(F.lds, P); }
    } SEAM(7);
    if (IN(8)) { for (int rep = 0; rep < NREP(8); ++rep) { if (rep) xcd_barrier(bar); LAUNDER(); p8_final(F, (NREP(8) == 2 && rep == 0) ? (float*)(F.ws + WS_HID) : FOUT); } }
#ifdef TIME_PHASE
    TSTAMP(9);
    if (F.tid == 0) { const unsigned long long d = tstamp[TIME_PHASE + 1] - tstamp[TIME_PHASE]; const unsigned long long t0 = __builtin_amdgcn_s_memrealtime();
        while (__builtin_amdgcn_s_memrealtime() - t0 < d) __builtin_amdgcn_s_sleep(8); }
#endif
#undef IN
#undef SEAM
}

extern "C" void kernel_launch(void* const* d_in, const int* in_sizes, int n_in, void* d_out, int out_size, void* d_ws, size_t ws_size, hipStream_t stream) {
    static int grid = 0;
    if (grid == 0) {
        if (n_in != 25 || in_sizes[0] != T * DM || out_size != T * DM || ws_size < WS_END) { fprintf(stderr, "kernel_launch: shape/workspace mismatch (n_in %d, in0 %d, out %d, ws %zu < %zu)\n", n_in, n_in > 0 ? in_sizes[0] : -1, out_size, ws_size, (size_t)WS_END); grid = -1; return; }
        int dev = 0, cus = 0, per_cu = 0;
        if (hipGetDevice(&dev) != hipSuccess || hipDeviceGetAttribute(&cus, hipDeviceAttributeMultiprocessorCount, dev) != hipSuccess) { grid = -1; return; }
        if (hipFuncSetAttribute((const void*)fwd_kernel, hipFuncAttributeMaxDynamicSharedMemorySize, LDS_BYTES) != hipSuccess) { fprintf(stderr, "kernel_launch: hipFuncSetAttribute failed\n"); grid = -1; return; }
        if (hipOccupancyMaxActiveBlocksPerMultiprocessor(&per_cu, (const void*)fwd_kernel, NTHR, LDS_BYTES) != hipSuccess || per_cu < 1) fprintf(stderr, "kernel_launch: occupancy query says %d\n", per_cu);
        (void)hipGetLastError();
        grid = cus;
        if (grid != 256) fprintf(stderr, "kernel_launch: %d CUs (built for 256)\n", grid);
    }
    if (grid < 0) return;
    if (hipMemsetAsync((char*)d_ws + WS_CTL, 0, CTL_ZERO_BYTES, stream) != hipSuccess) return;
    Args a{};
    for (int i = 0; i < 25; ++i) a.in[i] = (const float*)d_in[i];
    a.out = (float*)d_out; a.ws = (unsigned char*)d_ws; a.pad = 0;
    if (MK_N_LAUNCHES == 1) {
        a.ph_lo = 0; a.ph_hi = N_PHASES; a.li = 0;
        hipLaunchKernelGGL(fwd_kernel, dim3(grid), dim3(NTHR), LDS_BYTES, stream, a);
    } else {
        for (int li = 0; li < N_PHASES; ++li) { a.ph_lo = li; a.ph_hi = li + 1; a.li = li;
            hipLaunchKernelGGL(fwd_kernel, dim3(grid), dim3(NTHR), LDS_BYTES, stream, a); }
    }
    const hipError_t le = hipPeekAtLastError();
    if (le != hipSuccess) fprintf(stderr, "kernel_launch: launch failed: %s\n", hipGetErrorName(le));
}
```

```cpp
#include <hip/hip_runtime.h>
#include <cstdio>
#include <cstdint>


#ifndef MK_N_LAUNCHES
#define MK_N_LAUNCHES 1
#endif

#define GAS __attribute__((address_space(1)))
#define LAS __attribute__((address_space(3)))
typedef unsigned short bf16;
typedef unsigned v4u __attribute__((ext_vector_type(4)));
typedef unsigned v2u __attribute__((ext_vector_type(2)));
typedef float f32x4 __attribute__((ext_vector_type(4)));
typedef float f32x2 __attribute__((ext_vector_type(2)));
typedef short bf16x8 __attribute__((ext_vector_type(8)));
typedef __bf16 v2bf __attribute__((ext_vector_type(2)));
typedef int v4i __attribute__((ext_vector_type(4)));
typedef int v8i __attribute__((ext_vector_type(8)));

constexpr int NB = 8, SEQ = 2048, DM = 2048, T = NB * SEQ, LC = 256, TC = NB * LC;
constexpr int GW = 64, DC = 1024, NH = 8, HD = 128;
constexpr int NPROJ = 6144, QOFF = 3072, KOFF = 4096, VOFF = 5120;
constexpr int NE = 64, FE = 512, NSLOT = 9;
constexpr float EPS = 1e-6f;
constexpr int NWAVES = 8, NTHR = 512;
constexpr int LIST_CAP = 16384;
constexpr int MAX_TILES = 640;

constexpr size_t MiB = 1u << 20;
constexpr size_t WS_CTL = 0, CTL_ZERO_BYTES = 1 * MiB;
constexpr size_t WS_MOD = 1 * MiB;
constexpr size_t WS_ROPE = 1 * MiB + 512 * 1024;
constexpr size_t WS_RS2 = 1 * MiB + 768 * 1024;
constexpr size_t WS_SSQ = 2 * MiB;
constexpr size_t WS_LIST = 4 * MiB;
constexpr size_t WS_WRH = 13 * MiB, WS_WRL = 13 * MiB + 256 * 1024;
constexpr size_t WS_WDN = 14 * MiB;
constexpr size_t WS_YL = 144 * MiB;
constexpr size_t WS_HID = 208 * MiB;
constexpr size_t WS_WGU = 368 * MiB;
constexpr size_t WS_WIN = 628 * MiB;
constexpr size_t WS_WOUT = 652 * MiB;
constexpr size_t WS_HL = 660 * MiB;
constexpr size_t WS_HC = 724 * MiB;
constexpr size_t WS_KVC = 732 * MiB;
constexpr size_t WS_PROJ = 740 * MiB;
constexpr size_t WS_H2LO = 740 * MiB;
constexpr size_t WS_Y = 932 * MiB;
constexpr size_t WS_H2Q = 932 * MiB;
constexpr size_t WS_SLOT = 368 * MiB;
constexpr size_t WS_TOK = 1008 * MiB;
constexpr size_t WS_END = 1009 * MiB;
static_assert(WS_SLOT + (size_t)MAX_TILES * 256 * DM <= WS_TOK, "slot buffer");
constexpr int CW_BAR = 4096;
constexpr int CW_CNT = 65536;

constexpr int RING_BYTES = 131072;
constexpr int MISC_OFF = RING_BYTES;
constexpr int BARW_OFF = 163840 - 64;
constexpr int LDS_BYTES = 163840;

#define RLX_AGENT __ATOMIC_RELAXED, __HIP_MEMORY_SCOPE_AGENT
#define LDS_WAIT() asm volatile("s_waitcnt lgkmcnt(0)" ::: "memory")
#define VM_WAIT() asm volatile("s_waitcnt vmcnt(0)" ::: "memory")
__device__ __forceinline__ unsigned cvt_pk_bf16(float lo, float hi) { unsigned r; asm volatile("v_cvt_pk_bf16_f32 %0, %1, %2" : "=v"(r) : "v"(lo), "v"(hi)); return r; }
__device__ __forceinline__ float u2f(unsigned u) { return __builtin_bit_cast(float, u); }
__device__ __forceinline__ float bf_lo(unsigned u) { return __builtin_bit_cast(float, u << 16); }
__device__ __forceinline__ float bf_hi(unsigned u) { return __builtin_bit_cast(float, u & 0xffff0000u); }
__device__ __forceinline__ float clamp448(float v) { return fminf(fmaxf(v, -448.0f), 448.0f); }
__device__ __forceinline__ unsigned pack4_fp8(float a, float b, float c, float d) {
    int p = __builtin_amdgcn_cvt_pk_fp8_f32(a, b, 0, false); p = __builtin_amdgcn_cvt_pk_fp8_f32(c, d, p, true); return (unsigned)p; }
__device__ __forceinline__ float wave_sum(float v) {
#pragma unroll
    for (int o = 1; o < 64; o <<= 1) v += __shfl_xor(v, o);
    return v;
}
__device__ __forceinline__ float wave_max(float v) {
#pragma unroll
    for (int o = 1; o < 64; o <<= 1) v = fmaxf(v, __shfl_xor(v, o));
    return v;
}
__device__ __forceinline__ float silu_f(float v) { return v / (1.0f + expf(-v)); }

#define XB_TMO      128
#define XB_XCNT(j)  (256  + 64 * (j))
#define XB_XSUB(j)  (1280 + 64 * (j))
#define XB_XGEN(j)  (2304 + 64 * (j))
#define XB_TOP      3328
#define XB_TOPGEN   3392
#define XCD_BAR_WORDS 3456
#define XB_SPIN_CAP (1u << 18)
__device__ __forceinline__ unsigned xb_ld(unsigned* p)              { return __hip_atomic_load(p, __ATOMIC_RELAXED, __HIP_MEMORY_SCOPE_AGENT); }
__device__ __forceinline__ unsigned xb_add(unsigned* p, unsigned v) { return __hip_atomic_fetch_add(p, v, __ATOMIC_RELAXED, __HIP_MEMORY_SCOPE_AGENT); }
__device__ __forceinline__ unsigned xb_xcc_id() { return (unsigned)__builtin_amdgcn_s_getreg((3 << 11) | 20) & 0xFu; }
#define XB_SPIN(cond, bar) do { unsigned _sp = 0; while (cond) { __builtin_amdgcn_s_sleep(1); \
    if ((++_sp & 255u) == 0u) { if (xb_ld(&(bar)[XB_TMO])) break; if (_sp > XB_SPIN_CAP) { atomicAdd(&(bar)[XB_TMO], 1u); break; } } } } while (0)
struct XcdBarrier { unsigned* bar; unsigned x; volatile LAS unsigned* st; };
__device__ __forceinline__ XcdBarrier xcd_barrier_post(unsigned* bar, volatile LAS unsigned* st) {
    XcdBarrier b; b.bar = bar; b.x = xb_xcc_id(); b.st = st;
    if (threadIdx.x == 0) (void)xb_add(&bar[XB_XCNT(b.x)], 1u);
    return b;
}
__device__ __forceinline__ void xcd_barrier_complete(unsigned* bar, unsigned x, unsigned& nloc, unsigned& nx) {
    const unsigned G = gridDim.x * gridDim.y * gridDim.z;
    unsigned sum, cnt, mine, sp = 0u;
    for (;;) {
        sum = 0u; cnt = 0u; mine = 0u;
#pragma unroll
        for (unsigned j = 0; j < 16; ++j) { const unsigned c = xb_ld(&bar[XB_XCNT(j)]); sum += c; cnt += (c > 0u) ? 1u : 0u; mine = (j == x) ? c : mine; }
        if (sum == G) break;
        __builtin_amdgcn_s_sleep(1);
        if ((++sp & 255u) == 0u) { if (xb_ld(&bar[XB_TMO])) break; if (sp > XB_SPIN_CAP) { atomicAdd(&bar[XB_TMO], 1u); break; } }
    }
    nloc = mine > 0u ? mine : 1u; nx = cnt > 0u ? cnt : 1u;
}
__device__ __forceinline__ void xcd_barrier(const XcdBarrier& b) {
    asm volatile("s_waitcnt vmcnt(0)" ::: "memory");
    __syncthreads();
    if (threadIdx.x == 0) {
        unsigned* bar = b.bar;
        __builtin_amdgcn_s_waitcnt(0);
        unsigned nloc = b.st[0], nx = b.st[1];
        if (nloc == 0u) { xcd_barrier_complete(bar, b.x, nloc, nx); b.st[0] = nloc; b.st[1] = nx; }
        const unsigned old = xb_add(&bar[XB_XSUB(b.x)], 1u);
        const unsigned gen = old / nloc;
        if (old + 1u == (gen + 1u) * nloc) {
            __builtin_amdgcn_fence(__ATOMIC_RELEASE, "agent");
            asm volatile("s_waitcnt vmcnt(0)" ::: "memory");
            const unsigned og = xb_add(&bar[XB_TOP], 1u);
            const unsigned tg = og / nx;
            if (og + 1u == (tg + 1u) * nx) xb_add(&bar[XB_TOPGEN], 1u);
            else XB_SPIN(xb_ld(&bar[XB_TOPGEN]) == tg, bar);
            __builtin_amdgcn_fence(__ATOMIC_ACQUIRE, "agent");
            xb_add(&bar[XB_XGEN(b.x)], 1u);
            asm volatile("s_waitcnt vmcnt(0)" ::: "memory");
        } else {
            XB_SPIN(xb_ld(&bar[XB_XGEN(b.x)]) == gen, bar);
            __builtin_amdgcn_fence(__ATOMIC_ACQUIRE, "agent");
            asm volatile("s_waitcnt vmcnt(0)" ::: "memory");
        }
    }
    __syncthreads();
}

namespace pg8 {
constexpr int BM = 256, BK = 64, HALF = 128, HTB = HALF * BK * 2, STAGE_BYTES = 8 * HTB;
__host__ __device__ __forceinline__ int lds_byte(int r, int c) { const int st = (r >> 4) * 2 + (c >> 5), rr = r & 15, cc = c & 31, ob = rr * 64 + cc * 2; return st * 1024 + (ob ^ (((ob >> 9) & 1) << 5)); }
__host__ __device__ __forceinline__ void stage_rc(int b, int& R, int& C) { const int st = b / 1024, sb = b % 1024, swz = sb ^ (((sb >> 9) & 1) << 5); R = (st >> 1) * 16 + swz / 64; C = (st & 1) * 32 + (swz % 64) / 2; }
__host__ __device__ __forceinline__ int perm32(int rho) { const int n = rho >> 4, i = rho & 15; return 8 * (i >> 2) + 4 * n + (i & 3); }
struct Unit { int pm, pn, g; };

__device__ __forceinline__ int round_unit(int i, int G, int c, int total) {
    const int base = i * G; if (base + c >= total && (total - base) >= G) return -1;
    const int R = (total - base) < G ? (total - base) : G;
    if (R <= 0) return -1;
    if (R == G && (G & 7) == 0) return base + (c & 7) * (G >> 3) + (c >> 3);
    return c < R ? base + c : -1;
}

template <class P>
__device__ __forceinline__ void gemm_phase(LAS unsigned char* lds, const P& p) {
    constexpr int KB = P::KB, nt = KB / (BK * 2);
    const int tid = threadIdx.x, wid = __builtin_amdgcn_readfirstlane(tid >> 6), lane = tid & 63, wr = wid >> 2, wc = wid & 3, fr = lane & 15, fq = lane >> 4;
    unsigned voffB[2], voffA[2];
#pragma unroll
    for (int i = 0; i < 2; ++i) { int R, C; stage_rc(tid * 16 + i * 8192, R, C); const int Rb = P::PERM ? ((R & ~31) + perm32(R & 31)) : R;
        voffA[i] = (unsigned)(R * KB + C * 2); voffB[i] = (unsigned)(Rb * KB + C * 2); }
    LAS unsigned* goffs = (LAS unsigned*)(lds + STAGE_BYTES + 1024);
    constexpr size_t kstep = (size_t)(BK * 2);
    constexpr size_t hstep = (size_t)HALF * KB;
    const unsigned ldsw = (unsigned)wid * 1024u;
    const int aoff = lds_byte(wr * 64 + fr, fq * 8), boff = lds_byte(wc * 32 + fr, fq * 8);
#define PG8_SA(b, h) (((b) * 2 + (h)) * HTB)
#define PG8_SB(b, h) ((4 + (b) * 2 + (h)) * HTB)
#define PG8_STAGE(bufoff, gbase, voff) do { _Pragma("unroll") for (int _i = 0; _i < 2; ++_i) \
        __builtin_amdgcn_global_load_lds((const unsigned*)((const char*)(gbase) + (voff)[_i]), (LAS unsigned*)(lds + (bufoff) + ldsw + _i * 8192), 16, 0, 0); } while (0)
#define PG8_STAGE_A(bufoff, h, nextu, kb) do { if constexpr (P::GATHER) { \
            _Pragma("unroll") for (int _i = 0; _i < 2; ++_i) { const unsigned _o = goffs[((((nextu) ? ui + 1 : ui) & 1) * 4 + (h) * 2 + _i) * 512 + tid]; \
                __builtin_amdgcn_global_load_lds((const unsigned*)(gA + (kb) + _o), (LAS unsigned*)(lds + (bufoff) + ldsw + _i * 8192), 16, 0, 0); } } \
        else { const char* _b = ((nextu) ? nA : cA) + (h) * hstep + (kb); PG8_STAGE(bufoff, _b, voffA); } } while (0)
#define PG8_RD2(p) __builtin_shufflevector(*(const LAS v4i*)(p), *(const LAS v4i*)((p) + 1024), 0, 1, 2, 3, 4, 5, 6, 7)
#define PG8_LDA(dst, b, h) do { _Pragma("unroll") for (int m = 0; m < 4; ++m) dst[m] = PG8_RD2(lds + PG8_SA(b, h) + aoff + m * 2048); } while (0)
#define PG8_LDB(dst, b, h) do { _Pragma("unroll") for (int n = 0; n < 2; ++n) dst[n] = PG8_RD2(lds + PG8_SB(b, h) + boff + n * 2048); } while (0)
#define PG8_LO(x) __builtin_bit_cast(bf16x8, __builtin_shufflevector((x), (x), 0, 1, 2, 3))
#define PG8_HI(x) __builtin_bit_cast(bf16x8, __builtin_shufflevector((x), (x), 4, 5, 6, 7))
#define PG8_MMA(ai, bj, At, Bt) do { __builtin_amdgcn_s_setprio(1); if constexpr (P::FP8) { _Pragma("unroll") for (int m = 0; m < 4; ++m) _Pragma("unroll") for (int n = 0; n < 2; ++n) \
            asm volatile("v_mfma_scale_f32_16x16x128_f8f6f4 %0, %1, %2, %0, %3, %4 op_sel_hi:[0,0,0]" : "+v"(acc[ai][bj][m][n]) : "v"(Bt[n]), "v"(At[m]), "v"(n == 0 ? sclB : sclB1), "v"(sclA)); } \
        else { _Pragma("unroll") for (int m = 0; m < 4; ++m) _Pragma("unroll") for (int n = 0; n < 2; ++n) { \
            acc[ai][bj][m][n] = __builtin_amdgcn_mfma_f32_16x16x32_bf16(PG8_LO(Bt[n]), PG8_LO(At[m]), acc[ai][bj][m][n], 0, 0, 0); \
            acc[ai][bj][m][n] = __builtin_amdgcn_mfma_f32_16x16x32_bf16(PG8_HI(Bt[n]), PG8_HI(At[m]), acc[ai][bj][m][n], 0, 0, 0); } } __builtin_amdgcn_s_setprio(0); } while (0)
#define PG8_WAIT_V(n) asm volatile("s_waitcnt vmcnt(" #n ")" ::: "memory")
#define PG8_WAIT_L(n) asm volatile("s_waitcnt lgkmcnt(" #n ")" ::: "memory")
#define PG8_BAR __builtin_amdgcn_s_barrier()
#define PG8_SCHED __builtin_amdgcn_sched_barrier(0)
    Unit cur, nxt; int ui = 0;
    if (!p.next(0, cur)) return;
    f32x4 acc[2][2][4][2];
#pragma unroll
    for (int a = 0; a < 2; ++a)
#pragma unroll
        for (int b = 0; b < 2; ++b)
#pragma unroll
            for (int m = 0; m < 4; ++m)
#pragma unroll
                for (int n = 0; n < 2; ++n) acc[a][b][m][n] = (f32x4){0.f, 0.f, 0.f, 0.f};
    v8i At[4], B0[2], B1[2];
    int sclA = P::SCALE_A, sclB = P::SCALE_B, sclB1 = P::SCALE_B1; if constexpr (P::FP8) { asm volatile("" : "+v"(sclA), "+v"(sclB), "+v"(sclB1)); }
    const char* cA = p.a_base(cur); const char* cB = p.b_base(cur);
    const char* nA = cA; const char* gA = cA;
    if constexpr (P::GATHER) { p.rows(cur, tid, goffs); p.rows(cur, tid, goffs + 4 * 512); }
    PG8_STAGE(PG8_SB(0, 0), cB, voffB); PG8_STAGE(PG8_SB(0, 1), cB + hstep, voffB); PG8_STAGE_A(PG8_SA(0, 0), 0, false, 0); PG8_STAGE_A(PG8_SA(0, 1), 1, false, 0);
    if (wr == 1) PG8_BAR;
    PG8_WAIT_V(2); PG8_BAR;
    PG8_STAGE(PG8_SB(1, 0), cB + kstep, voffB); PG8_STAGE_A(PG8_SA(1, 0), 0, false, kstep); PG8_STAGE(PG8_SB(1, 1), cB + hstep + kstep, voffB);
    PG8_WAIT_V(6); PG8_BAR;
    for (;;) {
        const bool has_next = p.next(ui + 1, nxt);
        nA = has_next ? p.a_base(nxt) : cA; const char* nB = has_next ? p.b_base(nxt) : cB;
        if constexpr (P::GATHER) { p.rows(has_next ? nxt : cur, tid, goffs + ((ui + 1) & 1) * 4 * 512); }
#pragma unroll 1
        for (int t = 0; t < nt; t += 2) {
            const bool last = (t == nt - 2);
            const size_t k1 = (size_t)(t + 1) * kstep;
            const size_t k2 = last ? 0 : (size_t)(t + 2) * kstep;
            const char* b2 = last ? nB : cB + (size_t)(t + 2) * kstep;
            const size_t k3 = k2 + kstep; const char* b3 = b2 + kstep;
            const bool relax = (P::EPI_STORES > 0) && (t == 0) && (ui > 0);
            PG8_LDB(B0, 0, 0); PG8_LDB(B1, 0, 1); PG8_SCHED; PG8_LDA(At, 0, 0); PG8_STAGE_A(PG8_SA(1, 1), 1, false, k1);
            if (relax) { asm volatile("s_waitcnt vmcnt(%0)" :: "n"(8 + P::EPI_STORES) : "memory"); } else { PG8_WAIT_V(8); } PG8_WAIT_L(0); PG8_BAR; PG8_MMA(0, 0, At, B0); PG8_MMA(0, 1, At, B1); PG8_BAR; PG8_SCHED;
            PG8_LDA(At, 0, 1); PG8_STAGE(PG8_SB(0, 0), b2, voffB); PG8_STAGE(PG8_SB(0, 1), b2 + hstep, voffB); PG8_STAGE_A(PG8_SA(0, 0), 0, last, k2);
            if (relax) { asm volatile("s_waitcnt vmcnt(%0)" :: "n"(8 + P::EPI_STORES) : "memory"); } else { PG8_WAIT_V(8); } PG8_WAIT_L(0); PG8_BAR; PG8_MMA(1, 0, At, B0); PG8_MMA(1, 1, At, B1); PG8_BAR; PG8_SCHED;
            PG8_LDB(B0, 1, 0); PG8_LDB(B1, 1, 1); PG8_SCHED; PG8_LDA(At, 1, 0); PG8_STAGE_A(PG8_SA(0, 1), 1, last, k2);
            PG8_WAIT_V(8); PG8_WAIT_L(0); PG8_BAR; PG8_MMA(0, 0, At, B0); PG8_MMA(0, 1, At, B1); PG8_BAR; PG8_SCHED;
            PG8_LDA(At, 1, 1); PG8_STAGE(PG8_SB(1, 0), b3, voffB); PG8_STAGE(PG8_SB(1, 1), b3 + hstep, voffB); PG8_STAGE_A(PG8_SA(1, 0), 0, last, k3);
            PG8_WAIT_V(8); PG8_WAIT_L(0); PG8_BAR; PG8_MMA(1, 0, At, B0); PG8_MMA(1, 1, At, B1); PG8_BAR; PG8_SCHED;
        }
        if (wr == 0) PG8_BAR;
        if constexpr (P::FP8) { asm volatile("s_nop 15\n\ts_nop 15" ::: "memory"); }
        { int tz = threadIdx.x; asm volatile("" : "+v"(tz));
          const int ewid = tz >> 6, elane = tz & 63; p.epi(acc, cur, ewid >> 2, ewid & 3, elane & 15, elane >> 4); }
        if (!has_next) break;
#pragma unroll
        for (int a = 0; a < 2; ++a)
#pragma unroll
            for (int b = 0; b < 2; ++b)
#pragma unroll
                for (int m = 0; m < 4; ++m)
#pragma unroll
                    for (int n = 0; n < 2; ++n) acc[a][b][m][n] = (f32x4){0.f, 0.f, 0.f, 0.f};
        cur = nxt; cA = nA; cB = nB; ++ui;
        if (wr == 1) PG8_BAR;
    }
    PG8_WAIT_V(0);
    PG8_BAR;
#undef PG8_SA
#undef PG8_SB
#undef PG8_STAGE
#undef PG8_STAGE_A
#undef PG8_LDA
#undef PG8_LDB
#undef PG8_MMA
#undef PG8_LO
#undef PG8_HI
#undef PG8_RD2
#undef PG8_WAIT_V
#undef PG8_WAIT_L
#undef PG8_BAR
#undef PG8_SCHED
}
}

struct KArgs { const float* in[25]; float* out; unsigned char* ws; int ph_lo, ph_hi, li, pad; };
typedef const KArgs __attribute__((address_space(4))) CKArgs;
struct Frame {
    LAS unsigned char* lds;
    int tid, lane, wave, G, bid;
    CKArgs* ka;
    unsigned char* ws;
};
#define FIN(i) (F.ka->in[i])
#define FOUT (F.ka->out)
enum { I_X = 0, I_C, I_CTX, I_CCTX, I_WMOD, I_BMOD, I_GPREMIX, I_GPOSTMIX, I_GPREFFN, I_GPOSTFFN, I_WIN, I_CONVW, I_CONVB, I_RPB, I_GCONV, I_GATTN, I_WOUT, I_WROUTER, I_RBIAS,
       I_WEG, I_WEU, I_WED, I_WSG, I_WSU, I_WSD };

template <class RowMap>
__device__ __forceinline__ void transpose_item(const float* W, int ldn, int K, bf16* WT, LAS float* scr, int kb, int nb, int lane, const RowMap& rm) {
    const int k0 = 64 * kb, n0 = 64 * nb;
    f32x4 v[16];
#pragma unroll
    for (int i = 0; i < 16; ++i) v[i] = *(const GAS f32x4*)(W + (size_t)(k0 + 4 * i + (lane >> 4)) * ldn + n0 + 4 * (lane & 15));
#pragma unroll
    for (int i = 0; i < 16; ++i) { LAS float* d = scr + (4 * i + (lane >> 4)) * 65 + 4 * (lane & 15); d[0] = v[i].x; d[1] = v[i].y; d[2] = v[i].z; d[3] = v[i].w; }
    LDS_WAIT(); asm volatile("" ::: "memory");
    const int c = lane & 7;
#pragma unroll
    for (int j = 0; j < 8; ++j) { const int n = (lane >> 3) + 8 * j; const LAS float* s = scr + (8 * c) * 65 + n;
        v4u o; o.x = cvt_pk_bf16(s[0 * 65], s[1 * 65]); o.y = cvt_pk_bf16(s[2 * 65], s[3 * 65]); o.z = cvt_pk_bf16(s[4 * 65], s[5 * 65]); o.w = cvt_pk_bf16(s[6 * 65], s[7 * 65]);
        *(GAS v4u*)(WT + (size_t)rm(n0 + n) * K + k0 + 8 * c) = o; }
    LDS_WAIT(); asm volatile("" ::: "memory");
}
template <class RowMap>
__device__ __forceinline__ void transpose_item_fp8(const float* W, int ldn, int KBrow, unsigned char* WT, LAS float* scr, int kb, int nb, int lane, const RowMap& rm, float scale) {
    const int k0 = 64 * kb, n0 = 64 * nb;
    f32x4 v[16];
#pragma unroll
    for (int i = 0; i < 16; ++i) v[i] = *(const GAS f32x4*)(W + (size_t)(k0 + 4 * i + (lane >> 4)) * ldn + n0 + 4 * (lane & 15));
#pragma unroll
    for (int i = 0; i < 16; ++i) { LAS float* d = scr + (4 * i + (lane >> 4)) * 65 + 4 * (lane & 15); d[0] = v[i].x * scale; d[1] = v[i].y * scale; d[2] = v[i].z * scale; d[3] = v[i].w * scale; }
    LDS_WAIT(); asm volatile("" ::: "memory");
    const int c = lane & 3;
#pragma unroll
    for (int j = 0; j < 4; ++j) { const int n = (lane >> 2) + 16 * j; const LAS float* s = scr + (16 * c) * 65 + n;
        v4u o; o.x = pack4_fp8(s[0 * 65], s[1 * 65], s[2 * 65], s[3 * 65]); o.y = pack4_fp8(s[4 * 65], s[5 * 65], s[6 * 65], s[7 * 65]);
        o.z = pack4_fp8(s[8 * 65], s[9 * 65], s[10 * 65], s[11 * 65]); o.w = pack4_fp8(s[12 * 65], s[13 * 65], s[14 * 65], s[15 * 65]);
        *(GAS v4u*)(WT + (size_t)rm(n0 + n) * KBrow + k0 + 16 * c) = o; }
    LDS_WAIT(); asm volatile("" ::: "memory");
}
struct RmIdent { int off; __device__ __forceinline__ int operator()(int n) const { return off + n; } };
struct RmWin {
    __device__ __forceinline__ int operator()(int n) const {
        if (n < QOFF || n >= VOFF) return n;
        const int nn = n & 127, axis = nn >> 6, half = (nn >> 5) & 1, f = nn & 31;
        return (n - nn) + 2 * (axis * 32 + f) + half; }
};
struct RmGU { int base; int up; __device__ __forceinline__ int operator()(int f) const { return base + 32 * (f >> 4) + 16 * up + (f & 15); } };

constexpr int NF8 = 195 * 256;
constexpr int CONV_SCR = 17024;
__device__ __forceinline__ void conv_fp8_items(Frame& F, int it_lo, int it_hi, int gw, int NGW) {
    LAS float* scr = (LAS float*)(F.lds + F.wave * CONV_SCR);
    LAS unsigned long long* ptab = (LAS unsigned long long*)(F.lds + 8 * CONV_SCR);
    __syncthreads();
    if (F.tid == 0) { ptab[0] = (unsigned long long)FIN(I_WEG); ptab[1] = (unsigned long long)FIN(I_WEU); ptab[2] = (unsigned long long)FIN(I_WED);
        ptab[3] = (unsigned long long)FIN(I_WSG); ptab[4] = (unsigned long long)FIN(I_WSU); ptab[5] = (unsigned long long)FIN(I_WSD); }
    __syncthreads();
    const int lr = F.lane >> 3, lc = 4 * (F.lane & 7);
    f32x4 v[16], vn[16];
#define F8_DECODE(it_, kind_, e_, isdn_, k0_, n0_) const int _mi = (it_) >> 8, _q = (it_) & 255; const int kind_ = _mi < 192 ? (_mi >> 6) : (_mi - 189); const int e_ = _mi < 192 ? (_mi & 63) : 0; \
    const bool isdn_ = (kind_ == 2 || kind_ == 5); const int k0_ = 128 * (isdn_ ? (_q >> 6) : (_q >> 4)), n0_ = 32 * (isdn_ ? (_q & 63) : (_q & 15));
#define F8_LOAD(dst_, it_) do { F8_DECODE(it_, _kind, _e, _isdn, _k0, _n0) const float* _W = (const float*)ptab[_kind] + (size_t)_e * DM * FE; const int _ldn = _isdn ? DM : FE; \
    _Pragma("unroll") for (int i = 0; i < 16; ++i) dst_[i] = __builtin_nontemporal_load((const GAS f32x4*)(_W + (size_t)(_k0 + 8 * i + lr) * _ldn + _n0 + lc)); } while (0)
    f32x4 vnn[16];
    int it = it_lo + gw;
    if (it < it_hi) F8_LOAD(v, it);
    if (it + NGW < it_hi) F8_LOAD(vn, it + NGW);
    for (; it < it_hi; it += NGW) {
        const int itn = it + 2 * NGW;
        if (itn < it_hi) F8_LOAD(vnn, itn);
        {
            F8_DECODE(it, kind, e, isdn, k0, n0)
            const float scale = isdn ? 32.0f : 64.0f; const int KBrow = isdn ? FE : DM; unsigned char* WT = isdn ? (F.ws + WS_WDN) : (F.ws + WS_WGU);
            const int ee = kind < 3 ? e : 64; const int up = (kind == 1 || kind == 4) ? 16 : 0;
#pragma unroll
            for (int i = 0; i < 16; ++i) { LAS float* d = scr + (8 * i + lr) * 33 + (i >> 1) * 4 + lc; d[0] = v[i].x * scale; d[1] = v[i].y * scale; d[2] = v[i].z * scale; d[3] = v[i].w * scale; }
            LDS_WAIT(); asm volatile("" ::: "memory");
            const int c = F.lane >> 3;
#pragma unroll
            for (int j = 0; j < 4; ++j) { const int n = (F.lane & 7) + 8 * j; const LAS float* sp = scr + (16 * c) * 33 + 4 * c + n; const int nn = n0 + n;
                const int drow = isdn ? (ee * 2048 + (nn & ~255) + 128 * ((nn >> 3) & 1) + 32 * ((nn >> 6) & 3) + 16 * ((nn >> 2) & 1) + 4 * ((nn >> 4) & 3) + (nn & 3))
                                      : (ee * 1024 + 2 * (nn & ~127) + 128 * ((nn >> 2) & 1) + 32 * ((nn >> 5) & 3) + up + 4 * ((nn >> 3) & 3) + (nn & 3));
                v4u o; o.x = pack4_fp8(sp[0 * 33], sp[1 * 33], sp[2 * 33], sp[3 * 33]); o.y = pack4_fp8(sp[4 * 33], sp[5 * 33], sp[6 * 33], sp[7 * 33]);
                o.z = pack4_fp8(sp[8 * 33], sp[9 * 33], sp[10 * 33], sp[11 * 33]); o.w = pack4_fp8(sp[12 * 33], sp[13 * 33], sp[14 * 33], sp[15 * 33]);
                __builtin_nontemporal_store(o, (GAS v4u*)(WT + (size_t)drow * KBrow + k0 + 16 * c)); }
            LDS_WAIT(); asm volatile("" ::: "memory");
        }
#pragma unroll
        for (int i = 0; i < 16; ++i) { v[i] = vn[i]; vn[i] = vnn[i]; }
    }
#undef F8_DECODE
#undef F8_LOAD
}

constexpr int NITB = 32 * 96 + 32 * 32;
__device__ __forceinline__ void conv_bf16_items(Frame& F, int it_lo, int it_hi, int gw, int NGW) {
    LAS float* scr = (LAS float*)(F.lds + F.wave * CONV_SCR);
    LAS unsigned long long* ptab = (LAS unsigned long long*)(F.lds + 8 * CONV_SCR);
    __syncthreads();
    if (F.tid == 0) { ptab[0] = (unsigned long long)FIN(I_WIN); ptab[1] = (unsigned long long)FIN(I_WOUT); }
    __syncthreads();
    constexpr int IT_IN = 32 * 96;
    f32x4 v[16], vn[16];
#define B16_DECODE(it_, isout_, k0_, n0_, ldn_) const bool isout_ = (it_) >= IT_IN; const int _r = isout_ ? (it_) - IT_IN : (it_); const int ldn_ = isout_ ? DM : NPROJ; \
    const int k0_ = 64 * (isout_ ? (_r >> 5) : (_r / 96)), n0_ = 64 * (isout_ ? (_r & 31) : (_r % 96));
#define B16_LOAD(dst_, it_) do { B16_DECODE(it_, _io, _k0, _n0, _ldn) const float* _W = (const float*)ptab[_io ? 1 : 0]; \
    _Pragma("unroll") for (int i = 0; i < 16; ++i) dst_[i] = *(const GAS f32x4*)(_W + (size_t)(_k0 + 4 * i + (F.lane >> 4)) * _ldn + _n0 + 4 * (F.lane & 15)); } while (0)
    int it = it_lo + gw;
    if (it < it_hi) B16_LOAD(v, it);
    for (; it < it_hi; it += NGW) {
        if (it + NGW < it_hi) B16_LOAD(vn, it + NGW);
        {
            B16_DECODE(it, isout, k0, n0, ldn)
            bf16* WT = (bf16*)(F.ws + (isout ? WS_WOUT : WS_WIN));
#pragma unroll
            for (int i = 0; i < 16; ++i) { LAS float* d = scr + (4 * i + (F.lane >> 4)) * 65 + 4 * (F.lane & 15); d[0] = v[i].x; d[1] = v[i].y; d[2] = v[i].z; d[3] = v[i].w; }
            LDS_WAIT(); asm volatile("" ::: "memory");
            const int c = F.lane & 7;
#pragma unroll
            for (int j = 0; j < 8; ++j) { const int n = (F.lane >> 3) + 8 * j; const LAS float* sp = scr + (8 * c) * 65 + n;
                const int nn = n0 + n; const int drow = isout ? nn : RmWin{}(nn);
                v4u o; o.x = cvt_pk_bf16(sp[0 * 65], sp[1 * 65]); o.y = cvt_pk_bf16(sp[2 * 65], sp[3 * 65]); o.z = cvt_pk_bf16(sp[4 * 65], sp[5 * 65]); o.w = cvt_pk_bf16(sp[6 * 65], sp[7 * 65]);
                *(GAS v4u*)(WT + (size_t)drow * DM + k0 + 8 * c) = o; }
            LDS_WAIT(); asm volatile("" ::: "memory");
        }
#pragma unroll
        for (int i = 0; i < 16; ++i) v[i] = vn[i];
    }
#undef B16_DECODE
#undef B16_LOAD
}

#ifndef P0_MOD_WGS
#define P0_MOD_WGS 192
#endif
#ifndef P0_B16_STAGE1
#define P0_B16_STAGE1 2560
#endif
__device__ __forceinline__ void p0_prologue(Frame& F) {
    const int gw = F.bid * NWAVES + F.wave, NGW = F.G * NWAVES;
    if (F.tid < 8) {
        GAS f32x2* rope = (GAS f32x2*)(F.ws + WS_ROPE);
        for (int i = F.bid * 8 + F.tid; i < 64 * 32; i += F.G * 8) { const int pos = i >> 5, f = i & 31;
            const float inv = powf(10000.0f, -(float)f / 32.0f); const float ang = (float)pos * inv;
            rope[i] = (f32x2){(float)cos((double)ang), (float)sin((double)ang)}; }
    }
    {
        const int idx = F.bid * NTHR + F.tid;
        if (idx < DM * NE) { const int k = idx >> 6, n = idx & 63; const float v = FIN(I_WROUTER)[idx];
            const unsigned hi = cvt_pk_bf16(v, 0.f) & 0xffffu; const float rem = v - bf_lo(hi);
            ((bf16*)(F.ws + WS_WRH))[(size_t)n * DM + k] = (bf16)hi; ((bf16*)(F.ws + WS_WRL))[(size_t)n * DM + k] = (bf16)(cvt_pk_bf16(rem, 0.f) & 0xffffu); }
    }
    if (F.bid < P0_MOD_WGS) {
        LAS float* act = (LAS float*)F.lds;
        LAS float* red = (LAS float*)(F.lds + 9 * 2048 * 4);
        for (int i = F.tid; i < 9 * 2048; i += NTHR) { const int r = i >> 11, k = i & 2047; const float v = r < 8 ? FIN(I_C)[r * 2048 + k] : FIN(I_CCTX)[k]; act[i] = silu_f(v); }
        __syncthreads();
        const float* wm = FIN(I_WMOD);
        for (int cb = F.bid; cb < 192; cb += P0_MOD_WGS) {
            const int kq = F.wave * 4 + (F.lane >> 4), cq = F.lane & 15;
            f32x4 a[9];
#pragma unroll
            for (int r = 0; r < 9; ++r) a[r] = (f32x4){0.f, 0.f, 0.f, 0.f};
            for (int kb = kq; kb < 2048; kb += 512) {
                f32x4 w[16];
#pragma unroll
                for (int u = 0; u < 16; ++u) w[u] = *(const GAS f32x4*)(wm + (size_t)(kb + 32 * u) * 12288 + cb * 64 + cq * 4);
#pragma unroll
                for (int u = 0; u < 16; ++u)
#pragma unroll
                    for (int r = 0; r < 9; ++r) a[r] += w[u] * act[r * 2048 + kb + 32 * u]; }
#pragma unroll
            for (int r = 0; r < 9; ++r) { f32x4 s = a[r];
#pragma unroll
                for (int o = 16; o < 64; o <<= 1) { f32x4 t; t.x = __shfl_xor(s.x, o); t.y = __shfl_xor(s.y, o); t.z = __shfl_xor(s.z, o); t.w = __shfl_xor(s.w, o); s += t; }
                if (F.lane < 16) *(LAS f32x4*)(red + (F.wave * 9 + r) * 64 + F.lane * 4) = s; }
            __syncthreads();
            for (int i = F.tid; i < 9 * 64; i += NTHR) { const int r = i >> 6, cc = i & 63; float s = 0.f;
#pragma unroll
                for (int w = 0; w < 8; ++w) s += red[(w * 9 + r) * 64 + cc];
                ((GAS float*)(F.ws + WS_MOD))[r * 12288 + cb * 64 + cc] = s + FIN(I_BMOD)[cb * 64 + cc]; }
            __syncthreads();
        }
    } else conv_bf16_items(F, 0, P0_B16_STAGE1, (F.bid - P0_MOD_WGS) * NWAVES + F.wave, (F.G - P0_MOD_WGS) * NWAVES);
    conv_bf16_items(F, P0_B16_STAGE1, NITB, gw, NGW);
}

__device__ __forceinline__ void p1_norm(Frame& F, int row_lo, int row_hi, int gw, int NGW) {
    const float* MOD = (const float*)(F.ws + WS_MOD); const float* g = FIN(I_GPREMIX);
    for (int row = row_lo + gw; row < row_hi; row += NGW) {
        const bool lat = row < T; const int rr = lat ? row : row - T;
        const float* xr = (lat ? FIN(I_X) : FIN(I_CTX)) + (size_t)rr * DM;
        const float* md = MOD + (size_t)(lat ? (rr >> 11) : 8) * 12288;
        bf16* orow = (bf16*)(F.ws + (lat ? WS_HL : WS_HC)) + (size_t)rr * DM;
        f32x4 v[8]; float ss = 0.f;
#pragma unroll
        for (int j = 0; j < 8; ++j) { v[j] = *(const GAS f32x4*)(xr + 4 * F.lane + 256 * j); ss += (v[j].x * v[j].x + v[j].y * v[j].y) + (v[j].z * v[j].z + v[j].w * v[j].w); }
        const float rstd = 1.0f / sqrtf(wave_sum(ss) * (1.0f / DM) + EPS);
#pragma unroll
        for (int j = 0; j < 8; ++j) { const int c = 4 * F.lane + 256 * j;
            const f32x4 gg = *(const GAS f32x4*)(g + c), sh = *(const GAS f32x4*)(md + c), sc = *(const GAS f32x4*)(md + 2048 + c);
            const f32x4 o = (v[j] * rstd) * gg * (sc + 1.0f) + sh;
            *(GAS v2u*)(orow + c) = (v2u){cvt_pk_bf16(o.x, o.y), cvt_pk_bf16(o.z, o.w)}; }
    }
}

struct ProbProj {
    static constexpr int K = DM, KB = DM * 2, SCALE_A = 0, SCALE_B = 0, SCALE_B1 = 0, EPI_STORES = 16; static constexpr bool GATHER = false, PERM = true, FP8 = false;
    const bf16 *HL, *HC, *Win; bf16 *PROJ, *KVC; const f32x2* rope; int G, c, base, total;
    static constexpr int NMAIN = 64 * 24;
    __device__ __forceinline__ bool next(int i, pg8::Unit& u) const {
        int w = pg8::round_unit(i, G, c, total); if (w < 0) return false; w += base;
        if (w < NMAIN) { const int gid = w / 192, r = w % 192; u.pm = gid * 8 + (r & 7); u.pn = r >> 3; u.g = 0; }
        else { const int j = w - NMAIN; u.pm = j & 7; u.pn = 16 + (j >> 3); u.g = 1; }
        return true; }
    __device__ __forceinline__ const char* a_base(const pg8::Unit& u) const { return (const char*)HL + (size_t)u.g * (size_t)(WS_HC - WS_HL) + (size_t)u.pm * 256 * K * 2; }
    __device__ __forceinline__ const char* b_base(const pg8::Unit& u) const { return (const char*)Win + (size_t)u.pn * 256 * K * 2; }
    __device__ __forceinline__ void rows(const pg8::Unit&, int, LAS unsigned*) const {}
    __device__ __forceinline__ void epi(const f32x4 (&acc)[2][2][4][2], const pg8::Unit& u, int wr, int wc, int fr, int fq) const {
        const int row0 = u.pm * 256 + wr * 64 + fr;
        const bool rot = (u.g == 0) && (u.pn >= 12) && (u.pn < 20);
        bf16* base = (bf16*)((char*)PROJ + (long)u.g * ((long)WS_KVC - (long)WS_PROJ));
        const int ldc = NPROJ - u.g * (NPROJ - DM), col0 = (u.pn - 16 * u.g) * 256 + wc * 32 + 8 * fq;
        const int p0 = (wc * 32 + 8 * fq) >> 1, axis = p0 >> 5, f0 = p0 & 31;
#pragma unroll
        for (int ai = 0; ai < 2; ++ai)
#pragma unroll
            for (int m = 0; m < 4; ++m) {
                const int row = row0 + ai * 128 + m * 16; bf16* rowp = base + (size_t)row * ldc + col0;
                const int t = row & (SEQ - 1); const int pos = axis ? (t & 63) : (t >> 6);
                const f32x4 csA = *(const GAS f32x4*)(rope + pos * 32 + f0), csB = *(const GAS f32x4*)(rope + pos * 32 + f0 + 2);
                const f32x2 cs0 = (f32x2){csA.x, csA.y}, cs1 = (f32x2){csA.z, csA.w}, cs2 = (f32x2){csB.x, csB.y}, cs3 = (f32x2){csB.z, csB.w};
#pragma unroll
                for (int bj = 0; bj < 2; ++bj) { f32x4 v0 = acc[ai][bj][m][0], v1 = acc[ai][bj][m][1];
                    if (rot) { f32x4 r0, r1;
                        r0.x = v0.x * cs0.x - v0.y * cs0.y; r0.y = v0.y * cs0.x + v0.x * cs0.y;
                        r0.z = v0.z * cs1.x - v0.w * cs1.y; r0.w = v0.w * cs1.x + v0.z * cs1.y;
                        r1.x = v1.x * cs2.x - v1.y * cs2.y; r1.y = v1.y * cs2.x + v1.x * cs2.y;
                        r1.z = v1.z * cs3.x - v1.w * cs3.y; r1.w = v1.w * cs3.x + v1.z * cs3.y; v0 = r0; v1 = r1; }
                    v4u w; w.x = cvt_pk_bf16(v0.x, v0.y); w.y = cvt_pk_bf16(v0.z, v0.w); w.z = cvt_pk_bf16(v1.x, v1.y); w.w = cvt_pk_bf16(v1.z, v1.w);
                    *(GAS v4u*)(rowp + bj * 128) = w; } }
    }
};

__device__ __forceinline__ float dot2bf(unsigned a, unsigned b, float c) { return __builtin_amdgcn_fdot2_f32_bf16(__builtin_bit_cast(v2bf, a), __builtin_bit_cast(v2bf, b), c, false); }
__device__ __forceinline__ void p3_attn_simple(Frame& F) {
    const bf16* PROJ = (const bf16*)(F.ws + WS_PROJ); const bf16* KVC = (const bf16*)(F.ws + WS_KVC); bf16* Y = (bf16*)(F.ws + WS_Y);
    const float* rpb = FIN(I_RPB); const float* gat = FIN(I_GATTN);
    const float scale = 0.08838834764831845f;
    const int per = (T * NH) / F.G;
    for (int i = F.wave; i < per; i += NWAVES) {
        const int task = F.bid * per + i; const int t = task & (SEQ - 1), bh = task >> 11, h = bh & 7, b = bh >> 3;
        const int r = t >> 6, c = t & 63; int r0 = r - 4; r0 = r0 < 0 ? 0 : (r0 > 24 ? 24 : r0); int cs = c - 8; cs = cs < 0 ? 0 : (cs > 48 ? 48 : cs);
        const unsigned qv = *(const GAS unsigned*)(PROJ + (size_t)(b * SEQ + t) * NPROJ + QOFF + h * HD + 2 * F.lane);
        const bf16* kp[6]; float sc[6];
#pragma unroll
        for (int j = 0; j < 6; ++j) { const int n = F.lane + 64 * j;
            if (j < 2) { const int ii = n >> 4, jj = n & 15; const int tk = (r0 + ii) * GW + cs + jj; kp[j] = PROJ + (size_t)(b * SEQ + tk) * NPROJ + KOFF + h * HD; }
            else kp[j] = KVC + (size_t)(b * LC + (n - 128)) * DM + h * HD;
            sc[j] = 0.f; }
#pragma unroll 4
        for (int pc = 0; pc < 16; ++pc) {
            v4u kk[6];
#pragma unroll
            for (int j = 0; j < 6; ++j) kk[j] = *(const GAS v4u*)(kp[j] + 8 * pc);
            const unsigned q0 = __builtin_amdgcn_readlane(qv, 4 * pc), q1 = __builtin_amdgcn_readlane(qv, 4 * pc + 1), q2 = __builtin_amdgcn_readlane(qv, 4 * pc + 2), q3 = __builtin_amdgcn_readlane(qv, 4 * pc + 3);
#pragma unroll
            for (int j = 0; j < 6; ++j) { sc[j] = dot2bf(q0, kk[j].x, sc[j]); sc[j] = dot2bf(q1, kk[j].y, sc[j]); sc[j] = dot2bf(q2, kk[j].z, sc[j]); sc[j] = dot2bf(q3, kk[j].w, sc[j]); }
        }
        float mx = -1e30f;
#pragma unroll
        for (int j = 0; j < 6; ++j) { sc[j] *= scale;
            if (j < 2) { const int n = F.lane + 64 * j, ii = n >> 4, jj = n & 15; sc[j] += rpb[(h * 15 + (r0 + ii - r + 7)) * 31 + (cs + jj - c + 15)]; }
            mx = fmaxf(mx, sc[j]); }
        mx = wave_max(mx);
        float ps = 0.f;
#pragma unroll
        for (int j = 0; j < 6; ++j) { sc[j] = __expf(sc[j] - mx); ps += sc[j]; }
        ps = wave_sum(ps);
        float o0 = 0.f, o1 = 0.f;
        const bf16* vl = PROJ + (size_t)(b * SEQ) * NPROJ + VOFF + h * HD + 2 * F.lane;
        const bf16* vc = KVC + (size_t)(b * LC) * DM + DC + h * HD + 2 * F.lane;
#pragma unroll
        for (int j = 0; j < 6; ++j) {
#pragma unroll 8
            for (int l = 0; l < 64; ++l) { const int n = l + 64 * j; const float p = __builtin_bit_cast(float, __builtin_amdgcn_readlane(__builtin_bit_cast(unsigned, sc[j]), l));
                unsigned vv;
                if (j < 2) { const int tk = (r0 + (n >> 4)) * GW + cs + (n & 15); vv = *(const GAS unsigned*)(vl + (size_t)tk * NPROJ); }
                else vv = *(const GAS unsigned*)(vc + (size_t)(n - 128) * DM);
                o0 += p * bf_lo(vv); o1 += p * bf_hi(vv); }
        }
        const float inv = 1.0f / ps; o0 *= inv; o1 *= inv;
        const float rstd = 1.0f / sqrtf(wave_sum(o0 * o0 + o1 * o1) * (1.0f / HD) + EPS);
        const f32x2 gg = *(const GAS f32x2*)(gat + h * HD + 2 * F.lane);
        *(GAS unsigned*)(Y + (size_t)(b * SEQ + t) * DM + DC + h * HD + 2 * F.lane) = cvt_pk_bf16(o0 * rstd * gg.x, o1 * rstd * gg.y);
    }
}

namespace at {
typedef short s16x4 __attribute__((ext_vector_type(4)));
typedef float f32x16 __attribute__((ext_vector_type(16)));
constexpr float SCALE = 0.088388347648318440f;
constexpr float THR = 8.f;
constexpr int SHM_V = 64 * 128 * 2, SHM_K = 64 * 128 * 2;
constexpr int WS_OFF = 2 * SHM_V + 2 * SHM_K, BT_OFF = WS_OFF + 8 * 64 * 4, BT_FLOATS = 15 * 32 + 192;
#define KSWZ(row, colB) ((row) * 256 + ((colB) ^ (((row) & 7) << 4)))
#define SBAR() __builtin_amdgcn_sched_barrier(0)
__device__ __forceinline__ int crow(int r, int hi) { return (r & 3) + 8 * (r >> 2) + 4 * hi; }
__device__ __forceinline__ void partialSM(f32x16& p0, f32x16& p1, float& m_reg, float& mn, float& alpha) {
  constexpr float C = SCALE * 1.4426950408889634f;
  float pmax = p0[0];
#pragma unroll
  for (int r = 1; r < 16; ++r) pmax = fmaxf(pmax, p0[r]);
#pragma unroll
  for (int r = 0; r < 16; ++r) pmax = fmaxf(pmax, p1[r]);
  { auto rr = __builtin_amdgcn_permlane32_swap(__builtin_bit_cast(unsigned, pmax), __builtin_bit_cast(unsigned, pmax), false, false);
    pmax = fmaxf(u2f(rr[0]), u2f(rr[1])); }
  if (__builtin_expect(__all(pmax - m_reg <= THR / SCALE), 1)) { mn = m_reg; alpha = 1.f; }
  else { mn = fmaxf(m_reg, pmax); alpha = __builtin_amdgcn_exp2f((m_reg - mn) * C); m_reg = mn; }
  const float mnC = -mn * C;
#pragma unroll
  for (int r = 0; r < 16; ++r) p0[r] = fmaf(p0[r], C, mnC);
#pragma unroll
  for (int r = 0; r < 16; ++r) p1[r] = fmaf(p1[r], C, mnC);
#pragma unroll
  for (int r = 0; r < 16; ++r) p0[r] = __builtin_amdgcn_exp2f(p0[r]);
}
__device__ __forceinline__ void finishSM(f32x16& p0, f32x16& p1, float alpha, float& l_reg, bf16x8& pa0, bf16x8& pa1, bf16x8& pa2, bf16x8& pa3) {
#pragma unroll
  for (int r = 0; r < 16; ++r) p1[r] = __builtin_amdgcn_exp2f(p1[r]);
  float ps = 0;
#pragma unroll
  for (int r = 0; r < 16; ++r) ps += p0[r];
#pragma unroll
  for (int r = 0; r < 16; ++r) ps += p1[r];
  { auto rr = __builtin_amdgcn_permlane32_swap(__builtin_bit_cast(unsigned, ps), __builtin_bit_cast(unsigned, ps), false, false);
    ps = u2f(rr[0]) + u2f(rr[1]); }
  l_reg = l_reg * alpha + ps;
#define PK4(P, BASE, OUT) do { unsigned a0 = cvt_pk_bf16(P[BASE + 0], P[BASE + 1]), a1 = cvt_pk_bf16(P[BASE + 2], P[BASE + 3]);   \
    unsigned b0 = cvt_pk_bf16(P[BASE + 4], P[BASE + 5]), b1 = cvt_pk_bf16(P[BASE + 6], P[BASE + 7]);                              \
    auto r0 = __builtin_amdgcn_permlane32_swap(a0, b0, false, false); auto r1 = __builtin_amdgcn_permlane32_swap(a1, b1, false, false); \
    v4u w = {r0[0], r1[0], r0[1], r1[1]}; OUT = __builtin_bit_cast(bf16x8, w); } while (0)
  PK4(p0, 0, pa0); PK4(p0, 8, pa1); PK4(p1, 0, pa2); PK4(p1, 8, pa3);
#undef PK4
}
__device__ __forceinline__ void qkt(f32x16& p0, f32x16& p1, const LAS char* Ks, const bf16x8* qr, int r32, int hi) {
  p0 = f32x16{}; p1 = f32x16{};
#pragma unroll
  for (int d0 = 0; d0 < 8; ++d0) { const int cb = (d0 * 16 + hi * 8) * 2;
    const bf16x8 b0 = *(const LAS bf16x8*)(Ks + KSWZ(r32, cb));
    const bf16x8 b1 = *(const LAS bf16x8*)(Ks + KSWZ(32 + r32, cb));
    p0 = __builtin_amdgcn_mfma_f32_32x32x16_bf16(b0, qr[d0], p0, 0, 0, 0);
    p1 = __builtin_amdgcn_mfma_f32_32x32x16_bf16(b1, qr[d0], p1, 0, 0, 0); }
}
__device__ __forceinline__ int v_st(int k, int c) { const int kk = (k & ~0xC) | ((k & 4) << 1) | ((k & 8) >> 1); return ((kk >> 3) * 4 + (c >> 5)) * 512 + ((kk & 7) * 32 + (c & 31)) * 2; }
__device__ __forceinline__ int v_rd_base(int lane) { return ((lane & 3) << 3) | (((lane >> 2) & 3) << 6) | (((lane >> 4) & 1) << 5) | (((lane >> 5) & 1) << 8); }
constexpr int v_rd_off(int d0, int ks, int half) { return d0 * 512 + ks * 4096 + half * 2048; }
template <int OFF> __device__ __forceinline__ s16x4 tr_read(int vb) {
  s16x4 r; asm volatile("ds_read_b64_tr_b16 %0, %1 offset:%2" : "=&v"(r) : "v"(vb), "i"(OFF) : "memory"); return r;
}
template <int D0> __device__ __forceinline__ void pv_one(f32x16& od, int vb, bf16x8 pa0, bf16x8 pa1, bf16x8 pa2, bf16x8 pa3) {
  const s16x4 l0 = tr_read<v_rd_off(D0, 0, 0)>(vb), h0 = tr_read<v_rd_off(D0, 0, 1)>(vb), l1 = tr_read<v_rd_off(D0, 1, 0)>(vb), h1 = tr_read<v_rd_off(D0, 1, 1)>(vb);
  const s16x4 l2 = tr_read<v_rd_off(D0, 2, 0)>(vb), h2 = tr_read<v_rd_off(D0, 2, 1)>(vb), l3 = tr_read<v_rd_off(D0, 3, 0)>(vb), h3 = tr_read<v_rd_off(D0, 3, 1)>(vb);
  asm volatile("s_waitcnt lgkmcnt(0)" ::: "memory"); SBAR();
#define PK(L, H) (bf16x8){L[0], L[1], L[2], L[3], H[0], H[1], H[2], H[3]}
  od = __builtin_amdgcn_mfma_f32_32x32x16_bf16(pa0, PK(l0, h0), od, 0, 0, 0);
  od = __builtin_amdgcn_mfma_f32_32x32x16_bf16(pa1, PK(l1, h1), od, 0, 0, 0);
  od = __builtin_amdgcn_mfma_f32_32x32x16_bf16(pa2, PK(l2, h2), od, 0, 0, 0);
  od = __builtin_amdgcn_mfma_f32_32x32x16_bf16(pa3, PK(l3, h3), od, 0, 0, 0);
#undef PK
}
__device__ __forceinline__ void pv_d0(f32x16* o, int vb, bf16x8 pa0, bf16x8 pa1, bf16x8 pa2, bf16x8 pa3) {
  pv_one<0>(o[0], vb, pa0, pa1, pa2, pa3); pv_one<1>(o[1], vb, pa0, pa1, pa2, pa3); pv_one<2>(o[2], vb, pa0, pa1, pa2, pa3); pv_one<3>(o[3], vb, pa0, pa1, pa2, pa3);
}
__device__ __forceinline__ void bias_mask(f32x16& p0, f32x16& p1, const LAS float* bt, int j, int kr_lo, int rq, int r0w, int c, int cs, int hi) {
  if (j < 4) return;
  const int kr = kr_lo + (j - 4);
  if (kr < r0w || kr > r0w + 7) {
#pragma unroll
    for (int r = 0; r < 16; ++r) { p0[r] = -1e30f; p1[r] = -1e30f; }
    return; }
  const LAS float* bp = bt + 64 + (kr - rq + 7) * 32 + 15 - c + 4 * hi;
  const int kc0 = 4 * hi - cs;
#pragma unroll
  for (int r = 0; r < 16; ++r) { const int KC = (r & 3) + 8 * (r >> 2);
    const float b0 = bp[KC], b1 = bp[KC + 32];
    p0[r] = ((unsigned)(kc0 + KC) < 16u) ? p0[r] + b0 : -1e30f;
    p1[r] = ((unsigned)(kc0 + KC + 32) < 16u) ? p1[r] + b1 : -1e30f;
    if ((r & 3) == 3) asm volatile("" ::: "memory"); }
}
}

__device__ __forceinline__ void attn_unit(Frame& F, int b, int h, int g) {
  using namespace at;
  const bf16* PROJ = (const bf16*)(F.ws + WS_PROJ); const bf16* KVC = (const bf16*)(F.ws + WS_KVC); bf16* Y = (bf16*)(F.ws + WS_Y);
  const int tid = F.tid, wid = F.wave, lane = F.lane, r32 = lane & 31, hi = lane >> 5;
  const LAS char* ldsc = (const LAS char*)F.lds;
  LAS char* V_lds = (LAS char*)F.lds; LAS char* K_lds = (LAS char*)F.lds + 2 * SHM_V;
  LAS float* wsl = (LAS float*)(F.lds + WS_OFF) + wid * 64; LAS float* li_l = wsl; LAS float* al_l = wsl + 32;
  LAS float* bt = (LAS float*)(F.lds + BT_OFF);
  const int nloc = (g == 0 || g == 7) ? 8 : 11; const int kr_lo = (g == 0) ? 0 : (g == 7 ? 24 : 4 * g - 4); const int NT = 4 + nloc;
  const int rq = 4 * g + (wid >> 1); int r0w = rq - 4; r0w = r0w < 0 ? 0 : (r0w > 24 ? 24 : r0w);
  const int c = (wid & 1) * 32 + r32; int cs = c - 8; cs = cs < 0 ? 0 : (cs > 48 ? 48 : cs);
  __syncthreads();
  for (int i = tid; i < BT_FLOATS; i += NTHR) { const int k = i - 64; float v = 0.f;
    if (k >= 0 && k < 15 * 32 && (k & 31) < 31) v = FIN(I_RPB)[(h * 15 + (k >> 5)) * 31 + (k & 31)] * (1.0f / SCALE);
    bt[i] = v; }
  float m_reg = -1e30f, l_reg = 0; f32x16 o[4] = {}; bf16x8 qr[8];
  const bf16* Qw = PROJ + (size_t)(b * SEQ + rq * GW + c) * NPROJ + QOFF + h * HD + hi * 8;
#pragma unroll
  for (int d0 = 0; d0 < 8; ++d0) qr[d0] = *(const GAS bf16x8*)(Qw + d0 * 16);
  const int sr = tid >> 4, sc = (tid & 15) * 8, vst0 = v_st(sr, sc), vst1 = v_st(32 + sr, sc);
  const int vb0 = (int)(uintptr_t)V_lds + v_rd_base(lane);
  const GAS char* Kc = (const GAS char*)(KVC + (size_t)(b * LC) * DM + h * HD);
  const GAS char* Kl = (const GAS char*)(PROJ + (size_t)(b * SEQ) * NPROJ + KOFF + h * HD);
  const unsigned vo_c = (unsigned)(sr * DM + sc) * 2u, vo_l = (unsigned)(sr * NPROJ + sc) * 2u;
  struct { bf16x8 vs0, vs1, ks0, ks1; } st_;
#define SLOAD(j) do { const int _j = (j); const GAS char* _k; unsigned _vo; size_t _h; \
    if (_j < 4) { _k = Kc + (size_t)(_j * 64) * DM * 2; _vo = vo_c; _h = (size_t)32 * DM * 2; } else { _k = Kl + (size_t)((kr_lo + _j - 4) * GW) * NPROJ * 2; _vo = vo_l; _h = (size_t)32 * NPROJ * 2; } \
    st_.ks0 = *(const GAS bf16x8*)(_k + _vo); st_.ks1 = *(const GAS bf16x8*)(_k + _h + _vo); \
    st_.vs0 = *(const GAS bf16x8*)(_k + 2048 + _vo); st_.vs1 = *(const GAS bf16x8*)(_k + _h + 2048 + _vo); } while (0)
#define SWRITE(bb) do { *(LAS bf16x8*)(V_lds + (bb) * SHM_V + vst0) = st_.vs0; *(LAS bf16x8*)(V_lds + (bb) * SHM_V + vst1) = st_.vs1; const int kc = sc * 2; \
    *(LAS bf16x8*)(K_lds + (bb) * SHM_K + KSWZ(sr, kc)) = st_.ks0; *(LAS bf16x8*)(K_lds + (bb) * SHM_K + KSWZ(32 + sr, kc)) = st_.ks1; } while (0)
#define RESC(a) do { if (__any((a) < 1.f)) { if (hi == 0) al_l[r32] = (a); asm volatile("s_waitcnt lgkmcnt(0)" ::: "memory"); \
    _Pragma("unroll") for (int d = 0; d < 4; ++d) _Pragma("unroll") for (int r = 0; r < 16; ++r) o[d][r] *= al_l[crow(r, hi)]; } } while (0)
#define BIAS(P0, P1, j) bias_mask(P0, P1, bt, (j), kr_lo, rq, r0w, c, cs, hi)
  f32x16 p0, p1; float mn, al; bf16x8 pa0, pa1, pa2, pa3;
#define STEP(j, B) do { SWRITE(B); if ((j) + 1 < NT) SLOAD((j) + 1); __syncthreads(); \
    qkt(p0, p1, K_lds + (B) * SHM_K, qr, r32, hi); BIAS(p0, p1, (j)); partialSM(p0, p1, m_reg, mn, al); RESC(al); \
    finishSM(p0, p1, al, l_reg, pa0, pa1, pa2, pa3); SBAR(); pv_d0(o, vb0 + (B) * SHM_V, pa0, pa1, pa2, pa3); } while (0)
  SLOAD(0);
  for (int j = 0; j + 1 < NT; j += 2) { STEP(j, 0); STEP(j + 1, 1); }
  if (NT & 1) STEP(NT - 1, 0);
#undef STEP
  asm volatile("s_waitcnt vmcnt(0)" ::: "memory");
  if (hi == 0) li_l[r32] = l_reg; asm volatile("s_waitcnt lgkmcnt(0)" ::: "memory");
  const float* ga = FIN(I_GATTN) + h * HD;
  float gg[4];
#pragma unroll
  for (int d0 = 0; d0 < 4; ++d0) gg[d0] = ga[d0 * 32 + r32];
  bf16* Yw = Y + (size_t)(b * SEQ + rq * GW + (wid & 1) * 32) * DM + DC + h * HD + r32;
#pragma unroll
  for (int r = 0; r < 16; ++r) { const int orow = crow(r, hi); const float rl = 1.0f / li_l[orow];
    float v0 = o[0][r] * rl, v1 = o[1][r] * rl, v2 = o[2][r] * rl, v3 = o[3][r] * rl;
    float ss = (v0 * v0 + v1 * v1) + (v2 * v2 + v3 * v3);
    ss += __shfl_xor(ss, 1); ss += __shfl_xor(ss, 2); ss += __shfl_xor(ss, 4); ss += __shfl_xor(ss, 8); ss += __shfl_xor(ss, 16);
    const float rstd = 1.0f / sqrtf(ss * (1.0f / HD) + EPS);
    bf16* yr = Yw + (size_t)orow * DM;
    yr[0] = (bf16)(cvt_pk_bf16(v0 * rstd * gg[0], 0.f) & 0xffffu); yr[32] = (bf16)(cvt_pk_bf16(v1 * rstd * gg[1], 0.f) & 0xffffu);
    yr[64] = (bf16)(cvt_pk_bf16(v2 * rstd * gg[2], 0.f) & 0xffffu); yr[96] = (bf16)(cvt_pk_bf16(v3 * rstd * gg[3], 0.f) & 0xffffu); }
#undef SLOAD
#undef SWRITE
#undef RESC
#undef BIAS
}
__device__ __forceinline__ void p3_attn_mfma(Frame& F) {
  const int cx = (F.bid & 7) * 32 + (F.bid >> 3);
  for (int u = cx; u < 512; u += 256) {
    int bh, g;
    if (u < 384) { bh = u / 6; g = 1 + u % 6; } else { const int s = u - 384; bh = s >> 1; g = (s & 1) ? 7 : 0; }
    attn_unit(F, bh >> 3, bh & 7, g);
  }
}

__device__ __forceinline__ void p3_conv(Frame& F) {
    const bf16* PROJ = (const bf16*)(F.ws + WS_PROJ); bf16* Y = (bf16*)(F.ws + WS_Y);
    const float* cw = FIN(I_CONVW); const float* cb = FIN(I_CONVB); const float* gc = FIN(I_GCONV);
    const int gw = F.bid * NWAVES + F.wave, NGW = F.G * NWAVES;
    for (int task = gw; task < T / 2; task += NGW) {
        const int row0 = 4 * (task >> 1), t0 = row0 & (SEQ - 1), ch0 = (task & 1) * 512 + 8 * F.lane;
        const bf16* pr = PROJ + (size_t)row0 * NPROJ + ch0;
        v4u rc[6], rx[6], rb[4];
#pragma unroll
        for (int k = 0; k < 6; ++k) { const bool ok = (k == 0) ? (t0 > 0) : ((k == 5) ? (t0 + 4 < SEQ) : true);
            rc[k] = (v4u){0, 0, 0, 0}; rx[k] = (v4u){0, 0, 0, 0};
            if (ok) { rc[k] = *(const GAS v4u*)(pr + (long)(k - 1) * NPROJ + 1024); rx[k] = *(const GAS v4u*)(pr + (long)(k - 1) * NPROJ + 2048); } }
#pragma unroll
        for (int k = 0; k < 4; ++k) rb[k] = *(const GAS v4u*)(pr + (long)k * NPROJ);
        float w0[8], w1[8], w2[8], bb[8], gg[8];
#pragma unroll
        for (int q = 0; q < 2; ++q) { const f32x4 a0 = *(const GAS f32x4*)(cw + ch0 + 4 * q), a1 = *(const GAS f32x4*)(cw + 1024 + ch0 + 4 * q), a2 = *(const GAS f32x4*)(cw + 2048 + ch0 + 4 * q),
                a3 = *(const GAS f32x4*)(cb + ch0 + 4 * q), a4 = *(const GAS f32x4*)(gc + ch0 + 4 * q);
#pragma unroll
            for (int e = 0; e < 4; ++e) { w0[4 * q + e] = a0[e]; w1[4 * q + e] = a1[e]; w2[4 * q + e] = a2[e]; bb[4 * q + e] = a3[e]; gg[4 * q + e] = a4[e]; } }
        float p[6][8];
#pragma unroll
        for (int k = 0; k < 6; ++k)
#pragma unroll
            for (int q = 0; q < 4; ++q) { p[k][2 * q] = bf_lo(rc[k][q]) * bf_lo(rx[k][q]); p[k][2 * q + 1] = bf_hi(rc[k][q]) * bf_hi(rx[k][q]); }
#pragma unroll
        for (int i = 0; i < 4; ++i) {
            float o[8]; float ss = 0.f;
#pragma unroll
            for (int q = 0; q < 4; ++q)
#pragma unroll
                for (int z = 0; z < 2; ++z) { const int e = 2 * q + z; const float ubv = z ? bf_hi(rb[i][q]) : bf_lo(rb[i][q]);
                    const float cv = p[i][e] * w0[e] + p[i + 1][e] * w1[e] + p[i + 2][e] * w2[e] + bb[e]; o[e] = ubv * cv; ss += o[e] * o[e]; }
            ss += __shfl_xor(ss, 1); ss += __shfl_xor(ss, 2); ss += __shfl_xor(ss, 4); ss += __shfl_xor(ss, 8);
            const float rstd = 1.0f / sqrtf(ss * (1.0f / 128.0f) + EPS);
            unsigned w[4];
#pragma unroll
            for (int q = 0; q < 4; ++q) w[q] = cvt_pk_bf16(o[2 * q] * rstd * gg[2 * q], o[2 * q + 1] * rstd * gg[2 * q + 1]);
            *(GAS v4u*)(Y + (size_t)(row0 + i) * DM + ch0) = (v4u){w[0], w[1], w[2], w[3]};
        }
    }
}

struct ProbOut {
    static constexpr int K = DM, KB = DM * 2, SCALE_A = 0, SCALE_B = 0, SCALE_B1 = 0, EPI_STORES = 16; static constexpr bool GATHER = false, PERM = true, FP8 = false;
    const bf16 *Y, *Wout; bf16* YL; float* SSQ; int G, c;
    __device__ __forceinline__ bool next(int i, pg8::Unit& u) const {
        const int w = pg8::round_unit(i, G, c, 512); if (w < 0) return false;
        u.pm = (w >> 6) * 8 + (w & 7); u.pn = (w & 63) >> 3; u.g = 0; return true; }
    __device__ __forceinline__ const char* a_base(const pg8::Unit& u) const { return (const char*)Y + (size_t)u.pm * 256 * K * 2; }
    __device__ __forceinline__ const char* b_base(const pg8::Unit& u) const { return (const char*)Wout + (size_t)u.pn * 256 * K * 2; }
    __device__ __forceinline__ void rows(const pg8::Unit&, int, LAS unsigned*) const {}
    __device__ __forceinline__ void epi(const f32x4 (&acc)[2][2][4][2], const pg8::Unit& u, int wr, int wc, int fr, int fq) const {
        const int row0 = u.pm * 256 + wr * 64 + fr, col0 = u.pn * 256 + wc * 32 + 8 * fq;
#pragma unroll
        for (int ai = 0; ai < 2; ++ai)
#pragma unroll
            for (int m = 0; m < 4; ++m) { const int row = row0 + ai * 128 + m * 16; bf16* rowp = YL + (size_t)row * DM + col0; float ss = 0.f;
#pragma unroll
                for (int bj = 0; bj < 2; ++bj) { const f32x4 v0 = acc[ai][bj][m][0], v1 = acc[ai][bj][m][1];
                    ss += (v0.x * v0.x + v0.y * v0.y) + (v0.z * v0.z + v0.w * v0.w) + (v1.x * v1.x + v1.y * v1.y) + (v1.z * v1.z + v1.w * v1.w);
                    v4u w; w.x = cvt_pk_bf16(v0.x, v0.y); w.y = cvt_pk_bf16(v0.z, v0.w); w.z = cvt_pk_bf16(v1.x, v1.y); w.w = cvt_pk_bf16(v1.z, v1.w);
                    *(GAS v4u*)(rowp + bj * 128) = w; }
                ss += __shfl_xor(ss, 16); ss += __shfl_xor(ss, 32);
                if (fq == 0) SSQ[(size_t)row * 32 + u.pn * 4 + wc] = ss; }
    }
};

__device__ __forceinline__ void fp8x4_to_f32(unsigned u, float* o) { const f32x2 a = __builtin_amdgcn_cvt_pk_f32_fp8((int)u, false), b = __builtin_amdgcn_cvt_pk_f32_fp8((int)u, true); o[0] = a.x; o[1] = a.y; o[2] = b.x; o[3] = b.y; }
__device__ __forceinline__ void p5_route(Frame& F) {
    const float* MOD = (const float*)(F.ws + WS_MOD);
    const bf16* YL = (const bf16*)(F.ws + WS_YL); const float* SSQ = (const float*)(F.ws + WS_SSQ);
    const bf16* WRH = (const bf16*)(F.ws + WS_WRH); const bf16* WRL = (const bf16*)(F.ws + WS_WRL);
    unsigned* gcnt = (unsigned*)(F.ws + WS_CTL) + CW_CNT;
    v2u* LIST = (v2u*)(F.ws + WS_LIST);
    LAS float* part = (LAS float*)F.lds;
    LAS float* logit = (LAS float*)(F.lds + 131072);
    LAS unsigned* lcnt = (LAS unsigned*)(F.lds + 147456);
    LAS unsigned* lbase = (LAS unsigned*)(F.lds + 147456 + 256);
    LAS unsigned* ent = (LAS unsigned*)(F.lds + 147456 + 512);
    for (int blk = F.bid; blk < T / 64; blk += F.G) {
        const int row0 = blk * 64;
        if (F.tid < 64) lcnt[F.tid] = 0u;
        {
            const float* md = MOD + (size_t)(row0 >> 11) * 12288;
            f32x4 nx[8]; v2u ny[8]; float nsq;
#define P5_LOAD(rr_) do { const int _row = row0 + (rr_); const float* _xr = FIN(I_X) + (size_t)_row * DM; const bf16* _yr = YL + (size_t)_row * DM; \
                nsq = F.lane < 32 ? SSQ[(size_t)_row * 32 + F.lane] : 0.f; \
                _Pragma("unroll") for (int j = 0; j < 8; ++j) { nx[j] = *(const GAS f32x4*)(_xr + 4 * F.lane + 256 * j); ny[j] = *(const GAS v2u*)(_yr + 4 * F.lane + 256 * j); } } while (0)
            P5_LOAD(F.wave);
            for (int rr = F.wave; rr < 64; rr += NWAVES) {
                const int row = row0 + rr;
                f32x4 v[8]; v2u yv[8]; float sq = nsq;
#pragma unroll
                for (int j = 0; j < 8; ++j) { v[j] = nx[j]; yv[j] = ny[j]; }
                if (rr + NWAVES < 64) P5_LOAD(rr + NWAVES);
                sq = wave_sum(sq);
                const float rstd1 = 1.0f / sqrtf(sq * (1.0f / DM) + EPS);
                float ss = 0.f;
#pragma unroll
                for (int j = 0; j < 8; ++j) { const int c = 4 * F.lane + 256 * j;
                    const f32x4 gp = *(const GAS f32x4*)(FIN(I_GPOSTMIX) + c), gt = *(const GAS f32x4*)(md + 4096 + c);
                    const f32x4 yl = (f32x4){bf_lo(yv[j].x), bf_hi(yv[j].x), bf_lo(yv[j].y), bf_hi(yv[j].y)};
                    v[j] = v[j] + gt * (yl * rstd1 * gp);
                    { const unsigned h0 = cvt_pk_bf16(v[j].x, v[j].y), h1 = cvt_pk_bf16(v[j].z, v[j].w);
                      const unsigned l8 = pack4_fp8(clamp448((v[j].x - bf_lo(h0)) * 4096.0f), clamp448((v[j].y - bf_hi(h0)) * 4096.0f), clamp448((v[j].z - bf_lo(h1)) * 4096.0f), clamp448((v[j].w - bf_hi(h1)) * 4096.0f));
                      unsigned char* xp = (unsigned char*)FOUT + (size_t)row * (DM * 4) + (j >> 2) * 4096 + (4 * F.lane + 256 * (j & 3)) * 2;
                      *(GAS v2u*)xp = (v2u){h0, h1}; *(GAS unsigned*)((unsigned char*)FOUT + (size_t)row * (DM * 4) + (j >> 2) * 4096 + 2048 + (4 * F.lane + 256 * (j & 3))) = l8; }
                    ss += (v[j].x * v[j].x + v[j].y * v[j].y) + (v[j].z * v[j].z + v[j].w * v[j].w); }
                const float rstd2 = 1.0f / sqrtf(wave_sum(ss) * (1.0f / DM) + EPS);
                if (F.lane == 0) ((GAS float*)(F.ws + WS_RS2))[row] = rstd2;
#pragma unroll
                for (int j = 0; j < 8; ++j) { const int c = 4 * F.lane + 256 * j;
                    const f32x4 gg = *(const GAS f32x4*)(FIN(I_GPREFFN) + c), sh = *(const GAS f32x4*)(md + 6144 + c), sc = *(const GAS f32x4*)(md + 8192 + c);
                    const f32x4 h = (v[j] * rstd2) * gg * (sc + 1.0f) + sh;
                    *(GAS unsigned*)(F.ws + WS_H2Q + (size_t)row * DM + c) = pack4_fp8(clamp448(h.x * 4.0f), clamp448(h.y * 4.0f), clamp448(h.z * 4.0f), clamp448(h.w * 4.0f)); }
            }
#undef P5_LOAD
        }
        VM_WAIT(); __syncthreads();
        {
            int lz = F.lane; asm volatile("" : "+v"(lz));
            const int fr = lz & 15, fq = lz >> 4, k0 = F.wave * 256 + 8 * fq;
            const unsigned char* xh = (const unsigned char*)FOUT + (size_t)(row0 + fr) * (DM * 4) + (F.wave >> 2) * 4096 + ((F.wave & 3) * 256 + 8 * fq) * 2;
            const int xlo = 2048 - ((F.wave & 3) * 256 + 8 * fq);
            const float* mdb = MOD + (size_t)(row0 >> 11) * 12288;
            float rs[4];
#pragma unroll
            for (int i = 0; i < 4; ++i) rs[i] = ((const GAS float*)(F.ws + WS_RS2))[row0 + 16 * i + fr];
            const bf16* bh = WRH + (size_t)fr * DM + k0; const bf16* bl = WRL + (size_t)fr * DM + k0;
            f32x4 acc[4][4];
#pragma unroll
            for (int i = 0; i < 4; ++i)
#pragma unroll
                for (int n = 0; n < 4; ++n) acc[i][n] = (f32x4){0.f, 0.f, 0.f, 0.f};
#pragma unroll 2
            for (int s = 0; s < 8; ++s) {
                v4u XH[4]; v2u XL[4]; bf16x8 a_h[4], a_l[4], b_h[4], b_l[4];
#pragma unroll
                for (int i = 0; i < 4; ++i) { XH[i] = *(const GAS v4u*)(xh + (size_t)i * 16 * (DM * 4) + 64 * s); XL[i] = *(const GAS v2u*)(xh + (size_t)i * 16 * (DM * 4) + 32 * s + xlo);
                    b_h[i] = *(const GAS bf16x8*)(bh + (size_t)i * 16 * DM + 32 * s); b_l[i] = *(const GAS bf16x8*)(bl + (size_t)i * 16 * DM + 32 * s); }
                const int kc = k0 + 32 * s;
                f32x4 G[2], S[2];
#pragma unroll
                for (int z = 0; z < 2; ++z) { const f32x4 gg = *(const GAS f32x4*)(FIN(I_GPREFFN) + kc + 4 * z), sc = *(const GAS f32x4*)(mdb + 8192 + kc + 4 * z); G[z] = gg * (sc + 1.0f); S[z] = *(const GAS f32x4*)(mdb + 6144 + kc + 4 * z); }
#pragma unroll
                for (int i = 0; i < 4; ++i) { unsigned hh[4], ll[4];
#pragma unroll
                    for (int z = 0; z < 2; ++z) { const unsigned ha = z ? XH[i].z : XH[i].x, hb = z ? XH[i].w : XH[i].y; float lq[4]; fp8x4_to_f32(z ? XL[i].y : XL[i].x, lq);
                        const f32x4 xq = (f32x4){bf_lo(ha) + lq[0] * (1.0f / 4096.0f), bf_hi(ha) + lq[1] * (1.0f / 4096.0f), bf_lo(hb) + lq[2] * (1.0f / 4096.0f), bf_hi(hb) + lq[3] * (1.0f / 4096.0f)};
                        const f32x4 h = (xq * rs[i]) * G[z] + S[z];
                        hh[2 * z] = cvt_pk_bf16(h.x, h.y); hh[2 * z + 1] = cvt_pk_bf16(h.z, h.w);
                        ll[2 * z] = cvt_pk_bf16(h.x - bf_lo(hh[2 * z]), h.y - bf_hi(hh[2 * z])); ll[2 * z + 1] = cvt_pk_bf16(h.z - bf_lo(hh[2 * z + 1]), h.w - bf_hi(hh[2 * z + 1])); }
                    a_h[i] = __builtin_bit_cast(bf16x8, (v4u){hh[0], hh[1], hh[2], hh[3]}); a_l[i] = __builtin_bit_cast(bf16x8, (v4u){ll[0], ll[1], ll[2], ll[3]}); }
#pragma unroll
                for (int i = 0; i < 4; ++i)
#pragma unroll
                    for (int n = 0; n < 4; ++n) {
                        acc[i][n] = __builtin_amdgcn_mfma_f32_16x16x32_bf16(a_l[i], b_h[n], acc[i][n], 0, 0, 0);
                        acc[i][n] = __builtin_amdgcn_mfma_f32_16x16x32_bf16(a_h[i], b_l[n], acc[i][n], 0, 0, 0);
                        acc[i][n] = __builtin_amdgcn_mfma_f32_16x16x32_bf16(a_h[i], b_h[n], acc[i][n], 0, 0, 0); }
            }
            LAS float* pw = part + F.wave * 4096;
#pragma unroll
            for (int i = 0; i < 4; ++i)
#pragma unroll
                for (int n = 0; n < 4; ++n)
#pragma unroll
                    for (int r = 0; r < 4; ++r) pw[(i * 16 + 4 * fq + r) * 64 + n * 16 + fr] = acc[i][n][r];
        }
        __syncthreads();
#pragma unroll
        for (int q = 0; q < 8; ++q) { const int idx = F.tid + 512 * q; float sacc = 0.f;
#pragma unroll
            for (int w = 0; w < 8; ++w) sacc += part[w * 4096 + idx];
            logit[idx] = sacc; }
        __syncthreads();
        for (int rr = F.wave; rr < 64; rr += NWAVES) {
            const int row = row0 + rr; const int e = F.lane;
            const float lg = logit[rr * 64 + e]; const float score = 1.0f / (1.0f + expf(-lg)); const float sel = score + FIN(I_RBIAS)[e];
            float m1 = sel; m1 = fmaxf(m1, __shfl_xor(m1, 1)); m1 = fmaxf(m1, __shfl_xor(m1, 2)); m1 = fmaxf(m1, __shfl_xor(m1, 4));
            int i1 = (sel == m1) ? e : 1000; i1 = min(i1, __shfl_xor(i1, 1)); i1 = min(i1, __shfl_xor(i1, 2)); i1 = min(i1, __shfl_xor(i1, 4));
            float s2 = (e == i1) ? -INFINITY : sel; s2 = fmaxf(s2, __shfl_xor(s2, 1)); s2 = fmaxf(s2, __shfl_xor(s2, 2)); s2 = fmaxf(s2, __shfl_xor(s2, 4));
            const float gs = m1 + s2; const int g = e >> 3; int grank = 0;
#pragma unroll
            for (int g2 = 0; g2 < 8; ++g2) { const float o = __builtin_bit_cast(float, __builtin_amdgcn_readlane(__builtin_bit_cast(unsigned, gs), 8 * g2)); grank += (o > gs || (o == gs && g2 < g)) ? 1 : 0; }
            const float ms = grank < 4 ? sel : -INFINITY; int rank = 0;
#pragma unroll 8
            for (int e2 = 0; e2 < 64; ++e2) { const float o = __builtin_bit_cast(float, __builtin_amdgcn_readlane(__builtin_bit_cast(unsigned, ms), e2)); rank += (o > ms || (o == ms && e2 < e)) ? 1 : 0; }
            const bool chosen = rank < 8;
            const float ssum = wave_sum(chosen ? score : 0.f);
            const float w = score / ssum * 2.5f;
            if (chosen) { const unsigned lp = __hip_atomic_fetch_add(lcnt + e, 1u, __ATOMIC_RELAXED, __HIP_MEMORY_SCOPE_WORKGROUP);
                LAS unsigned* en = ent + (rr * 8 + rank) * 4; en[0] = (unsigned)e; en[1] = lp; en[2] = (unsigned)row * 16u + (unsigned)rank; en[3] = __builtin_bit_cast(unsigned, w); }
            if (F.lane == 0) LIST[(size_t)64 * LIST_CAP + row] = (v2u){(unsigned)row * 16u + 8u, __builtin_bit_cast(unsigned, 1.0f)};
        }
        __syncthreads();
        { int tq = F.tid; asm volatile("" : "+v"(tq));
          if (tq < 64) lbase[tq] = __hip_atomic_fetch_add(gcnt + 64 * tq, lcnt[tq], RLX_AGENT); }
        __syncthreads();
        { const LAS unsigned* en = ent + F.tid * 4; const unsigned e = en[0], idx = lbase[e] + en[1]; LIST[(size_t)e * LIST_CAP + idx] = (v2u){en[2], en[3]};
          ((v2u*)(F.ws + WS_TOK))[(size_t)(en[2] >> 4) * 8 + (en[2] & 15u)] = (v2u){(e << 16) | idx, en[3]}; }
        __syncthreads();
    }
}

struct TileTab { LAS int* cnt; LAS int* tstart; };
__device__ __forceinline__ TileTab build_tiles(Frame& F) {
    TileTab tt; tt.cnt = (LAS int*)(F.lds + MISC_OFF); tt.tstart = tt.cnt + 128;
    const unsigned* gcnt = (const unsigned*)(F.ws + WS_CTL) + CW_CNT;
    if (F.tid < 64) tt.cnt[F.tid] = (int)__hip_atomic_load(gcnt + 64 * F.tid, RLX_AGENT);
    if (F.tid == 64) tt.cnt[64] = T;
    __syncthreads();
    if (F.tid == 0) { int s = 0; for (int e = 0; e < 65; ++e) { tt.tstart[e] = s; s += (tt.cnt[e] + 255) >> 8; } tt.tstart[65] = s; }
    __syncthreads();
    return tt;
}
__device__ __forceinline__ int tile_expert(const TileTab& tt, int tile, int e) { while (tt.tstart[e + 1] <= tile) ++e; return e; }

struct ProbGU {
    static constexpr int KB = DM, SCALE_A = 0x7D7D7D7D  , SCALE_B = 0x79797979  , SCALE_B1 = 0x7B7B7B7B  , EPI_STORES = 0  ; static constexpr bool GATHER = true, PERM = false, FP8 = true;
    const unsigned char *H2Q, *Wgu; unsigned char* HID; const v2u* LIST; TileTab tt; int G, c; mutable int eh;
    __device__ __forceinline__ bool next(int i, pg8::Unit& u) const {
        const int total = tt.tstart[65] * 4; const int w = pg8::round_unit(i, G, c, total); if (w < 0) return false;
        u.pm = w >> 2; u.pn = w & 3; eh = tile_expert(tt, u.pm, eh); u.g = eh; return true; }
    __device__ __forceinline__ const char* a_base(const pg8::Unit&) const { return (const char*)H2Q; }
    __device__ __forceinline__ const char* b_base(const pg8::Unit& u) const { return (const char*)Wgu + ((size_t)u.g * 1024 + (size_t)u.pn * 256) * KB; }
    __device__ __forceinline__ void rows(const pg8::Unit& u, int tid, LAS unsigned* dst) const {
        const int lt = u.pm - tt.tstart[u.g]; const int nrow = tt.cnt[u.g] - lt * 256; const v2u* lp = LIST + (size_t)u.g * LIST_CAP + lt * 256;
        unsigned tk[2][2];
#pragma unroll
        for (int i = 0; i < 2; ++i) { int R0, C; pg8::stage_rc(tid * 16 + i * 8192, R0, C);
#pragma unroll
            for (int h = 0; h < 2; ++h) { int R = R0 + 128 * h; R = R < nrow ? R : nrow - 1; tk[h][i] = lp[R].x; } }
#pragma unroll
        for (int i = 0; i < 2; ++i) { int R0, C; pg8::stage_rc(tid * 16 + i * 8192, R0, C);
#pragma unroll
            for (int h = 0; h < 2; ++h) dst[(h * 2 + i) * 512 + tid] = (tk[h][i] >> 4) * (unsigned)KB + (unsigned)(C * 2); }
    }
    __device__ __forceinline__ void epi(const f32x4 (&acc)[2][2][4][2], const pg8::Unit& u, int wr, int wc, int fr, int fq) const {
#pragma unroll
        for (int ai = 0; ai < 2; ++ai)
#pragma unroll
            for (int m = 0; m < 4; ++m) { const int R = ai * 128 + wr * 64 + m * 16 + fr;
                unsigned char* rowp = HID + ((size_t)u.pm * 256 + R) * FE + u.pn * 128 + wc * 32 + 8 * fq;
                unsigned pk[2];
#pragma unroll
                for (int bj = 0; bj < 2; ++bj) { const f32x4 g = acc[ai][bj][m][0], up = acc[ai][bj][m][1]; f32x4 hv;
#pragma unroll
                    for (int q = 0; q < 4; ++q) hv[q] = __builtin_amdgcn_fmed3f(g[q] * __builtin_amdgcn_rcpf(1.0f + __expf(-g[q])) * up[q], -448.0f, 448.0f);
                    pk[bj] = pack4_fp8(hv.x, hv.y, hv.z, hv.w); }
                *(GAS v2u*)rowp = (v2u){pk[0], pk[1]}; }
    }
};
struct ProbDown {
    static constexpr int KB = FE, SCALE_A = 0x7D7D7D7D  , SCALE_B = 0x7E7E7E7E  , SCALE_B1 = 0x7E7E7E7E, EPI_STORES = 8; static constexpr bool GATHER = false, PERM = false, FP8 = true;
    const unsigned char *HID, *Wdn; unsigned char* SLOT; const v2u* LIST; TileTab tt; int G, c; mutable int eh;
    __device__ __forceinline__ bool next(int i, pg8::Unit& u) const {
        const int total = tt.tstart[65] * 8; const int w = pg8::round_unit(i, G, c, total); if (w < 0) return false;
        u.pm = w >> 3; u.pn = w & 7; eh = tile_expert(tt, u.pm, eh); u.g = eh; return true; }
    __device__ __forceinline__ const char* a_base(const pg8::Unit& u) const { return (const char*)HID + (size_t)u.pm * 256 * KB; }
    __device__ __forceinline__ const char* b_base(const pg8::Unit& u) const { return (const char*)Wdn + ((size_t)u.g * 2048 + (size_t)u.pn * 256) * KB; }
    __device__ __forceinline__ void rows(const pg8::Unit&, int, LAS unsigned*) const {}
    __device__ __forceinline__ void epi(const f32x4 (&acc)[2][2][4][2], const pg8::Unit& u, int wr, int wc, int fr, int fq) const {
        const int col0 = u.pn * 256 + wc * 64 + 16 * fq;
#pragma unroll
        for (int ai = 0; ai < 2; ++ai)
#pragma unroll
            for (int m = 0; m < 4; ++m) { const int R = ai * 128 + wr * 64 + m * 16 + fr; unsigned char* rowp = SLOT + ((size_t)u.pm * 256 + R) * DM + col0;
                unsigned pk[4];
#pragma unroll
                for (int bj = 0; bj < 2; ++bj)
#pragma unroll
                    for (int n = 0; n < 2; ++n) { const f32x4 v = acc[ai][bj][m][n];
                        pk[bj * 2 + n] = pack4_fp8(__builtin_amdgcn_fmed3f(v.x, -448.0f, 448.0f), __builtin_amdgcn_fmed3f(v.y, -448.0f, 448.0f), __builtin_amdgcn_fmed3f(v.z, -448.0f, 448.0f), __builtin_amdgcn_fmed3f(v.w, -448.0f, 448.0f)); }
                *(GAS v4u*)rowp = (v4u){pk[0], pk[1], pk[2], pk[3]}; }
    }
};

__device__ __forceinline__ void p8_final(Frame& F, float* dst) {
    const int gw = F.bid * NWAVES + F.wave, NGW = F.G * NWAVES;
    const TileTab tt = build_tiles(F);
    const float* MOD = (const float*)(F.ws + WS_MOD); const unsigned char* SLOT = F.ws + WS_SLOT; const float* g = FIN(I_GPOSTFFN);
    const v2u* TOK = (const v2u*)(F.ws + WS_TOK);
    const int sh0 = tt.tstart[64] * 256;
    v2u ntk = (v2u){0u, 0u}; if (gw < T && F.lane < 8) ntk = TOK[(size_t)gw * 8 + F.lane];
    for (int row = gw; row < T; row += NGW) {
        const float* md = MOD + (size_t)(row >> 11) * 12288;
        unsigned mypos = 0u; float myw = 0.f;
        { const v2u tk = ntk; const unsigned e = tk.x >> 16; if (F.lane < 8) { mypos = (unsigned)tt.tstart[e & 63u] * 256u + (tk.x & 0xffffu); myw = u2f(tk.y) * (1.0f / 16.0f); } }
        if (row + NGW < T && F.lane < 8) ntk = TOK[(size_t)(row + NGW) * 8 + F.lane];
        v4u raw[9][2];
        { const unsigned char* sr = SLOT + (size_t)(sh0 + row) * DM + 16 * F.lane;
#pragma unroll
          for (int j = 0; j < 2; ++j) raw[8][j] = *(const GAS v4u*)(sr + 1024 * j); }
        float wv[9]; wv[8] = 1.0f / 16.0f;
#pragma unroll
        for (int s = 0; s < 8; ++s) { const unsigned pos = __builtin_amdgcn_readlane(mypos, s); wv[s] = u2f(__builtin_amdgcn_readlane(__builtin_bit_cast(unsigned, myw), s));
            const unsigned char* sr = SLOT + (size_t)pos * DM + 16 * F.lane;
#pragma unroll
            for (int j = 0; j < 2; ++j) raw[s][j] = *(const GAS v4u*)(sr + 1024 * j); }
        f32x4 xin[2][4];
#pragma unroll
        for (int j = 0; j < 2; ++j) { const GAS v4u* op = (const GAS v4u*)((const unsigned char*)FOUT + (size_t)row * (DM * 4) + j * 4096 + 32 * F.lane);
#pragma unroll
            for (int q = 0; q < 2; ++q) { const v4u H = op[q];
                xin[j][2 * q] = (f32x4){bf_lo(H.x), bf_hi(H.x), bf_lo(H.y), bf_hi(H.y)}; xin[j][2 * q + 1] = (f32x4){bf_lo(H.z), bf_hi(H.z), bf_lo(H.w), bf_hi(H.w)}; } }
        float f[2][16]; float ss = 0.f;
#pragma unroll
        for (int j = 0; j < 2; ++j) {
#pragma unroll
            for (int i = 0; i < 16; ++i) f[j][i] = 0.f;
#pragma unroll
            for (int s = 0; s < 9; ++s) { const int sx = (s + 8) % 9; const v4u r = raw[sx][j]; float t[16];
                fp8x4_to_f32(r.x, t); fp8x4_to_f32(r.y, t + 4); fp8x4_to_f32(r.z, t + 8); fp8x4_to_f32(r.w, t + 12);
#pragma unroll
                for (int i = 0; i < 16; ++i) f[j][i] += t[i] * wv[sx]; }
#pragma unroll
            for (int i = 0; i < 16; ++i) ss += f[j][i] * f[j][i]; }
        const float rstd = 1.0f / sqrtf(wave_sum(ss) * (1.0f / DM) + EPS);
#pragma unroll
        for (int j = 0; j < 2; ++j) { const int c = 16 * F.lane + 1024 * j; GAS f32x4* dp = (GAS f32x4*)(dst + (size_t)row * DM + c);
#pragma unroll
            for (int q = 0; q < 4; ++q) { const f32x4 ga = *(const GAS f32x4*)(g + c + 4 * q), ta = *(const GAS f32x4*)(md + 10240 + c + 4 * q);
                const f32x4 fv = (f32x4){f[j][4 * q], f[j][4 * q + 1], f[j][4 * q + 2], f[j][4 * q + 3]};
                dp[q] = xin[j][q] + ta * (fv * rstd * ga); } }
    }
}

constexpr int N_PHASES = 9;
#ifndef F8_IN_P0
#define F8_IN_P0 4992
#endif
#ifndef P2_GEMM_WGS
#define P2_GEMM_WGS 192
#endif
typedef KArgs Args;
__global__ void __launch_bounds__(NTHR, 2) fwd_kernel(Args args) {
    extern __shared__ __attribute__((aligned(16))) unsigned char lds_raw[];
    Frame F;
    F.lds = (LAS unsigned char*)lds_raw;
    F.tid = threadIdx.x; F.lane = F.tid & 63; F.wave = __builtin_amdgcn_readfirstlane(F.tid >> 6);
    F.G = gridDim.x; F.bid = blockIdx.x;
    F.ka = (CKArgs*)__builtin_amdgcn_kernarg_segment_ptr(); F.ws = args.ws;
#define LAUNDER() do { CKArgs* _p = (CKArgs*)__builtin_amdgcn_kernarg_segment_ptr(); asm volatile("" : "+s"(_p) :: "memory"); F.ka = _p; unsigned char* _w = _p->ws; F.ws = _w; } while (0)
    volatile LAS unsigned* barw = (volatile LAS unsigned*)(F.lds + BARW_OFF);
    if (F.tid < 16) barw[F.tid] = 0u;
    __syncthreads();
    XcdBarrier bar; bar.bar = (unsigned*)(F.ws + WS_CTL) + CW_BAR + args.li * XCD_BAR_WORDS; bar.x = 0; bar.st = nullptr;
    const int lo = args.ph_lo, hi = args.ph_hi;
    bar = xcd_barrier_post((unsigned*)(F.ws + WS_CTL) + CW_BAR + args.li * XCD_BAR_WORDS, barw);
#ifndef PH_MASK
#define PH_MASK 0x1ff
#endif
#define IN(k) (((PH_MASK >> (k)) & 1) && lo <= (k) && (k) < hi)
#ifdef TIME_PHASE
    volatile LAS unsigned long long* tstamp = (volatile LAS unsigned long long*)(F.lds + BARW_OFF - 128);
#define TSTAMP(k) do { if (F.tid == 0) tstamp[k] = __builtin_amdgcn_s_memrealtime(); } while (0)
#else
#define TSTAMP(k) do { } while (0)
#endif
#define SEAM(k) do { if (IN(k) && IN((k) + 1)) xcd_barrier(bar); TSTAMP((k) + 1); } while (0)
#ifndef REPEAT_MASK
#define REPEAT_MASK 0
#endif
#define NREP(k) (((REPEAT_MASK >> (k)) & 1) ? 2 : 1)
    TSTAMP(0);
    if (IN(0)) { for (int rep = 0; rep < NREP(0); ++rep) { if (rep) xcd_barrier(bar); LAUNDER(); p0_prologue(F); if (F8_IN_P0 > 0) conv_fp8_items(F, 0, F8_IN_P0, F.bid * NWAVES + F.wave, F.G * NWAVES); } } SEAM(0);
    if (IN(1)) {
        LAUNDER(); p1_norm(F, T, T + TC, F.bid * NWAVES + F.wave, F.G * NWAVES);
        xcd_barrier(bar); LAUNDER();
        if (F.bid < 64) {
            ProbProj P; P.HL = (const bf16*)(F.ws + WS_HL); P.HC = (const bf16*)(F.ws + WS_HC); P.Win = (const bf16*)(F.ws + WS_WIN); P.PROJ = (bf16*)(F.ws + WS_PROJ); P.KVC = (bf16*)(F.ws + WS_KVC);
            P.rope = (const f32x2*)(F.ws + WS_ROPE); P.G = 64; P.c = F.bid; P.base = ProbProj::NMAIN; P.total = 64;
            pg8::gemm_phase<ProbProj>(F.lds, P);
        } else p1_norm(F, 0, T, (F.bid - 64) * NWAVES + F.wave, (F.G - 64) * NWAVES);
    } SEAM(1);
    if (IN(2)) { LAUNDER();
        ProbProj P; P.HL = (const bf16*)(F.ws + WS_HL); P.HC = (const bf16*)(F.ws + WS_HC); P.Win = (const bf16*)(F.ws + WS_WIN); P.PROJ = (bf16*)(F.ws + WS_PROJ); P.KVC = (bf16*)(F.ws + WS_KVC);
        P.rope = (const f32x2*)(F.ws + WS_ROPE); P.G = F.G; P.c = F.bid; P.base = 0; P.total = ProbProj::NMAIN;
        P.G = P2_GEMM_WGS;
        if (F.bid < P2_GEMM_WGS) { for (int rep = 0; rep < NREP(2); ++rep) { if (rep) xcd_barrier(bar); pg8::gemm_phase<ProbProj>(F.lds, P); } }
        else conv_fp8_items(F, F8_IN_P0, NF8, (F.bid - P2_GEMM_WGS) * NWAVES + F.wave, (F.G - P2_GEMM_WGS) * NWAVES);
    } SEAM(2);
    if (IN(3)) { for (int rep = 0; rep < NREP(3); ++rep) { if (rep) xcd_barrier(bar); LAUNDER();
#ifdef ATTN_SIMPLE
        p3_attn_simple(F);
#else
        p3_attn_mfma(F);
#endif
        LAUNDER(); p3_conv(F); } } SEAM(3);
    if (IN(4)) { LAUNDER();
        ProbOut P; P.Y = (const bf16*)(F.ws + WS_Y); P.Wout = (const bf16*)(F.ws + WS_WOUT); P.YL = (bf16*)(F.ws + WS_YL); P.SSQ = (float*)(F.ws + WS_SSQ); P.G = F.G; P.c = F.bid;
        for (int rep = 0; rep < NREP(4); ++rep) { if (rep) xcd_barrier(bar); pg8::gemm_phase<ProbOut>(F.lds, P); }
    } SEAM(4);
    if (IN(5)) { LAUNDER(); p5_route(F); } SEAM(5);
    if (IN(6)) { LAUNDER();
        ProbGU P; P.eh = 0; P.tt = build_tiles(F); P.H2Q = F.ws + WS_H2Q; P.Wgu = F.ws + WS_WGU; P.HID = F.ws + WS_HID; P.LIST = (const v2u*)(F.ws + WS_LIST); P.G = F.G; P.c = F.bid;
        for (int rep = 0; rep < NREP(6); ++rep) { if (rep) xcd_barrier(bar); P.eh = 0; pg8::gemm_phase<ProbGU>(F.lds, P); }
    } SEAM(6);
    if (IN(7)) { LAUNDER();
        ProbDown P; P.eh = 0; P.tt = build_tiles(F); P.HID = F.ws + WS_HID; P.Wdn = F.ws + WS_WDN; P.SLOT = F.ws + WS_SLOT; P.LIST = (const v2u*)(F.ws + WS_LIST); P.G = F.G; P.c = F.bid;
        for (int rep = 0; rep < NREP(7); ++rep) { if (rep) xcd_barrier(bar); P.eh = 0; pg8::gemm_phase<ProbDown>(F.lds, P); }
    } SEAM(7);
    if (IN(8)) { for (int rep = 0; rep < NREP(8); ++rep) { if (rep) xcd_barrier(bar); LAUNDER(); p8_final(F, (NREP(8) == 2 && rep == 0) ? (float*)(F.ws + WS_HID) : FOUT); } }
#ifdef TIME_PHASE
    TSTAMP(9);
    if (F.tid == 0) { const unsigned long long d = tstamp[TIME_PHASE + 1] - tstamp[TIME_PHASE]; const unsigned long long t0 = __builtin_amdgcn_s_memrealtime();
        while (__builtin_amdgcn_s_memrealtime() - t0 < d) __builtin_amdgcn_s_sleep(8); }
#endif
#undef IN
#undef SEAM
}

extern "C" void kernel_launch(void* const* d_in, const int* in_sizes, int n_in, void* d_out, int out_size, void* d_ws, size_t ws_size, hipStream_t stream) {
    static int grid = 0;
    if (grid == 0) {
        if (n_in != 25 || in_sizes[0] != T * DM || out_size != T * DM || ws_size < WS_END) { fprintf(stderr, "kernel_launch: shape/workspace mismatch (n_in %d, in0 %d, out %d, ws %zu < %zu)\n", n_in, n_in > 0 ? in_sizes[0] : -1, out_size, ws_size, (size_t)WS_END); grid = -1; return; }
        int dev = 0, cus = 0, per_cu = 0;
        if (hipGetDevice(&dev) != hipSuccess || hipDeviceGetAttribute(&cus, hipDeviceAttributeMultiprocessorCount, dev) != hipSuccess) { grid = -1; return; }
        if (hipFuncSetAttribute((const void*)fwd_kernel, hipFuncAttributeMaxDynamicSharedMemorySize, LDS_BYTES) != hipSuccess) { fprintf(stderr, "kernel_launch: hipFuncSetAttribute failed\n"); grid = -1; return; }
        if (hipOccupancyMaxActiveBlocksPerMultiprocessor(&per_cu, (const void*)fwd_kernel, NTHR, LDS_BYTES) != hipSuccess || per_cu < 1) fprintf(stderr, "kernel_launch: occupancy query says %d\n", per_cu);
        (void)hipGetLastError();
        grid = cus;
        if (grid != 256) fprintf(stderr, "kernel_launch: %d CUs (built for 256)\n", grid);
    }
    if (grid < 0) return;
    if (hipMemsetAsync((char*)d_ws + WS_CTL, 0, CTL_ZERO_BYTES, stream) != hipSuccess) return;
    Args a{};
    for (int i = 0; i < 25; ++i) a.in[i] = (const float*)d_in[i];
    a.out = (float*)d_out; a.ws = (unsigned char*)d_ws; a.pad = 0;
    if (MK_N_LAUNCHES == 1) {
        a.ph_lo = 0; a.ph_hi = N_PHASES; a.li = 0;
        hipLaunchKernelGGL(fwd_kernel, dim3(grid), dim3(NTHR), LDS_BYTES, stream, a);
    } else {
        for (int li = 0; li < N_PHASES; ++li) { a.ph_lo = li; a.ph_hi = li + 1; a.li = li;
            hipLaunchKernelGGL(fwd_kernel, dim3(grid), dim3(NTHR), LDS_BYTES, stream, a); }
    }
    const hipError_t le = hipPeekAtLastError();
    if (le != hipSuccess) fprintf(stderr, "kernel_launch: launch failed: %s\n", hipGetErrorName(le));
}
```
